# Optimizing an MI355X kernel written in HIP

```python
import math
import jax, jax.numpy as jnp
from jax import lax
import numpy as np

D_MODEL = 1024
BATCH = 32
SEQ = 2048
DEPTH = 4

POOL_WINDOWS = (2, 4, 8, 16)
N_POOL_GROUPS = 4
POOL_GROUP = D_MODEL // N_POOL_GROUPS
HEAD_DIM = 64
N_HEADS = D_MODEL // HEAD_DIM
N_KV_HEADS = 4
GROUP_SIZE = N_HEADS // N_KV_HEADS
N_BRANCH = 3
CMP_LEN = 32
CMP_STRIDE = 16
CMP_HIDDEN = 4 * HEAD_DIM
SLC_LEN = 64
N_SEL = 4
WINDOW = 256
Q_BLOCK = 128
FORCED_SCORE = 1.0e4
N_BUCKETS = 32
MAX_DISTANCE = 128
D_FF = (7 * D_MODEL) // 2
N_EXPERTS = 8
TOP_K = 2
EPS = 1e-6
NEG = -1e30
TINY = 1e-30

kernel_name = "yoco_pool_nsa_moe_hybrid"


def rmsnorm(x, g):
    xf = x.astype(jnp.float32)
    y = xf * lax.rsqrt(jnp.mean(xf * xf, axis=-1, keepdims=True) + EPS)
    return (y * g.astype(jnp.float32)).astype(x.dtype)


def masked_softmax(s, mask):
    s = jnp.where(mask, s, NEG)
    m = jnp.max(s, axis=-1, keepdims=True)
    p = jnp.where(mask, jnp.exp(s - m), 0.0)
    return p / jnp.maximum(jnp.sum(p, axis=-1, keepdims=True), TINY)


def rel_bucket(dist):
    n = jnp.maximum(dist, 0)
    max_exact = N_BUCKETS // 2
    nf = jnp.maximum(n, 1).astype(jnp.float32)
    large = max_exact + (jnp.log(nf / max_exact) / math.log(MAX_DISTANCE / max_exact)
                         * (N_BUCKETS - max_exact)).astype(jnp.int32)
    large = jnp.minimum(large, N_BUCKETS - 1)
    return jnp.where(n < max_exact, n, large)


def pool_mixer(h, w_grp, scale):
    B, S, D = h.shape
    hg = h.reshape(B, S, N_POOL_GROUPS, POOL_GROUP)
    csum = jnp.cumsum(hg.astype(jnp.float32), axis=1)
    t = jnp.arange(S)
    pooled = []
    for gi, w in enumerate(POOL_WINDOWS):
        c = csum[:, :, gi]
        prev = jnp.pad(c, ((0, 0), (w, 0), (0, 0)))[:, :S]
        cnt = jnp.minimum(t + 1, w).astype(jnp.float32)[None, :, None]
        pooled.append((c - prev) / cnt)
    pooled = jnp.stack(pooled, axis=2)
    diff = (pooled - hg.astype(jnp.float32)).astype(h.dtype)
    y = jnp.einsum('bsgc,gcd->bsgd', diff, w_grp).reshape(B, S, D)
    return y * scale


def swiglu(h, wg, wu, wd):
    return (jax.nn.silu(h @ wg) * (h @ wu)) @ wd


def moe(h, router, wg, wu, wd):
    B, S, D = h.shape
    xf = h.reshape(-1, D)
    logits = jnp.einsum('nd,de->ne', xf, router, preferred_element_type=jnp.float32)
    top_val, top_idx = lax.top_k(logits, TOP_K)
    gate = jax.nn.softmax(top_val, axis=-1)
    flat_e = top_idx.reshape(-1)
    order = jnp.argsort(flat_e)
    tok = order // TOP_K
    sizes = jnp.bincount(flat_e, length=N_EXPERTS).astype(jnp.int32)
    xs = xf[tok]
    hid = jax.nn.silu(lax.ragged_dot(xs, wg, sizes)) * lax.ragged_dot(xs, wu, sizes)
    ys = lax.ragged_dot(hid, wd, sizes) * gate.reshape(-1)[order][:, None].astype(h.dtype)
    return jnp.zeros_like(xf).at[tok].add(ys).reshape(B, S, D)


def build_shared_kv(x, norm_kv, w_kv, g_k, cmp_pos, cmp_w1, cmp_w2):
    B, S, _ = x.shape
    y = rmsnorm(x, norm_kv)
    kv = (y @ w_kv).reshape(B, S, 2 * N_BRANCH, N_KV_HEADS, HEAD_DIM)
    k_c, v_c, k_s, v_s, k_w, v_w = [kv[:, :, i] for i in range(2 * N_BRANCH)]
    nc = (S - CMP_LEN) // CMP_STRIDE + 1
    idx = np.arange(nc)[:, None] * CMP_STRIDE + np.arange(CMP_LEN)[None, :]

    def compress(z, pos, w1, w2):
        blocks = z[:, idx] + pos[None, None, :, None, :]
        blocks = blocks.transpose(0, 1, 3, 2, 4).reshape(B, nc, N_KV_HEADS, CMP_LEN * HEAD_DIM)
        return jax.nn.silu(blocks @ w1) @ w2

    k_cmp = rmsnorm(compress(k_c, cmp_pos[0], cmp_w1[0], cmp_w2[0]), g_k[0])
    v_cmp = compress(v_c, cmp_pos[1], cmp_w1[1], cmp_w2[1])
    nsb = S // SLC_LEN

    def to_blocks(z):
        return (z.reshape(B, nsb, SLC_LEN, N_KV_HEADS, HEAD_DIM)
                 .transpose(0, 3, 1, 2, 4).reshape(B, N_KV_HEADS, nsb, SLC_LEN * HEAD_DIM))

    k_slc = to_blocks(rmsnorm(k_s, g_k[1]))
    v_slc = to_blocks(v_s)
    pad = ((0, 0), (WINDOW, 0), (0, 0), (0, 0))
    k_win = jnp.pad(rmsnorm(k_w, g_k[2]), pad)
    v_win = jnp.pad(v_w, pad)
    return (k_cmp, v_cmp, k_slc, v_slc, k_win, v_win)


def nsa_mixer(h, w_qg, g_q, w_o, rel_bias, k_cmp, v_cmp, k_slc, v_slc, k_win, v_win):
    B, S, _ = h.shape
    HD = N_HEADS * HEAD_DIM
    G, R, DH = N_KV_HEADS, GROUP_SIZE, HEAD_DIM
    qg = h @ w_qg
    q = rmsnorm(qg[..., :HD].reshape(B, S, G, R, DH), g_q) * (DH ** -0.5)
    gates = jax.nn.sigmoid(qg[..., HD:].astype(jnp.float32)).reshape(B, S, G, R, N_BRANCH).astype(h.dtype)
    nc = k_cmp.shape[1]
    nsb = S // SLC_LEN
    n_sel = min(N_SEL, nsb)
    cmp_start = np.arange(nc) * CMP_STRIDE
    cmp_end = jnp.asarray(cmp_start + CMP_LEN - 1, dtype=jnp.int32)
    slc_start = np.arange(nsb) * SLC_LEN
    overlap = np.clip(np.minimum(cmp_start[:, None] + CMP_LEN, slc_start[None, :] + SLC_LEN)
                      - np.maximum(cmp_start[:, None], slc_start[None, :]), 0, None) / CMP_LEN
    cmp_to_slc = jnp.asarray(overlap, dtype=jnp.float32)
    bias_tab = rel_bias.astype(jnp.float32).reshape(N_BUCKETS, G, R)
    bias_tab_g = bias_tab.transpose(1, 0, 2)
    g_idx = jnp.arange(G)
    jb = jnp.arange(nsb)

    def block(qb):
        t0 = qb * Q_BLOCK
        tq = t0 + jnp.arange(Q_BLOCK)
        qblk = lax.dynamic_slice_in_dim(q, t0, Q_BLOCK, axis=1)
        gblk = lax.dynamic_slice_in_dim(gates, t0, Q_BLOCK, axis=1)
        dc = tq[:, None] - cmp_end[None, :]
        s = jnp.einsum('bqgrd,bcgd->bgrqc', qblk, k_cmp, preferred_element_type=jnp.float32)
        s = s + bias_tab[rel_bucket(dc)].transpose(2, 3, 0, 1)
        p_cmp = masked_softmax(s, dc >= 0)
        o_cmp = jnp.einsum('bgrqc,bcgd->bqgrd', p_cmp.astype(v_cmp.dtype), v_cmp)
        imp = jnp.einsum('bgrqc,cj->bqgj', p_cmp, cmp_to_slc)
        blk_q = tq // SLC_LEN
        valid = jb[None, :] <= blk_q[:, None]
        forced = (jb[None, :] == 0) | (jb[None, :] == blk_q[:, None]) | (jb[None, :] == blk_q[:, None] - 1)
        score = jnp.where(forced[None, :, None, :], FORCED_SCORE,
                          jnp.where(valid[None, :, None, :], imp, NEG))
        _, sel = lax.top_k(score, n_sel)
        sel_t = sel.transpose(0, 2, 1, 3)
        flat = sel_t.reshape(B, G, Q_BLOCK * n_sel)[..., None]
        ks = jnp.take_along_axis(k_slc, flat, axis=2).reshape(B, G, Q_BLOCK, n_sel, SLC_LEN, DH)
        vs = jnp.take_along_axis(v_slc, flat, axis=2).reshape(B, G, Q_BLOCK, n_sel, SLC_LEN, DH)
        pos = sel_t[..., None] * SLC_LEN + jnp.arange(SLC_LEN)
        ds = tq[None, None, :, None, None] - pos
        bias_s = bias_tab_g[g_idx[None, :, None, None, None], rel_bucket(ds)]
        s = jnp.einsum('bqgrd,bgqnld->bgrqnl', qblk, ks, preferred_element_type=jnp.float32)
        s = (s + bias_s.transpose(0, 1, 5, 2, 3, 4)).reshape(B, G, R, Q_BLOCK, n_sel * SLC_LEN)
        mask_s = (ds >= 0).reshape(B, G, 1, Q_BLOCK, n_sel * SLC_LEN)
        p = masked_softmax(s, mask_s).reshape(B, G, R, Q_BLOCK, n_sel, SLC_LEN)
        o_slc = jnp.einsum('bgrqnl,bgqnld->bqgrd', p.astype(vs.dtype), vs)
        kw = lax.dynamic_slice_in_dim(k_win, t0, Q_BLOCK + WINDOW, axis=1)
        vw = lax.dynamic_slice_in_dim(v_win, t0, Q_BLOCK + WINDOW, axis=1)
        kpos = t0 - WINDOW + jnp.arange(Q_BLOCK + WINDOW)
        dw = tq[:, None] - kpos[None, :]
        mw = (dw >= 0) & (dw < WINDOW) & (kpos[None, :] >= 0)
        s = jnp.einsum('bqgrd,bkgd->bgrqk', qblk, kw, preferred_element_type=jnp.float32)
        s = s + bias_tab[rel_bucket(dw)].transpose(2, 3, 0, 1)
        p = masked_softmax(s, mw)
        o_win = jnp.einsum('bgrqk,bkgd->bqgrd', p.astype(vw.dtype), vw)
        return gblk[..., 0:1] * o_cmp + gblk[..., 1:2] * o_slc + gblk[..., 2:3] * o_win

    out = lax.map(block, jnp.arange(S // Q_BLOCK))
    out = out.transpose(1, 0, 2, 3, 4, 5).reshape(B, S, HD)
    return out @ w_o


def setup_inputs(seed: int = 0) -> dict:
    key = jax.random.key(seed)
    ks = iter(jax.random.split(key, 32))
    f32 = jnp.float32

    def nrm(shape, fan_in):
        return jax.random.normal(next(ks), shape, f32) * (fan_in ** -0.5)

    def gain(shape):
        return 1.0 + 0.05 * jax.random.normal(next(ks), shape, f32)

    n_a = DEPTH // 2
    n_b = DEPTH - n_a
    n_dense = (DEPTH + 1) // 2
    n_moe = DEPTH // 2
    HD = N_HEADS * HEAD_DIM
    return {
        "x": jax.random.normal(next(ks), (BATCH, SEQ, D_MODEL), f32),
        "rel_bias": 0.5 * jax.random.normal(next(ks), (N_BUCKETS, N_HEADS), f32),
        "norm_mix": gain((DEPTH, D_MODEL)),
        "norm_ffn": gain((DEPTH, D_MODEL)),
        "pool_w": nrm((n_a, N_POOL_GROUPS, POOL_GROUP, POOL_GROUP), POOL_GROUP),
        "pool_scale": gain((n_a, D_MODEL)),
        "norm_kv": gain((D_MODEL,)),
        "w_kv": nrm((D_MODEL, 2 * N_BRANCH * N_KV_HEADS * HEAD_DIM), D_MODEL),
        "g_k": gain((N_BRANCH, HEAD_DIM)),
        "cmp_pos": 0.1 * jax.random.normal(next(ks), (2, CMP_LEN, HEAD_DIM), f32),
        "cmp_w1": nrm((2, CMP_LEN * HEAD_DIM, CMP_HIDDEN), CMP_LEN * HEAD_DIM),
        "cmp_w2": nrm((2, CMP_HIDDEN, HEAD_DIM), CMP_HIDDEN),
        "w_qg": nrm((n_b, D_MODEL, HD + N_BRANCH * N_HEADS), D_MODEL),
        "g_q": gain((n_b, HEAD_DIM)),
        "w_o": nrm((n_b, HD, D_MODEL), HD),
        "ffn_wg": nrm((n_dense, D_MODEL, D_FF), D_MODEL),
        "ffn_wu": nrm((n_dense, D_MODEL, D_FF), D_MODEL),
        "ffn_wd": nrm((n_dense, D_FF, D_MODEL), D_FF),
        "router": nrm((n_moe, D_MODEL, N_EXPERTS), D_MODEL),
        "moe_wg": nrm((n_moe, N_EXPERTS, D_MODEL, D_FF), D_MODEL),
        "moe_wu": nrm((n_moe, N_EXPERTS, D_MODEL, D_FF), D_MODEL),
        "moe_wd": nrm((n_moe, N_EXPERTS, D_FF, D_MODEL), D_FF),
    }


def reference(x, rel_bias, norm_mix, norm_ffn, pool_w, pool_scale, norm_kv, w_kv, g_k,
              cmp_pos, cmp_w1, cmp_w2, w_qg, g_q, w_o, ffn_wg, ffn_wu, ffn_wd,
              router, moe_wg, moe_wu, moe_wd):
    n_a = DEPTH // 2
    shared = None
    for layer in range(DEPTH):
        h = rmsnorm(x, norm_mix[layer])
        if layer < n_a:
            x = x + pool_mixer(h, pool_w[layer], pool_scale[layer])
        else:
            j = layer - n_a
            x = x + nsa_mixer(h, w_qg[j], g_q[j], w_o[j], rel_bias, *shared)
        h = rmsnorm(x, norm_ffn[layer])
        i = layer // 2
        if layer % 2 == 0:
            x = x + swiglu(h, ffn_wg[i], ffn_wu[i], ffn_wd[i])
        else:
            x = x + moe(h, router[i], moe_wg[i], moe_wu[i], moe_wd[i])
        if layer == n_a - 1:
            shared = build_shared_kv(x, norm_kv, w_kv, g_k, cmp_pos, cmp_w1, cmp_w2)
    return x
```

```cpp
#include <hip/hip_runtime.h>
#include <cstdio>
#include <cstdint>

#ifndef MK_SINGLE_LAUNCH
#define MK_SINGLE_LAUNCH 1
#endif

#ifndef PROBE_BAR
#define PROBE_BAR 0
#endif
#ifndef PROBE_ATTN
#define PROBE_ATTN 0
#endif
#ifndef PROBE_DUP
#define PROBE_DUP 0
#endif
#define DUP(bit) for (int _rep = 0; _rep < (((PROBE_DUP) >> (bit)) & 1) + 1; ++_rep)
#define LAS __attribute__((address_space(3)))
typedef unsigned short bf16_t;
typedef short bf16x8 __attribute__((ext_vector_type(8)));
typedef float f32x4 __attribute__((ext_vector_type(4)));
typedef float f32x2 __attribute__((ext_vector_type(2)));
typedef unsigned u32x4 __attribute__((ext_vector_type(4)));
typedef int v8i32 __attribute__((ext_vector_type(8)));
typedef int v4i32 __attribute__((ext_vector_type(4)));
typedef unsigned u32x2 __attribute__((ext_vector_type(2)));

constexpr int NTOK = 65536, DM = 1024, FFD = 3584, NEXP = 8, SEQ = 2048, NBATCH = 32;
constexpr int NCMP = 127, NSLC = 32;
constexpr float EPS = 1e-6f;
constexpr float NEGF = -1e30f, TINYF = 1e-30f;

constexpr size_t MiB = (size_t)1 << 20;
constexpr size_t WS_CTL = 0;
constexpr size_t CTL_ZERO_BYTES = 64 * 1024;
constexpr size_t CTL_CNT = 64 * 1024;
constexpr size_t CTL_TILEE = 80 * 1024;
constexpr size_t CTL_NT = 88 * 1024;
constexpr size_t WS_W = 1 * MiB;
constexpr size_t W_POOL = WS_W;
constexpr size_t W_GU = W_POOL + (size_t)2 * 4 * 256 * 256 * 2;
constexpr size_t W_D = W_GU + (size_t)2 * 7168 * 1024 * 2;
constexpr size_t W_KV = W_D + (size_t)2 * 1024 * 3584 * 2;
constexpr size_t W_QG = W_KV + (size_t)1536 * 1024 * 2;
constexpr size_t W_O = W_QG + (size_t)2 * 1280 * 1024 * 2;
constexpr size_t W_C1 = W_O + (size_t)2 * 1024 * 1024 * 2;
constexpr size_t W_C2 = W_C1 + (size_t)2 * 256 * 2048 * 2;
constexpr size_t W_END = W_C2 + (size_t)2 * 256 * 256 * 2;
constexpr size_t WS_WMOE = 60 * MiB;
constexpr size_t WMOE_D = WS_WMOE + (size_t)8 * 7168 * 1024 * 2;
constexpr size_t WS_A = 228 * MiB;
constexpr size_t WS_BLK = WS_A + 128 * MiB;
constexpr size_t WS_KF = WS_WMOE;
constexpr size_t WS_VF = WS_WMOE + 64 * MiB;
constexpr size_t WS_KCF = WS_WMOE + 128 * MiB;
constexpr size_t WS_VCF = WS_KCF + 2 * MiB;
constexpr size_t WS_H = 488 * MiB;
constexpr size_t WS_KVRAW = 616 * MiB;
constexpr size_t WS_QGRAW = 808 * MiB;
constexpr size_t WS_MISC = 968 * MiB;
constexpr size_t MS_CMPRAW = WS_MISC;
constexpr size_t MS_RE = WS_MISC + 8 * MiB;
constexpr size_t MS_RG = MS_RE + 256 * 1024;
constexpr size_t MS_RSTD = MS_RG + 512 * 1024;
constexpr size_t MS_SLOT = MS_RSTD + 256 * 1024;
constexpr size_t MS_SSQ = MS_SLOT + 512 * 1024;
constexpr size_t WS_END = WS_MISC + 12 * MiB;
static_assert(W_END <= WS_WMOE, "weights region");

__device__ __forceinline__ unsigned f2bf(float f) { unsigned u = __builtin_bit_cast(unsigned, f); return (u + 0x7fffu + ((u >> 16) & 1u)) >> 16; }
__device__ __forceinline__ unsigned pk2(float lo, float hi) { return f2bf(lo) | (f2bf(hi) << 16); }
__device__ __forceinline__ float bf2f(unsigned short b) { return __builtin_bit_cast(float, (unsigned)b << 16); }
__device__ __forceinline__ float bflo(unsigned w) { return __builtin_bit_cast(float, w << 16); }
__device__ __forceinline__ float bfhi(unsigned w) { return __builtin_bit_cast(float, w & 0xffff0000u); }
__device__ __forceinline__ unsigned cvt_pk_bf16(float lo, float hi) { unsigned r; asm volatile("v_cvt_pk_bf16_f32 %0, %1, %2" : "=v"(r) : "v"(lo), "v"(hi)); return r; }
__device__ __forceinline__ f32x4 ld4(const float* p) { return *(const f32x4*)p; }
__device__ __forceinline__ f32x4 ld4(const bf16_t* p) { const u32x2 w = *(const u32x2*)p; return (f32x4){bflo(w.x), bfhi(w.x), bflo(w.y), bfhi(w.y)}; }
__device__ __forceinline__ void ld8(const float* p, f32x4& a, f32x4& b) { a = *(const f32x4*)p; b = *(const f32x4*)(p + 4); }
__device__ __forceinline__ void ld8(const bf16_t* p, f32x4& a, f32x4& b) { const u32x4 w = *(const u32x4*)p; a = (f32x4){bflo(w.x), bfhi(w.x), bflo(w.y), bfhi(w.y)}; b = (f32x4){bflo(w.z), bfhi(w.z), bflo(w.w), bfhi(w.w)}; }
__device__ __forceinline__ float wave_sum(float v) {
#pragma unroll
    for (int o = 1; o < 64; o <<= 1) v += __shfl_xor(v, o);
    return v;
}
__device__ __forceinline__ int opaque_tid() { int t = threadIdx.x; asm volatile("" : "+v"(t)); return t; }
__device__ __forceinline__ float silu_f(float g) { return g * __builtin_amdgcn_rcpf(1.f + __expf(-g)); }

namespace pg8 {
constexpr int BM = 256, BK = 64, HALF = 128, HTB = HALF * BK * 2, STAGE_BYTES = 8 * HTB, NXCD = 8, WGM = 8;
__host__ __device__ __forceinline__ int lds_byte(int r, int c) { const int st = (r >> 4) * 2 + (c >> 5), rr = r & 15, cc = c & 31, ob = rr * 64 + cc * 2; return st * 1024 + (ob ^ (((ob >> 9) & 1) << 5)); }
__host__ __device__ __forceinline__ void stage_rc(int b, int& R, int& C) { const int st = b / 1024, sb = b % 1024, swz = sb ^ (((sb >> 9) & 1) << 5); R = (st >> 1) * 16 + swz / 64; C = (st & 1) * 32 + (swz % 64) / 2; }
__host__ __device__ __forceinline__ int perm32(int rho) { const int n = rho >> 4, i = rho & 15; return 8 * (i >> 2) + 4 * n + (i & 3); }

struct Unit { int pm, pn; };
struct Gemm { int K, lda, ldb; };

__device__ __forceinline__ bool grid_order(int nM, int nN, int G, int c, int i, Unit& u) {
    const int nwg = nM * nN; const long L = (long)i * G + c; if (L >= nwg) return false;
    int wgid = (int)L; { const int q = nwg / NXCD, r = nwg % NXCD, xcd = wgid % NXCD, off = wgid / NXCD; wgid = (xcd < r ? xcd * (q + 1) : r * (q + 1) + (xcd - r) * q) + off; }
    const int nig = WGM * nN, gid = wgid / nig, fm = gid * WGM, gsz = (nM - fm) < WGM ? (nM - fm) : WGM;
    u.pm = fm + ((wgid % nig) % gsz); u.pn = (wgid % nig) / gsz; return true;
}
struct GridSched {
    int nM, nN, G, c; const char* A; size_t a_sm, a_sn; const char* B; size_t b_sn, b_sm; int b_div;
    __device__ __forceinline__ bool next(int i, Unit& u) const { return grid_order(nM, nN, G, c, i, u); }
    __device__ __forceinline__ const char* a_tile(const Unit& u) const { return A + (size_t)u.pm * a_sm + (size_t)u.pn * a_sn; }
    __device__ __forceinline__ const char* b_tile(const Unit& u) const { return B + (size_t)u.pn * b_sn + (size_t)(u.pm / b_div) * b_sm; }
};
struct MoeSched {
    int nM, nN, G, c; const LAS int* tile_e; const char* A; size_t a_sm; const char* B; size_t b_tile_bytes; int tiles_per_e;
    __device__ __forceinline__ bool next(int i, Unit& u) const { return grid_order(nM, nN, G, c, i, u); }
    __device__ __forceinline__ const char* a_tile(const Unit& u) const { return A + (size_t)u.pm * a_sm; }
    __device__ __forceinline__ const char* b_tile(const Unit& u) const { const int e = __builtin_amdgcn_readfirstlane(tile_e[u.pm]); return B + ((size_t)e * tiles_per_e + u.pn) * b_tile_bytes; }
};

constexpr int XSPLIT = 7, XK = 512, XROWS = 8 * 256;
constexpr float F8_HS = 8.f, F8_WS = 64.f, F8_OSC = 1.f / (F8_HS * F8_WS);
constexpr float F8_XS = 8.f, F8_GUS = 1.f / (F8_XS * F8_WS);
constexpr int XKE = XK / 2;
struct MoeSplitSched {
    int nX, G, c; const LAS int* tile_e; const char* A; size_t a_sm; const char* B; size_t b_tile_bytes;
    __device__ __forceinline__ bool next(int i, Unit& u) const { return grid_order(nX, 4 * XSPLIT, G, c, i, u); }
    __device__ __forceinline__ const char* a_tile(const Unit& u) const { return A + (size_t)u.pm * a_sm + (size_t)(u.pn >> 2) * (XK / 64) * 1024; }
    __device__ __forceinline__ const char* b_tile(const Unit& u) const { const int e = __builtin_amdgcn_readfirstlane(tile_e[u.pm]); return B + ((size_t)e * 4 + (u.pn & 3)) * b_tile_bytes + (size_t)(u.pn >> 2) * (XK / 64) * 1024; }
};
struct RowScale {
    const float* SSQ; int row_off; LAS float* SQ;
    __device__ __forceinline__ void pre_dma(const Unit& u, int slot, int wid, int lane) const {
        const float* g = SSQ + (size_t)(row_off + u.pm * BM) * 4 + wid * 64 + lane;
#pragma unroll
        for (int i = 0; i < 2; ++i) __builtin_amdgcn_global_load_lds((const unsigned*)(g + i * 512), (LAS unsigned*)(SQ + slot * 1024 + i * 512 + wid * 64), 4, 0, 0);
    }
    __device__ __forceinline__ float msq(int slot, int lrow) const { const f32x4 p = *(const LAS f32x4*)(SQ + slot * 1024 + lrow * 4); return ((p.x + p.y) + (p.z + p.w)) * (1.f / DM) + EPS; }
    __device__ __forceinline__ float get(int slot, int lrow) const { const f32x4 p = *(const LAS f32x4*)(SQ + slot * 1024 + lrow * 4); return __builtin_amdgcn_rsqf(((p.x + p.y) + (p.z + p.w)) * (1.f / DM) + EPS); }
};
template <typename TS> struct EpiResid {
    static constexpr bool PERM = true, PRE = false; static constexpr int NSTORE = 0;
    __device__ __forceinline__ void pre_dma(const Unit&, int, int, int) const {}
    const TS* src; bf16_t* XB; float* SSQ; int ld; int row_off; LAS float* P; float osc;
    __device__ __forceinline__ void operator()(const f32x4 (&acc)[2][2][4][2], const Unit& u, int wr, int wc, int fr, int fq, int) const {
        const int row0 = row_off + u.pm * BM + wr * 64 + fr, col0 = u.pn * BM + wc * 32 + 8 * fq;
#pragma unroll
        for (int ai = 0; ai < 2; ++ai)
#pragma unroll
            for (int m = 0; m < 4; ++m) { const size_t ro = (size_t)(row0 + ai * HALF + m * 16) * ld + col0; float ss = 0.f;
#pragma unroll
                for (int bj = 0; bj < 2; ++bj) { f32x4 v0, v1; ld8(src + ro + bj * HALF, v0, v1); v0 += acc[ai][bj][m][0] * osc; v1 += acc[ai][bj][m][1] * osc;
                        u32x4 w; w.x = cvt_pk_bf16(v0.x, v0.y); w.y = cvt_pk_bf16(v0.z, v0.w); w.z = cvt_pk_bf16(v1.x, v1.y); w.w = cvt_pk_bf16(v1.z, v1.w); *(u32x4*)(XB + ro + bj * HALF) = w;
                        ss += ((v0.x * v0.x + v0.y * v0.y) + (v0.z * v0.z + v0.w * v0.w)) + ((v1.x * v1.x + v1.y * v1.y) + (v1.z * v1.z + v1.w * v1.w)); }
                ss += __shfl_xor(ss, 16); ss += __shfl_xor(ss, 32);
                if (fq == 0) P[(ai * HALF + wr * 64 + m * 16 + fr) * 4 + wc] = ss; }
        asm volatile("s_waitcnt lgkmcnt(0)" ::: "memory"); __builtin_amdgcn_s_barrier(); asm volatile("" ::: "memory");
        const int t = opaque_tid();
        if (t < 256) { const f32x4 p = *(const LAS f32x4*)(P + t * 4); SSQ[(size_t)(row_off + u.pm * BM + t) * 4 + u.pn] = (p.x + p.y) + (p.z + p.w); }
    }
};
template <bool SCALE> struct EpiSwiGLU {
    static constexpr bool PERM = true, PRE = SCALE; static constexpr int NSTORE = 0;
    bf16_t* O; int ldc; RowScale R; unsigned* sink;
    __device__ __forceinline__ unsigned* dummy() const { return sink + (size_t)blockIdx.x * 4096; }
    __device__ __forceinline__ void pre_dma(const Unit& u, int slot, int wid, int lane) const { if (SCALE) R.pre_dma(u, slot, wid, lane); }
    __device__ __forceinline__ void operator()(const f32x4 (&acc)[2][2][4][2], const Unit& u, int wr, int wc, int fr, int fq, int slot) const {
        const int rb0 = u.pm * 16 + wr * 4, cb = u.pn * 2 + (wc >> 1), ncb = ldc >> 6;
#pragma unroll
        for (int ai = 0; ai < 2; ++ai)
#pragma unroll
            for (int m = 0; m < 4; ++m) { bf16_t* rowp = (bf16_t*)((char*)O + ((size_t)(rb0 + ai * 8 + m) * ncb + cb) * 1024 + fr * 64 + (wc & 1) * 32 + fq * 8);
                float nr = SCALE ? -1.44269504f : -1.44269504f * F8_GUS, ir2 = 1.f;
                if (SCALE) { ir2 = R.msq(slot, ai * HALF + wr * 64 + m * 16 + fr); nr = -1.44269504f * __builtin_amdgcn_rsqf(ir2); }
                const float icd = SCALE ? ir2 * (1.f / F8_HS) : 1.f / (F8_HS * F8_GUS * F8_GUS);
                u32x4 w = (u32x4){0u, 0u, 0u, 0u};
#pragma unroll
                for (int n = 0; n < 2; ++n) {
#pragma unroll
                    for (int hh = 0; hh < 2; ++hh) { const f32x2 g = (f32x2){acc[ai][0][m][n][2 * hh], acc[ai][0][m][n][2 * hh + 1]}, u = (f32x2){acc[ai][1][m][n][2 * hh], acc[ai][1][m][n][2 * hh + 1]};
                        const f32x2 t = g * nr; f32x2 e; e.x = __builtin_amdgcn_exp2f(t.x); e.y = __builtin_amdgcn_exp2f(t.y);
                        const f32x2 d = e * icd + icd;
                        f32x2 q; q.x = __builtin_amdgcn_rcpf(d.x); q.y = __builtin_amdgcn_rcpf(d.y);
                        const f32x2 hv = (g * u) * q;
                        { const f32x2 h8 = hv;
                            if (n == 0 && hh == 0) w.x = (unsigned)__builtin_amdgcn_cvt_pk_fp8_f32(h8.x, h8.y, (int)w.x, false); else if (n == 0) w.x = (unsigned)__builtin_amdgcn_cvt_pk_fp8_f32(h8.x, h8.y, (int)w.x, true);
                            else if (hh == 0) w.y = (unsigned)__builtin_amdgcn_cvt_pk_fp8_f32(h8.x, h8.y, (int)w.y, false); else w.y = (unsigned)__builtin_amdgcn_cvt_pk_fp8_f32(h8.x, h8.y, (int)w.y, true); } } }
                *(u32x2*)rowp = (u32x2){w.x, w.y}; }
    }
};
template <int ACT  , bool SCALE> struct EpiBf16 {
    static constexpr bool PERM = true, PRE = SCALE; static constexpr int NSTORE = 0;
    bf16_t* O; int ldc; RowScale R; float osc;
    __device__ __forceinline__ void pre_dma(const Unit& u, int slot, int wid, int lane) const { if (SCALE) R.pre_dma(u, slot, wid, lane); }
    __device__ __forceinline__ void operator()(const f32x4 (&acc)[2][2][4][2], const Unit& u, int wr, int wc, int fr, int fq, int slot) const {
        const int row0 = u.pm * BM + wr * 64 + fr, col0 = u.pn * BM + wc * 32 + 8 * fq;
#pragma unroll
        for (int ai = 0; ai < 2; ++ai)
#pragma unroll
            for (int m = 0; m < 4; ++m) { bf16_t* rowp = O + (size_t)(row0 + ai * HALF + m * 16) * ldc + col0;
                const float r = (SCALE ? R.get(slot, ai * HALF + wr * 64 + m * 16 + fr) : 1.f) * osc;
#pragma unroll
                for (int bj = 0; bj < 2; ++bj) { f32x4 v0 = acc[ai][bj][m][0] * r, v1 = acc[ai][bj][m][1] * r;
                    if (ACT == 1) {
#pragma unroll
                        for (int j = 0; j < 4; ++j) { v0[j] = silu_f(v0[j]); v1[j] = silu_f(v1[j]); } }
                    u32x4 w; w.x = cvt_pk_bf16(v0[0], v0[1]); w.y = cvt_pk_bf16(v0[2], v0[3]); w.z = cvt_pk_bf16(v1[0], v1[1]); w.w = cvt_pk_bf16(v1[2], v1[3]);
                    *(u32x4*)(rowp + bj * HALF) = w; } }
    }
};

struct EpiPart {
    static constexpr bool PERM = true, PRE = false; static constexpr int NSTORE = 0;
    bf16_t* P;
    __device__ __forceinline__ void pre_dma(const Unit&, int, int, int) const {}
    __device__ __forceinline__ void operator()(const f32x4 (&acc)[2][2][4][2], const Unit& u, int wr, int wc, int fr, int fq, int) const {
        const int row0 = u.pm * BM + wr * 64 + fr, col0 = (u.pn & 3) * BM + wc * 32 + 8 * fq; bf16_t* O = P + (size_t)(u.pn >> 2) * XROWS * DM;
#pragma unroll
        for (int ai = 0; ai < 2; ++ai)
#pragma unroll
            for (int m = 0; m < 4; ++m) { bf16_t* rowp = O + (size_t)(row0 + ai * HALF + m * 16) * DM + col0;
#pragma unroll
                for (int bj = 0; bj < 2; ++bj) { const f32x4 v0 = acc[ai][bj][m][0] * F8_OSC, v1 = acc[ai][bj][m][1] * F8_OSC;
                    u32x4 w; w.x = cvt_pk_bf16(v0[0], v0[1]); w.y = cvt_pk_bf16(v0[2], v0[3]); w.z = cvt_pk_bf16(v1[0], v1[1]); w.w = cvt_pk_bf16(v1[2], v1[3]);
                    *(u32x4*)(rowp + bj * HALF) = w; } }
    }
};

__device__ __forceinline__ int vt_pos_(int k) { return (k & ~12) | ((k & 4) << 1) | ((k & 8) >> 1); }
struct EpiKV {
    static constexpr bool PERM = true, PRE = true; static constexpr int NSTORE = 0;
    RowScale R; bf16_t* BLK; bf16_t* KF; bf16_t* VF; const LAS float* gain; const LAS float* pos;
    __device__ __forceinline__ void pre_dma(const Unit& u, int slot, int wid, int lane) const { R.pre_dma(u, slot, wid, lane); }
    __device__ __forceinline__ void operator()(const f32x4 (&acc)[2][2][4][2], const Unit& u, int wr, int wc, int fr, int fq, int slot) const {
        const int kind = u.pn, w = kind >> 1, g = wc;
#pragma unroll
        for (int ai = 0; ai < 2; ++ai)
#pragma unroll
            for (int m = 0; m < 4; ++m) {
                const int lrow = ai * HALF + wr * 64 + m * 16 + fr, row = u.pm * BM + lrow, b = row >> 11, t = row & 2047;
                const float rs = R.get(slot, lrow);
                f32x4 v[2][2];
#pragma unroll
                for (int bj = 0; bj < 2; ++bj)
#pragma unroll
                    for (int n = 0; n < 2; ++n) v[bj][n] = acc[ai][bj][m][n] * rs;
                if (kind < 2) {
#pragma unroll
                    for (int which = 0; which < 2; ++which) { const int c = (t >> 4) - which, l = (t & 15) + 16 * which;
                        if (c >= 0 && c < NCMP) { bf16_t* dst = BLK + ((size_t)kind * 16384 + (size_t)(b * NCMP + c) * 4 + g) * 2048 + l * 64;
#pragma unroll
                            for (int bj = 0; bj < 2; ++bj) { const int d0 = 32 * bj + 8 * fq; const LAS float* pp = pos + (kind * 32 + l) * 64 + d0;
                                const f32x4 p0 = *(const LAS f32x4*)pp, p1 = *(const LAS f32x4*)(pp + 4); const f32x4 x0 = v[bj][0] + p0, x1 = v[bj][1] + p1;
                                u32x4 o; o.x = cvt_pk_bf16(x0[0], x0[1]); o.y = cvt_pk_bf16(x0[2], x0[3]); o.z = cvt_pk_bf16(x1[0], x1[1]); o.w = cvt_pk_bf16(x1[2], x1[3]);
                                *(u32x4*)(dst + d0) = o; } } }
                } else if ((kind & 1) == 0) {
                    float ss = 0.f;
#pragma unroll
                    for (int bj = 0; bj < 2; ++bj)
#pragma unroll
                        for (int n = 0; n < 2; ++n) ss += (v[bj][n][0] * v[bj][n][0] + v[bj][n][1] * v[bj][n][1]) + (v[bj][n][2] * v[bj][n][2] + v[bj][n][3] * v[bj][n][3]);
                    ss += __shfl_xor(ss, 16); ss += __shfl_xor(ss, 32);
                    const float rn = __builtin_amdgcn_rsqf(ss * (1.f / 64.f) + EPS);
                    const int kk = t & 63; bf16_t* tile = KF + (((size_t)(w - 1) * 128 + b * 4 + g) * 32 + (t >> 6)) * 4096;
#pragma unroll
                    for (int bj = 0; bj < 2; ++bj) { const int d0 = 32 * bj + 8 * fq; const LAS float* gp = gain + w * 64 + d0;
                        const f32x4 g0 = *(const LAS f32x4*)gp, g1 = *(const LAS f32x4*)(gp + 4); const f32x4 x0 = v[bj][0] * rn * g0, x1 = v[bj][1] * rn * g1;
                        u32x4 o; o.x = cvt_pk_bf16(x0[0], x0[1]); o.y = cvt_pk_bf16(x0[2], x0[3]); o.z = cvt_pk_bf16(x1[0], x1[1]); o.w = cvt_pk_bf16(x1[2], x1[3]);
                        *(u32x4*)(tile + (((kk >> 5) * 4 + (d0 >> 4)) * 64 + ((d0 >> 3) & 1) * 32 + (kk & 31)) * 8) = o; }
                } else {
                    const int kk = t & 63, ps = vt_pos_(kk); bf16_t* tile = VF + (((size_t)(w - 1) * 128 + b * 4 + g) * 32 + (t >> 6)) * 4096 + (((ps >> 4) * 2) * 64 + ((ps >> 3) & 1) * 32) * 8 + (ps & 7);
#pragma unroll
                    for (int bj = 0; bj < 2; ++bj)
#pragma unroll
                        for (int n = 0; n < 2; ++n)
#pragma unroll
                            for (int jj = 0; jj < 4; ++jj) { const int cc = 8 * fq + 4 * n + jj;
                                tile[(bj * 64 + cc) * 8] = (bf16_t)(cvt_pk_bf16(v[bj][n][jj], 0.f) & 0xffffu); }
                } }
    }
};
struct EpiQG {
    static constexpr bool PERM = true, PRE = true; static constexpr int NSTORE = 0;
    RowScale R; bf16_t* Q; int ldq; const LAS float* gain; float qscale;
    __device__ __forceinline__ void pre_dma(const Unit& u, int slot, int wid, int lane) const { R.pre_dma(u, slot, wid, lane); }
    __device__ __forceinline__ void operator()(const f32x4 (&acc)[2][2][4][2], const Unit& u, int wr, int wc, int fr, int fq, int slot) const {
#pragma unroll
        for (int ai = 0; ai < 2; ++ai)
#pragma unroll
            for (int m = 0; m < 4; ++m) {
                const int lrow = ai * HALF + wr * 64 + m * 16 + fr, row = u.pm * BM + lrow;
                const float rs = R.get(slot, lrow);
                f32x4 v[2][2];
#pragma unroll
                for (int bj = 0; bj < 2; ++bj)
#pragma unroll
                    for (int n = 0; n < 2; ++n) v[bj][n] = acc[ai][bj][m][n] * rs;
                if (u.pn < 4) {
                    float ss = 0.f;
#pragma unroll
                    for (int bj = 0; bj < 2; ++bj)
#pragma unroll
                        for (int n = 0; n < 2; ++n) ss += (v[bj][n][0] * v[bj][n][0] + v[bj][n][1] * v[bj][n][1]) + (v[bj][n][2] * v[bj][n][2] + v[bj][n][3] * v[bj][n][3]);
                    ss += __shfl_xor(ss, 16); ss += __shfl_xor(ss, 32);
                    const float rn = qscale * __builtin_amdgcn_rsqf(ss * (1.f / 64.f) + EPS);
                    bf16_t* dst = Q + (size_t)row * ldq + (4 * u.pn + wc) * 64;
#pragma unroll
                    for (int bj = 0; bj < 2; ++bj) { const int d0 = 32 * bj + 8 * fq; const LAS float* gp = gain + d0;
                        const f32x4 g0 = *(const LAS f32x4*)gp, g1 = *(const LAS f32x4*)(gp + 4); const f32x4 x0 = v[bj][0] * rn * g0, x1 = v[bj][1] * rn * g1;
                        u32x4 o; o.x = cvt_pk_bf16(x0[0], x0[1]); o.y = cvt_pk_bf16(x0[2], x0[3]); o.z = cvt_pk_bf16(x1[0], x1[1]); o.w = cvt_pk_bf16(x1[2], x1[3]);
                        *(u32x4*)(dst + d0) = o; }
                } else {
#pragma unroll
                    for (int bj = 0; bj < 2; ++bj) { const int o0 = 64 * wc + 32 * bj + 8 * fq;
                        if (o0 < 48) { u32x4 o; o.x = cvt_pk_bf16(v[bj][0][0], v[bj][0][1]); o.y = cvt_pk_bf16(v[bj][0][2], v[bj][0][3]); o.z = cvt_pk_bf16(v[bj][1][0], v[bj][1][1]); o.w = cvt_pk_bf16(v[bj][1][2], v[bj][1][3]);
                            *(u32x4*)(Q + (size_t)row * ldq + 1024 + o0) = o; } }
                } }
    }
};

struct EpiCmp2 {
    static constexpr bool PERM = true, PRE = false; static constexpr int NSTORE = 0;
    float* CMP;
    __device__ __forceinline__ void pre_dma(const Unit&, int, int, int) const {}
    __device__ __forceinline__ void operator()(const f32x4 (&acc)[2][2][4][2], const Unit& u, int wr, int wc, int fr, int fq, int) const {
        if (wc != 0) return;
#pragma unroll
        for (int ai = 0; ai < 2; ++ai)
#pragma unroll
            for (int m = 0; m < 4; ++m) { float* rowp = CMP + (size_t)(u.pm * BM + ai * HALF + wr * 64 + m * 16 + fr) * 64 + 8 * fq;
#pragma unroll
                for (int bj = 0; bj < 2; ++bj) { *(f32x4*)(rowp + 32 * bj) = acc[ai][bj][m][0]; *(f32x4*)(rowp + 32 * bj + 4) = acc[ai][bj][m][1]; } }
    }
};

struct NoHook { static constexpr bool ON = false; __device__ __forceinline__ void operator()() const {} };
template <class Epi, class Sched, class Hook = NoHook, bool ATILED = false, bool FP8 = false>
__device__ __forceinline__ void gemm_phase(LAS unsigned char* lds, const Gemm g, const Sched& S, const Epi& E, const Hook hook = Hook()) {
    const int tid = opaque_tid(), wid = __builtin_amdgcn_readfirstlane(tid >> 6), lane = tid & 63, wr = wid >> 2, wc = wid & 3, fr = lane & 15, fq = lane >> 4;
    int nt = g.K / BK; asm volatile("" : "+s"(nt));
    unsigned voffA[2], voffB[2];
#pragma unroll
    for (int i = 0; i < 2; ++i) { int R, C; stage_rc(tid * 16 + i * 8192, R, C); const int Rb = Epi::PERM ? ((R & ~31) + perm32(R & 31)) : R;
        voffA[i] = ATILED ? (unsigned)((((R >> 4) * (g.lda >> 5) + (C >> 5)) << 10) + (R & 15) * 64 + (C & 31) * 2) : (unsigned)(R * g.lda + C) * 2u;
        static_assert(Epi::PERM, "the converted weights are stored in the PERM row order"); (void)Rb;
        voffB[i] = (unsigned)((((R >> 4) * (g.ldb >> 5) + (C >> 5)) << 10) + (R & 15) * 64 + (C & 31) * 2); }
    const size_t voffA_step = ATILED ? (size_t)4 * (g.lda >> 5) * 1024 : (size_t)64 * g.lda * 2, voffB_step = (size_t)4 * (g.ldb >> 5) * 1024;
    const size_t kstep = (size_t)2048, kstepA = ATILED ? (size_t)2048 : (size_t)(BK * 2);
    const size_t hstepA = ATILED ? (size_t)(HALF / 16) * (g.lda >> 5) * 1024 : (size_t)HALF * g.lda * 2, hstepB = (size_t)(HALF / 16) * (g.ldb >> 5) * 1024;
    const unsigned ldsw = (unsigned)wid * 1024u;
    const int lanep = lds_byte(fr, fq * 8), aoffs = wr * 8192, boffs = wc * 4096;
#define aoff (__extension__({ int o_ = lanep; asm volatile("" : "+v"(o_)); o_ + aoffs; }))
#define boff (__extension__({ int o_ = lanep; asm volatile("" : "+v"(o_)); o_ + boffs; }))
#define PG8_SA(b, h) (((b) * 2 + (h)) * HTB)
#define PG8_SB(b, h) ((4 + (b) * 2 + (h)) * HTB)
#define PG8_STAGE(bufoff, gbase, voff) do { _Pragma("unroll") for (int _i = 0; _i < 2; ++_i) \
        { unsigned vo_ = (voff)[0]; asm volatile("" : "+v"(vo_)); __builtin_amdgcn_global_load_lds((const unsigned*)((const char*)(gbase) + _i * voff##_step + vo_), (LAS unsigned*)(lds + (bufoff) + ldsw + _i * 8192), 16, 0, 0); } } while (0)
#define PG8_LDA(dst, b, h) do { const int aoff_ = aoff; _Pragma("unroll") for (int m = 0; m < 4; ++m) { \
        if constexpr (FP8) { const v4i32 l_ = *(const LAS v4i32*)(lds + PG8_SA(b, h) + aoff_ + m * 2048), h_ = *(const LAS v4i32*)(lds + PG8_SA(b, h) + aoff_ + m * 2048 + 1024); dst##8[m] = __builtin_shufflevector(l_, h_, 0, 1, 2, 3, 4, 5, 6, 7); } \
        else { _Pragma("unroll") for (int k = 0; k < 2; ++k) dst[m][k] = *(const LAS bf16x8*)(lds + PG8_SA(b, h) + aoff_ + m * 2048 + k * 1024); } } } while (0)
#define PG8_LDB(dst, b, h) do { const int boff_ = boff; _Pragma("unroll") for (int n = 0; n < 2; ++n) { \
        if constexpr (FP8) { const v4i32 l_ = *(const LAS v4i32*)(lds + PG8_SB(b, h) + boff_ + n * 2048), h_ = *(const LAS v4i32*)(lds + PG8_SB(b, h) + boff_ + n * 2048 + 1024); dst##8[n] = __builtin_shufflevector(l_, h_, 0, 1, 2, 3, 4, 5, 6, 7); } \
        else { _Pragma("unroll") for (int k = 0; k < 2; ++k) dst[n][k] = *(const LAS bf16x8*)(lds + PG8_SB(b, h) + boff_ + n * 2048 + k * 1024); } } } while (0)
#define PG8_MMA(ai, bj, At, Bt) do { __builtin_amdgcn_s_setprio(1); _Pragma("unroll") for (int m = 0; m < 4; ++m) _Pragma("unroll") for (int n = 0; n < 2; ++n) { \
        if constexpr (FP8) { acc[ai][bj][m][n] = __builtin_amdgcn_mfma_scale_f32_16x16x128_f8f6f4(Bt##8[n], At##8[m], acc[ai][bj][m][n], 0, 0, 0, 0x7f7f7f7f, 0, 0x7f7f7f7f); } \
        else { _Pragma("unroll") for (int k = 0; k < 2; ++k) acc[ai][bj][m][n] = __builtin_amdgcn_mfma_f32_16x16x32_bf16(Bt[n][k], At[m][k], acc[ai][bj][m][n], 0, 0, 0); } } \
        __builtin_amdgcn_s_setprio(0); } while (0)
#define PG8_WAIT_V(n) asm volatile("s_waitcnt vmcnt(" #n ")" ::: "memory")
#define PG8_WAIT_L(n) asm volatile("s_waitcnt lgkmcnt(" #n ")" ::: "memory")
#define PG8_BAR __builtin_amdgcn_s_barrier()
#define PG8_SCHED __builtin_amdgcn_sched_barrier(0)
    Unit cur, nxt; int ui = 0;
    static_assert(Epi::NSTORE == 0 || Epi::NSTORE == 8, "the relaxed waits are written for 8 epilogue stores");
    if (!S.next(0, cur)) { if constexpr (Hook::ON) hook(); return; }
    f32x4 acc[2][2][4][2];
#pragma unroll
    for (int a = 0; a < 2; ++a)
#pragma unroll
        for (int b = 0; b < 2; ++b)
#pragma unroll
            for (int m = 0; m < 4; ++m)
#pragma unroll
                for (int n = 0; n < 2; ++n) acc[a][b][m][n] = (f32x4){0.f, 0.f, 0.f, 0.f};
    bf16x8 At[4][2], B0[2][2], B1[2][2]; v8i32 At8[4], B08[2], B18[2];
    const char* cA = S.a_tile(cur); const char* cB = S.b_tile(cur);
    if constexpr (Epi::PRE) E.pre_dma(cur, 0, wid, lane);
    PG8_STAGE(PG8_SB(0, 0), cB, voffB); PG8_STAGE(PG8_SB(0, 1), cB + hstepB, voffB); PG8_STAGE(PG8_SA(0, 0), cA, voffA); PG8_STAGE(PG8_SA(0, 1), cA + hstepA, voffA);
    if (wr == 1) PG8_BAR;
    PG8_WAIT_V(2); PG8_BAR;
    PG8_STAGE(PG8_SB(1, 0), cB + kstep, voffB); PG8_STAGE(PG8_SA(1, 0), cA + kstepA, voffA); PG8_STAGE(PG8_SB(1, 1), cB + hstepB + kstep, voffB);
    PG8_WAIT_V(6); PG8_BAR;
    if constexpr (Epi::NSTORE == 8) {
        PG8_STAGE(PG8_SA(1, 1), cA + kstepA + hstepA, voffA);
        unsigned* dz = E.dummy() + tid;
#pragma unroll
        for (int i = 0; i < 8; ++i) __builtin_nontemporal_store(0u, dz + i * 512); }
    for (;;) {
        const bool has_next = S.next(ui + 1, nxt);
        const char* nA = has_next ? S.a_tile(nxt) : cA; const char* nB = has_next ? S.b_tile(nxt) : cB;
        int t = 0;
        if constexpr (Epi::NSTORE == 8) {
            const bool last = (t == nt - 2);
            const char* a2 = last ? nA : cA + (size_t)(t + 2) * kstepA; const char* b2 = last ? nB : cB + (size_t)(t + 2) * kstep;
            const char* a3 = a2 + kstepA; const char* b3 = b2 + kstep;
            if constexpr (Epi::PRE) { if (last && has_next) E.pre_dma(nxt, (ui + 1) & 1, wid, lane); }
            PG8_LDB(B0, 0, 0); PG8_LDB(B1, 0, 1); PG8_SCHED; PG8_LDA(At, 0, 0);
            PG8_WAIT_V(16); PG8_WAIT_L(0); PG8_BAR; PG8_MMA(0, 0, At, B0); PG8_MMA(0, 1, At, B1); PG8_BAR; PG8_SCHED;
            PG8_LDA(At, 0, 1); PG8_STAGE(PG8_SB(0, 0), b2, voffB); PG8_STAGE(PG8_SB(0, 1), b2 + hstepB, voffB); PG8_STAGE(PG8_SA(0, 0), a2, voffA);
            PG8_WAIT_V(16); PG8_WAIT_L(0); PG8_BAR; PG8_MMA(1, 0, At, B0); PG8_MMA(1, 1, At, B1); PG8_BAR; PG8_SCHED;
            PG8_LDB(B0, 1, 0); PG8_LDB(B1, 1, 1); PG8_SCHED; PG8_LDA(At, 1, 0); PG8_STAGE(PG8_SA(0, 1), a2 + hstepA, voffA);
            PG8_WAIT_V(16); PG8_WAIT_L(0); PG8_BAR; PG8_MMA(0, 0, At, B0); PG8_MMA(0, 1, At, B1); PG8_BAR; PG8_SCHED;
            PG8_LDA(At, 1, 1); PG8_STAGE(PG8_SB(1, 0), b3, voffB); PG8_STAGE(PG8_SB(1, 1), b3 + hstepB, voffB); PG8_STAGE(PG8_SA(1, 0), a3, voffA);
            PG8_WAIT_V(8); PG8_WAIT_L(0); PG8_BAR; PG8_MMA(1, 0, At, B0); PG8_MMA(1, 1, At, B1); PG8_BAR; PG8_SCHED;
            t = 2; }
        for (; t < nt; t += 2) {
            const bool last = (t == nt - 2);
            const char* a1 = cA + (size_t)(t + 1) * kstepA;
            const char* a2 = last ? nA : cA + (size_t)(t + 2) * kstepA; const char* b2 = last ? nB : cB + (size_t)(t + 2) * kstep;
            const char* a3 = a2 + kstepA; const char* b3 = b2 + kstep;
            if constexpr (Epi::PRE) { if (last && has_next) E.pre_dma(nxt, (ui + 1) & 1, wid, lane); }
            PG8_LDB(B0, 0, 0); PG8_LDB(B1, 0, 1); PG8_SCHED; PG8_LDA(At, 0, 0); PG8_STAGE(PG8_SA(1, 1), a1 + hstepA, voffA);
            PG8_WAIT_V(8); PG8_WAIT_L(0); PG8_BAR; PG8_MMA(0, 0, At, B0); PG8_MMA(0, 1, At, B1); PG8_BAR; PG8_SCHED;
            PG8_LDA(At, 0, 1); PG8_STAGE(PG8_SB(0, 0), b2, voffB); PG8_STAGE(PG8_SB(0, 1), b2 + hstepB, voffB); PG8_STAGE(PG8_SA(0, 0), a2, voffA);
            PG8_WAIT_V(8); PG8_WAIT_L(0); PG8_BAR; PG8_MMA(1, 0, At, B0); PG8_MMA(1, 1, At, B1); PG8_BAR; PG8_SCHED;
            PG8_LDB(B0, 1, 0); PG8_LDB(B1, 1, 1); PG8_SCHED; PG8_LDA(At, 1, 0); PG8_STAGE(PG8_SA(0, 1), a2 + hstepA, voffA);
            PG8_WAIT_V(8); PG8_WAIT_L(0); PG8_BAR; PG8_MMA(0, 0, At, B0); PG8_MMA(0, 1, At, B1); PG8_BAR; PG8_SCHED;
            PG8_LDA(At, 1, 1); PG8_STAGE(PG8_SB(1, 0), b3, voffB); PG8_STAGE(PG8_SB(1, 1), b3 + hstepB, voffB); PG8_STAGE(PG8_SA(1, 0), a3, voffA);
            PG8_WAIT_V(8); PG8_WAIT_L(0); PG8_BAR; PG8_MMA(1, 0, At, B0); PG8_MMA(1, 1, At, B1); PG8_BAR; PG8_SCHED;
        }
        if (wr == 0) PG8_BAR;
        if constexpr (Hook::ON) { if (ui == 0) hook(); }
        if constexpr (Epi::NSTORE == 8) {
            if (has_next) PG8_STAGE(PG8_SA(1, 1), nA + kstepA + hstepA, voffA); }
        { const int tz = opaque_tid(), lz = tz & 63;
          E(acc, cur, wr, wc, lz & 15, lz >> 4, ui & 1); }
        if (!has_next) break;
#pragma unroll
        for (int a = 0; a < 2; ++a)
#pragma unroll
            for (int b = 0; b < 2; ++b)
#pragma unroll
                for (int m = 0; m < 4; ++m)
#pragma unroll
                    for (int n = 0; n < 2; ++n) acc[a][b][m][n] = (f32x4){0.f, 0.f, 0.f, 0.f};
        cur = nxt; cA = nA; cB = nB; ++ui;
        if (wr == 1) PG8_BAR;
    }
    PG8_WAIT_V(0);
    PG8_BAR;
#undef PG8_SA
#undef PG8_SB
#undef PG8_STAGE
#undef PG8_LDA
#undef PG8_LDB
#undef PG8_MMA
#undef PG8_WAIT_V
#undef PG8_WAIT_L
#undef PG8_BAR
#undef PG8_SCHED
#undef aoff
#undef boff
}
}

#define XB_TMO      128
#define XB_XCNT(j)  (256  + 64 * (j))
#define XB_XSUB(j)  (1280 + 64 * (j))
#define XB_XGEN(j)  (2304 + 64 * (j))
#define XB_TOP      3328
#define XB_TOPGEN   3392
#define XCD_BAR_WORDS 3456
#define XB_SPIN_CAP (1u << 22)
__device__ __forceinline__ unsigned xb_ld(unsigned* p)              { return __hip_atomic_load(p, __ATOMIC_RELAXED, __HIP_MEMORY_SCOPE_AGENT); }
__device__ __forceinline__ unsigned xb_add(unsigned* p, unsigned v) { return __hip_atomic_fetch_add(p, v, __ATOMIC_RELAXED, __HIP_MEMORY_SCOPE_AGENT); }
__device__ __forceinline__ unsigned xb_xcc_id() { return (unsigned)__builtin_amdgcn_s_getreg((3 << 11) | 20) & 0xFu; }
#define XB_SPIN(cond, bar) do { unsigned _sp = 0; while (cond) { __builtin_amdgcn_s_sleep(1); \
    if ((++_sp & 255u) == 0u) { if (xb_ld(&(bar)[XB_TMO])) break; if (_sp > XB_SPIN_CAP) { atomicAdd(&(bar)[XB_TMO], 1u); break; } } } } while (0)
struct XcdBarrier { unsigned* bar; unsigned x; volatile LAS unsigned* st; };
__device__ __forceinline__ XcdBarrier xcd_barrier_post(unsigned* bar, volatile LAS unsigned* st) {
    XcdBarrier b; b.bar = bar; b.x = xb_xcc_id(); b.st = st;
    if (threadIdx.x == 0) (void)xb_add(&bar[XB_XCNT(b.x)], 1u);
    return b;
}
__device__ __forceinline__ void xcd_barrier_complete(unsigned* bar, unsigned x, unsigned& nloc, unsigned& nx) {
    const unsigned G = gridDim.x * gridDim.y * gridDim.z;
    unsigned sum, cnt, mine, sp = 0u;
    for (;;) {
        sum = 0u; cnt = 0u; mine = 0u;
#pragma unroll
        for (unsigned j = 0; j < 16; ++j) { const unsigned c = xb_ld(&bar[XB_XCNT(j)]); sum += c; cnt += (c > 0u) ? 1u : 0u; mine = (j == x) ? c : mine; }
        if (sum == G) break;
        __builtin_amdgcn_s_sleep(1);
        if ((++sp & 255u) == 0u) { if (xb_ld(&bar[XB_TMO])) break; if (sp > XB_SPIN_CAP) { atomicAdd(&bar[XB_TMO], 1u); break; } }
    }
    nloc = mine > 0u ? mine : 1u; nx = cnt > 0u ? cnt : 1u;
}
__device__ __forceinline__ void xcd_barrier(const XcdBarrier& b) {
    asm volatile("s_waitcnt vmcnt(0)" ::: "memory");
    __syncthreads();
    if (threadIdx.x == 0) {
        unsigned* bar = b.bar;
        __builtin_amdgcn_s_waitcnt(0);
        unsigned nloc = b.st[0], nx = b.st[1];
        if (nloc == 0u) { xcd_barrier_complete(bar, b.x, nloc, nx); b.st[0] = nloc; b.st[1] = nx; }
        const unsigned old = xb_add(&bar[XB_XSUB(b.x)], 1u);
        const unsigned gen = old / nloc;
        if (old + 1u == (gen + 1u) * nloc) {
            __builtin_amdgcn_fence(__ATOMIC_RELEASE, "agent");
            asm volatile("s_waitcnt vmcnt(0)" ::: "memory");
            const unsigned og = xb_add(&bar[XB_TOP], 1u);
            const unsigned tg = og / nx;
            if (og + 1u == (tg + 1u) * nx) xb_add(&bar[XB_TOPGEN], 1u);
            else XB_SPIN(xb_ld(&bar[XB_TOPGEN]) == tg, bar);
            __builtin_amdgcn_fence(__ATOMIC_ACQUIRE, "agent");
            xb_add(&bar[XB_XGEN(b.x)], 1u);
            asm volatile("s_waitcnt vmcnt(0)" ::: "memory");
        } else {
            XB_SPIN((int)(xb_ld(&bar[XB_XGEN(b.x)]) - (gen + 1u)) < 0, bar);
            __builtin_amdgcn_fence(__ATOMIC_ACQUIRE, "agent");
            asm volatile("s_waitcnt vmcnt(0)" ::: "memory");
        }
    }
    __syncthreads();
}
__device__ __forceinline__ void xcd_arrive(const XcdBarrier& b) {
    asm volatile("s_waitcnt vmcnt(0)" ::: "memory");
    __syncthreads();
    if (threadIdx.x == 0) {
        unsigned* bar = b.bar;
        __builtin_amdgcn_s_waitcnt(0);
        unsigned nloc = b.st[0], nx = b.st[1];
        if (nloc == 0u) { xcd_barrier_complete(bar, b.x, nloc, nx); b.st[0] = nloc; b.st[1] = nx; }
        const unsigned old = xb_add(&bar[XB_XSUB(b.x)], 1u);
        const unsigned gen = old / nloc;
        unsigned leader = 0u;
        if (old + 1u == (gen + 1u) * nloc) {
            leader = 1u;
            __builtin_amdgcn_fence(__ATOMIC_RELEASE, "agent");
            asm volatile("s_waitcnt vmcnt(0)" ::: "memory");
            const unsigned og = xb_add(&bar[XB_TOP], 1u);
            const unsigned tg = og / nx;
            if (og + 1u == (tg + 1u) * nx) xb_add(&bar[XB_TOPGEN], 1u);
        }
        b.st[2] = gen; b.st[3] = leader;
    }
}
__device__ __forceinline__ void xcd_wait_arrived(const XcdBarrier& b) {
    if (threadIdx.x == 0) {
        unsigned* bar = b.bar; const unsigned gen = b.st[2], leader = b.st[3];
        XB_SPIN((int)(xb_ld(&bar[XB_TOPGEN]) - (gen + 1u)) < 0, bar);
        __builtin_amdgcn_fence(__ATOMIC_ACQUIRE, "agent");
        if (leader) xb_add(&bar[XB_XGEN(b.x)], 1u);
        asm volatile("s_waitcnt vmcnt(0)" ::: "memory");
    }
    __syncthreads();
}

constexpr size_t CTL_GRP = 32 * 1024, CTL_XMASK = 36 * 1024;
__device__ __forceinline__ void group_barrier(const XcdBarrier& b, int cid) {
    asm volatile("s_waitcnt vmcnt(0)" ::: "memory");
    __syncthreads();
    if (threadIdx.x == 0) {
        unsigned* bar = b.bar; const unsigned* xm = bar + CTL_XMASK / 4; unsigned ok = (gridDim.x == 256u) ? 1u : 0u;
#pragma unroll
        for (int j = 0; j < 8; ++j) { const unsigned mk = xb_ld((unsigned*)&xm[j]); ok &= (mk != 0u && (mk & (mk - 1u)) == 0u) ? 1u : 0u; }
        b.st[4] = ok;
        if (ok) {
            unsigned* cnt = bar + CTL_GRP / 4 + (cid & 7) * 64;
            __builtin_amdgcn_s_waitcnt(0);
            const unsigned old = xb_add(cnt, 1u), target = (old / 32u + 1u) * 32u;
            XB_SPIN((int)(xb_ld(cnt) - target) < 0, bar);
            __builtin_amdgcn_fence(__ATOMIC_ACQUIRE, "agent");
            asm volatile("s_waitcnt vmcnt(0)" ::: "memory");
        }
    }
    __syncthreads();
    if (!b.st[4]) xcd_barrier(b);
}
struct WaitHook { static constexpr bool ON = true; bool on; unsigned* bar; volatile LAS unsigned* st;
    __device__ __forceinline__ void operator()() const { if (on) { XcdBarrier bw; bw.bar = bar; bw.x = xb_xcc_id(); bw.st = st; xcd_wait_arrived(bw); } } };

constexpr int NWAVES = 8, NTHREADS = 512;
constexpr int RING_BYTES = 131072, MISC_OFF = RING_BYTES, LDS_BYTES = 163840;
constexpr int LX_P = 1024, LX_SQ = 5120, LX_GAIN = 13312, LX_POS = 16384;

struct Args { const float* in[22]; float* out; unsigned char* ws; int ph_lo, ph_hi; };
enum { I_X = 0, I_RELB, I_NMIX, I_NFFN, I_POOLW, I_POOLS, I_NKV, I_WKV, I_GK, I_CPOS, I_CW1, I_CW2, I_WQG, I_GQ, I_WO, I_FWG, I_FWU, I_FWD, I_ROUTER, I_MWG, I_MWU, I_MWD };

__device__ __forceinline__ void cvt_item(const float* src, int ld, int nvalid, const float* rowgain, const float* colscale, bf16_t* dst, int K, int k0, LAS float* scr, int lane, bool f8 = false) {
    { const int q = lane & 7, r = lane >> 3;
      f32x4 v[8];
#pragma unroll
      for (int i = 0; i < 8; ++i) { const int kk = 8 * i + r; v[i] = (f32x4){0.f, 0.f, 0.f, 0.f};
          if (4 * q < nvalid) { v[i] = *(const f32x4*)(src + (size_t)(k0 + kk) * ld + 4 * q); if (rowgain) v[i] *= rowgain[k0 + kk]; } }
#pragma unroll
      for (int i = 0; i < 8; ++i) { LAS float* d = scr + (8 * i + r) * 33 + 4 * q; d[0] = v[i].x; d[1] = v[i].y; d[2] = v[i].z; d[3] = v[i].w; } }
    asm volatile("s_waitcnt lgkmcnt(0)" ::: "memory");
    const int c = lane & 7;
#pragma unroll
    for (int j = 0; j < 4; ++j) { const int n = (lane >> 3) + 8 * j; const LAS float* s = scr + (8 * c) * 33 + n;
        const float cs = (colscale && n < nvalid) ? colscale[n] : 1.f;
        u32x4 o; o.x = pk2(s[0 * 33] * cs, s[1 * 33] * cs); o.y = pk2(s[2 * 33] * cs, s[3 * 33] * cs); o.z = pk2(s[4 * 33] * cs, s[5 * 33] * cs); o.w = pk2(s[6 * 33] * cs, s[7 * 33] * cs);
        const int np = 16 * ((n >> 2) & 1) + (((n >> 3) << 2) | (n & 3)), kc = k0 + 8 * c;
        if (!f8) *(u32x4*)((char*)dst + ((size_t)((np >> 4) * (K >> 5) + (kc >> 5)) << 10) + (np & 15) * 64 + (kc & 31) * 2) = o;
        else { const float ws = cs * pg8::F8_WS;
            int lo = __builtin_amdgcn_cvt_pk_fp8_f32(s[0 * 33] * ws, s[1 * 33] * ws, 0, false); lo = __builtin_amdgcn_cvt_pk_fp8_f32(s[2 * 33] * ws, s[3 * 33] * ws, lo, true);
            int hi = __builtin_amdgcn_cvt_pk_fp8_f32(s[4 * 33] * ws, s[5 * 33] * ws, 0, false); hi = __builtin_amdgcn_cvt_pk_fp8_f32(s[6 * 33] * ws, s[7 * 33] * ws, hi, true);
            *(u32x2*)((char*)dst + ((size_t)((np >> 4) * (K >> 6) + (kc >> 6)) << 10) + (np & 15) * 64 + (kc & 63)) = (u32x2){(unsigned)lo, (unsigned)hi}; } }
    asm volatile("s_waitcnt lgkmcnt(0)" ::: "memory");
}
__device__ __forceinline__ void cvt_plain(const float* src, int K, int N, const float* rowgain, const float* colscale, bf16_t* dst, int item, LAS float* scr, int lane, bool f8 = false) {
    const int nblk = N / 32, kb = item / nblk, nb = item % nblk;
    cvt_item(src + nb * 32, N, 32, rowgain, colscale ? colscale + nb * 32 : nullptr, f8 ? (bf16_t*)((char*)dst + (size_t)nb * 32 * K) : dst + (size_t)nb * 32 * K, K, kb * 64, scr, lane, f8);
}
__device__ __forceinline__ void cvt_gu(const float* wg, const float* wu, const float* rowgain, bf16_t* dst, int item, LAS float* scr, int lane, bool f8 = false) {
    constexpr int nblk = 7168 / 32; const int kb = item / nblk, nb = item % nblk, np = nb * 32, p = np >> 8, b = (np >> 7) & 1, j0 = np & 127;
    cvt_item((b ? wu : wg) + p * 128 + j0, FFD, 32, rowgain, nullptr, f8 ? (bf16_t*)((char*)dst + (size_t)np * DM) : dst + (size_t)np * DM, DM, kb * 64, scr, lane, f8);
}
__device__ __forceinline__ void cvt_qg(const float* w, const float* rowgain, bf16_t* dst, int item, LAS float* scr, int lane) {
    constexpr int nblk = 1280 / 32; const int kb = item / nblk, nb = item % nblk, np = nb * 32;
    int nvalid = 1072 - np; nvalid = nvalid < 0 ? 0 : (nvalid > 32 ? 32 : nvalid);
    cvt_item(w + np, 1072, nvalid, rowgain, nullptr, dst + (size_t)np * DM, DM, kb * 64, scr, lane);
}
__device__ __forceinline__ void cvt_headperm(const float* w, int ld, int ncols, const float* rowgain, bf16_t* dst, int K, int nblk, int item, LAS float* scr, int lane) {
    const int kb = item / nblk, nb = item % nblk, np = nb * 32, tile = np >> 8, bj = (np >> 7) & 1, wc = (np >> 5) & 3, o = tile * 256 + 64 * wc + 32 * bj;
    int nvalid = ncols - o; nvalid = nvalid < 0 ? 0 : (nvalid > 32 ? 32 : nvalid);
    cvt_item(w + o, ld, nvalid, rowgain, nullptr, dst + (size_t)np * K, K, kb * 64, scr, lane);
}
constexpr int IT_POOL = 8 * 32, IT_GU = 16 * 224, IT_D = 56 * 32, IT_KV = 16 * 48, IT_QG = 16 * 40, IT_O = 16 * 32, IT_C1 = 32 * 8;
constexpr int IT_C2 = 4 * 8;
constexpr int IT_STATIC = IT_POOL + 2 * IT_GU + 2 * IT_D + IT_KV + 2 * IT_QG + 2 * IT_O + 2 * IT_C1 + 2 * IT_C2;
__device__ __forceinline__ void p_convert_static(const Args& a, LAS unsigned char* lds) {
    const int tz = opaque_tid(), lane = tz & 63, wave = tz >> 6;
    LAS float* scr = (LAS float*)(lds + wave * 16384);
    unsigned char* ws = a.ws;
    for (int it = blockIdx.x * NWAVES + wave; it < IT_STATIC; it += gridDim.x * NWAVES) {
        int r = it;
        if (r < IT_POOL) { const int mg = r / 32, L = mg >> 2, g = mg & 3;
            cvt_plain(a.in[I_POOLW] + (size_t)mg * 65536, 256, 256, a.in[I_NMIX] + L * DM + g * 256, a.in[I_POOLS] + L * DM + g * 256, (bf16_t*)(ws + W_POOL) + (size_t)mg * 65536, r % 32, scr, lane); continue; } r -= IT_POOL;
        if (r < 2 * IT_GU) { const int i = r / IT_GU;
            cvt_gu(a.in[I_FWG] + (size_t)i * DM * FFD, a.in[I_FWU] + (size_t)i * DM * FFD, a.in[I_NFFN] + (2 * i) * DM, (bf16_t*)(ws + W_GU) + (size_t)i * 7168 * DM, r % IT_GU, scr, lane); continue; } r -= 2 * IT_GU;
        if (r < 2 * IT_D) { const int i = r / IT_D;
            cvt_plain(a.in[I_FWD] + (size_t)i * FFD * DM, FFD, DM, nullptr, nullptr, (bf16_t*)(ws + W_D + (size_t)i * DM * FFD), r % IT_D, scr, lane, true); continue; } r -= 2 * IT_D;
        if (r < IT_KV) { cvt_headperm(a.in[I_WKV], 1536, 1536, a.in[I_NKV], (bf16_t*)(ws + W_KV), DM, 48, r, scr, lane); continue; } r -= IT_KV;
        if (r < 2 * IT_QG) { const int j = r / IT_QG;
            cvt_headperm(a.in[I_WQG] + (size_t)j * DM * 1072, 1072, 1072, a.in[I_NMIX] + (2 + j) * DM, (bf16_t*)(ws + W_QG) + (size_t)j * 1280 * DM, DM, 40, r % IT_QG, scr, lane); continue; } r -= 2 * IT_QG;
        if (r < 2 * IT_O) { const int j = r / IT_O;
            cvt_plain(a.in[I_WO] + (size_t)j * DM * DM, DM, DM, nullptr, nullptr, (bf16_t*)(ws + W_O) + (size_t)j * DM * DM, r % IT_O, scr, lane); continue; } r -= 2 * IT_O;
        if (r < 2 * IT_C1) { const int w = r / IT_C1;
            cvt_plain(a.in[I_CW1] + (size_t)w * 2048 * 256, 2048, 256, nullptr, nullptr, (bf16_t*)(ws + W_C1) + (size_t)w * 256 * 2048, r % IT_C1, scr, lane); continue; } r -= 2 * IT_C1;
        { const int w = r / IT_C2;
            cvt_headperm(a.in[I_CW2] + (size_t)w * 256 * 64, 64, 64, nullptr, (bf16_t*)(ws + W_C2) + (size_t)w * 256 * 256, 256, 8, r % IT_C2, scr, lane); }
    }
}
__device__ __forceinline__ void p_convert_moe(const Args& a, LAS unsigned char* lds, int l) {
    const int tz = opaque_tid(), lane = tz & 63, wave = tz >> 6;
    LAS float* scr = (LAS float*)(lds + wave * 16384);
    unsigned char* ws = a.ws;
    const float* gain = a.in[I_NFFN] + (2 * l + 1) * DM;
    constexpr int NIT = 8 * (IT_GU + IT_D);
    for (int it = blockIdx.x * NWAVES + wave; it < NIT; it += gridDim.x * NWAVES) {
        if (it < 8 * IT_GU) { const int e = it / IT_GU; const size_t wo = ((size_t)l * 8 + e) * DM * FFD;
            cvt_gu(a.in[I_MWG] + wo, a.in[I_MWU] + wo, gain, (bf16_t*)(ws + WS_WMOE + (size_t)e * 7168 * DM), it % IT_GU, scr, lane, true); }
        else { const int r = it - 8 * IT_GU, e = r / IT_D; const size_t wo = ((size_t)l * 8 + e) * FFD * DM;
            cvt_plain(a.in[I_MWD] + wo, FFD, DM, nullptr, nullptr, (bf16_t*)(ws + WMOE_D + (size_t)e * DM * FFD), r % IT_D, scr, lane, true); }
    }
}

__device__ __forceinline__ float row_load_rstd(const float* xrow, int lane, f32x4 (&v)[4]) {
    const f32x4* xr = (const f32x4*)xrow + lane; float s = 0.f;
#pragma unroll
    for (int j = 0; j < 4; ++j) { v[j] = xr[64 * j]; s += (v[j].x * v[j].x + v[j].y * v[j].y) + (v[j].z * v[j].z + v[j].w * v[j].w); }
    return 1.0f / sqrtf(wave_sum(s) * (1.f / DM) + EPS);
}
__device__ __forceinline__ void row_store_bf16(bf16_t* orow, int lane, const f32x4 (&v)[4], float sc) {
    unsigned long long* o8 = (unsigned long long*)orow + lane;
#pragma unroll
    for (int j = 0; j < 4; ++j) o8[64 * j] = (unsigned long long)pk2(v[j].x * sc, v[j].y * sc) | ((unsigned long long)pk2(v[j].z * sc, v[j].w * sc) << 32);
}
__device__ __forceinline__ void row_load8(const bf16_t* xrow, int lane, f32x4 (&v)[4]) {
#pragma unroll
    for (int j = 0; j < 2; ++j) ld8(xrow + 8 * lane + 512 * j, v[2 * j], v[2 * j + 1]);
}
__device__ __forceinline__ void row_store8(bf16_t* orow, int lane, const f32x4 (&v)[4], float sc) {
#pragma unroll
    for (int j = 0; j < 2; ++j) { u32x4 o; o.x = pk2(v[2 * j].x * sc, v[2 * j].y * sc); o.y = pk2(v[2 * j].z * sc, v[2 * j].w * sc); o.z = pk2(v[2 * j + 1].x * sc, v[2 * j + 1].y * sc); o.w = pk2(v[2 * j + 1].z * sc, v[2 * j + 1].w * sc);
        *(u32x4*)(orow + 8 * lane + 512 * j) = o; }
}
__device__ __forceinline__ void row_store_f8(unsigned char* orow, int lane, const f32x4 (&v)[4], float sc) {
#pragma unroll
    for (int j = 0; j < 2; ++j) { int lo = __builtin_amdgcn_cvt_pk_fp8_f32(v[2 * j].x * sc, v[2 * j].y * sc, 0, false); lo = __builtin_amdgcn_cvt_pk_fp8_f32(v[2 * j].z * sc, v[2 * j].w * sc, lo, true);
        int hi = __builtin_amdgcn_cvt_pk_fp8_f32(v[2 * j + 1].x * sc, v[2 * j + 1].y * sc, 0, false); hi = __builtin_amdgcn_cvt_pk_fp8_f32(v[2 * j + 1].z * sc, v[2 * j + 1].w * sc, hi, true);
        *(u32x2*)(orow + 8 * lane + 512 * j) = (u32x2){(unsigned)lo, (unsigned)hi}; }
}
__device__ __forceinline__ void p_norm(const float* x, bf16_t* XN) {
    const int tz = opaque_tid(), lane = tz & 63, gw = blockIdx.x * NWAVES + (tz >> 6), NGW = gridDim.x * NWAVES;
    for (int m = gw; m < NTOK; m += NGW) { f32x4 v[4]; const float r = row_load_rstd(x + (size_t)m * DM, lane, v); row_store_bf16(XN + (size_t)m * DM, lane, v, r); }
}
template <typename TX> __device__ __forceinline__ void p_pool_diff(const TX* x, const float* SSQ  , bf16_t* DIFF, LAS unsigned char* lds) {
    LAS float* rs = (LAS float*)lds;
    const int tid = opaque_tid(), lane = tid & 63, wave = tid >> 6;
    for (int tile = blockIdx.x; tile < NTOK / 128; tile += gridDim.x) {
        const int b = tile >> 4, t0 = (tile & 15) * 128; const TX* xb = x + (size_t)b * SEQ * DM;
        if (SSQ) { if (tid < 143) { const int t = t0 - 15 + tid; if (t >= 0) { const f32x4 p = *(const f32x4*)(SSQ + ((size_t)b * SEQ + t) * 4); rs[tid] = 1.0f / sqrtf(((p.x + p.y) + (p.z + p.w)) * (1.f / DM) + EPS); } } }
        else for (int i = wave; i < 143; i += NWAVES) { const int t = t0 - 15 + i; if (t >= 0) { float sq = 0.f;
#pragma unroll
                for (int j = 0; j < 4; ++j) { const f32x4 v = ld4(xb + (size_t)t * DM + 4 * lane + 256 * j); sq += (v.x * v.x + v.y * v.y) + (v.z * v.z + v.w * v.w); }
                const float r = 1.0f / sqrtf(wave_sum(sq) * (1.f / DM) + EPS); if (lane == 0) rs[i] = r; } }
        __syncthreads();
        const int q = tid >> 7, cq = tid & 127, g = cq >> 5, w = 2 << g, ts = t0 + 32 * q;
        const TX* xc = xb + 8 * cq;
        f32x4 sa = (f32x4){0.f, 0.f, 0.f, 0.f}, sb = sa;
        { f32x4 wa[15], wb[15];
#pragma unroll
          for (int i = 1; i < 16; ++i) { const int ii = i < w ? i : w - 1; int t = ts - ii; t = t < 0 ? 0 : t; ld8(xc + (size_t)t * DM, wa[i - 1], wb[i - 1]); }
#pragma unroll
          for (int i = 1; i < 16; ++i) { const int t = ts - i; const float r = (i < w && t >= 0) ? rs[t - t0 + 15] : 0.f; sa += wa[i - 1] * r; sb += wb[i - 1] * r; } }
        for (int tt0 = 0; tt0 < 32; tt0 += 4) {
            f32x4 na[4], nb[4], oa[4], ob[4];
#pragma unroll
            for (int j = 0; j < 4; ++j) { const int t = ts + tt0 + j; ld8(xc + (size_t)t * DM, na[j], nb[j]); int told = t + 1 - w; told = told < 0 ? 0 : told; ld8(xc + (size_t)told * DM, oa[j], ob[j]); }
#pragma unroll
            for (int j = 0; j < 4; ++j) { const int t = ts + tt0 + j;
                f32x4 ha = na[j], hb = nb[j]; { const float r = rs[t - t0 + 15]; ha *= r; hb *= r; }
                sa += ha; sb += hb;
                const int cnt = (t + 1 < w) ? (t + 1) : w; const float ic = __builtin_amdgcn_rcpf((float)cnt);
                const f32x4 da = sa * ic - ha, db = sb * ic - hb;
                u32x4 o; o.x = pk2(da.x, da.y); o.y = pk2(da.z, da.w); o.z = pk2(db.x, db.y); o.w = pk2(db.z, db.w);
                *(u32x4*)(DIFF + ((size_t)b * SEQ + t) * DM + 8 * cq) = o;
                const int told = t + 1 - w; const float ro = (told >= 0) ? rs[told - t0 + 15] : 0.f; sa -= oa[j] * ro; sb -= ob[j] * ro; } }
        __syncthreads();
    }
}
__device__ __forceinline__ void p_router_a(const Args& a, const bf16_t* x, int l, LAS unsigned char* lds) {
    LAS float* grT = (LAS float*)lds;
    LAS int* cnt = (LAS int*)(lds + 32768);
    const int tid = opaque_tid(), lane = tid & 63, wave = tid >> 6;
    const float* gain = a.in[I_NFFN] + (2 * l + 1) * DM; const float* router = a.in[I_ROUTER] + (size_t)l * DM * NEXP;
    for (int i = tid; i < DM * NEXP; i += NTHREADS) { const int k = i >> 3, e = i & 7; grT[e * DM + k] = gain[k] * router[i]; }
    int* RE = (int*)(a.ws + MS_RE); f32x2* RG = (f32x2*)(a.ws + MS_RG); float* RSTD = (float*)(a.ws + MS_RSTD); int* CNT = (int*)(a.ws + CTL_CNT);
    for (int tb = blockIdx.x; tb < NTOK / 256; tb += gridDim.x) {
        if (tid < 8) cnt[tid] = 0;
        __syncthreads();
        for (int i0 = wave * 4; i0 < 256; i0 += NWAVES * 4) {
            f32x4 v4[4][4];
#pragma unroll
            for (int q = 0; q < 4; ++q) row_load8(x + (size_t)(tb * 256 + i0 + q) * DM, lane, v4[q]);
#pragma unroll
            for (int q = 0; q < 4; ++q) { const int tok = tb * 256 + i0 + q;
                float ssq = 0.f;
#pragma unroll
                for (int j = 0; j < 4; ++j) ssq += (v4[q][j].x * v4[q][j].x + v4[q][j].y * v4[q][j].y) + (v4[q][j].z * v4[q][j].z + v4[q][j].w * v4[q][j].w);
                const float r = 1.0f / sqrtf(wave_sum(ssq) * (1.f / DM) + EPS);
                float lg[8];
#pragma unroll
                for (int e = 0; e < 8; ++e) { float sd = 0.f;
#pragma unroll
                    for (int j = 0; j < 4; ++j) { const f32x4 w = *(const LAS f32x4*)(grT + e * DM + 512 * (j >> 1) + 8 * lane + 4 * (j & 1)); sd += (v4[q][j].x * w.x + v4[q][j].y * w.y) + (v4[q][j].z * w.z + v4[q][j].w * w.w); }
                    lg[e] = wave_sum(sd) * r; }
                int e0 = 0; float l0 = lg[0];
#pragma unroll
                for (int e = 1; e < 8; ++e) if (lg[e] > l0) { l0 = lg[e]; e0 = e; }
                int e1 = -1; float l1 = 0.f;
#pragma unroll
                for (int e = 0; e < 8; ++e) if (e != e0 && (e1 < 0 || lg[e] > l1)) { l1 = lg[e]; e1 = e; }
                if (lane == 0) { const float g1 = 1.f / (1.f + expf(l0 - l1)), g0 = 1.f - g1;
                    RE[tok] = e0 | (e1 << 8); RG[tok] = (f32x2){g0, g1}; RSTD[tok] = r; __hip_atomic_fetch_add(&cnt[e0], 1, __ATOMIC_RELAXED, __HIP_MEMORY_SCOPE_WORKGROUP); __hip_atomic_fetch_add(&cnt[e1], 1, __ATOMIC_RELAXED, __HIP_MEMORY_SCOPE_WORKGROUP); } } }
        __syncthreads();
        if (tid < 8) CNT[tb * 8 + tid] = cnt[tid];
        __syncthreads();
    }
}
__device__ __forceinline__ void p_router_b(const Args& a, const bf16_t* x, LAS unsigned char* lds) {
    LAS int* cn = (LAS int*)lds;
    LAS int* tot = cn + 2048; LAS int* bef = tot + 8; LAS int* seg = bef + 8; LAS int* wtot = seg + 16;
    LAS int* slot = wtot + 32;
    const int tid = opaque_tid(), lane = tid & 63, wave = tid >> 6;
    const int* RE = (const int*)(a.ws + MS_RE); const float* RSTD = (const float*)(a.ws + MS_RSTD); const int* CNT = (const int*)(a.ws + CTL_CNT);
    int* SLOT = (int*)(a.ws + MS_SLOT); int* TILE_E = (int*)(a.ws + CTL_TILEE); int* NT = (int*)(a.ws + CTL_NT);
    unsigned char* XS8 = a.ws + WS_A + 128 * MiB;
    for (int tb = blockIdx.x; tb < NTOK / 256; tb += gridDim.x) {
        { const int4 c4 = *(const int4*)(CNT + tid * 4); cn[tid * 4] = c4.x; cn[tid * 4 + 1] = c4.y; cn[tid * 4 + 2] = c4.z; cn[tid * 4 + 3] = c4.w; }
        __syncthreads();
        if (tid < 8) { int t = 0, bf = 0; for (int b = 0; b < 256; ++b) { const int c = cn[b * 8 + tid]; t += c; if (b < tb) bf += c; } tot[tid] = t; bef[tid] = bf; }
        __syncthreads();
        if (tid == 0) { int s = 0; for (int e = 0; e < 8; ++e) { seg[e] = s; s += ((tot[e] + 255) >> 8) << 8; } seg[8] = s; if (tb == 0) *NT = s >> 8; }
        int e0 = 0, e1 = 0, r0 = 0, r1 = 0;
        if (tid < 256) { const int re = RE[tb * 256 + tid]; e0 = re & 255; e1 = re >> 8;
#pragma unroll
            for (int e = 0; e < 8; ++e) { const bool f = (e0 == e) || (e1 == e); const unsigned long long mk = __ballot(f);
                const int r = __popcll(mk & ((1ull << lane) - 1ull)); if (lane == 0) wtot[wave * 8 + e] = __popcll(mk); if (e == e0) r0 = r; if (e == e1) r1 = r; } }
        __syncthreads();
        if (tb == 0) { const int ntl = seg[8] >> 8;
            for (int t = tid; t < ntl; t += NTHREADS) { int e = 0;
#pragma unroll
                for (int q = 1; q < 8; ++q) e = (seg[q] <= (t << 8)) ? q : e;
                TILE_E[t] = e; } }
        if (tid < 256) { int o0 = 0, o1 = 0; for (int w = 0; w < wave; ++w) { o0 += wtot[w * 8 + e0]; o1 += wtot[w * 8 + e1]; }
            const int p0 = seg[e0] + bef[e0] + o0 + r0, p1 = seg[e1] + bef[e1] + o1 + r1;
            slot[tid * 2] = p0; slot[tid * 2 + 1] = p1; *(int2*)(SLOT + (size_t)(tb * 256 + tid) * 2) = make_int2(p0, p1); }
        __syncthreads();
        for (int i0 = wave * 4; i0 < 256; i0 += NWAVES * 4) {
            f32x4 v4[4][4]; float r4[4];
#pragma unroll
            for (int q = 0; q < 4; ++q) { const int tok = tb * 256 + i0 + q; r4[q] = RSTD[tok]; row_load8(x + (size_t)tok * DM, lane, v4[q]); }
#pragma unroll
            for (int q = 0; q < 4; ++q) { row_store_f8(XS8 + (size_t)slot[(i0 + q) * 2] * DM, lane, v4[q], r4[q] * pg8::F8_XS); row_store_f8(XS8 + (size_t)slot[(i0 + q) * 2 + 1] * DM, lane, v4[q], r4[q] * pg8::F8_XS); } }
        __syncthreads();
    }
}
template <bool FINAL> __device__ __forceinline__ void p_moe_combine(const Args& a, bf16_t* XB, float* SSQ, float* out) {
    const int tz = opaque_tid(), lane = tz & 63, gw = blockIdx.x * NWAVES + (tz >> 6), NGW = gridDim.x * NWAVES;
    const f32x2* RG = (const f32x2*)(a.ws + MS_RG); const int* SLOT = (const int*)(a.ws + MS_SLOT); const bf16_t* YS = (const bf16_t*)(a.ws + WS_A);
    const bf16_t* YSP = (const bf16_t*)(a.ws + WS_QGRAW);
    constexpr int XROW0 = 1 << 30;
    for (int m0 = gw * 2; m0 < NTOK; m0 += NGW * 2) {
        f32x2 g2[2]; int2 sl2[2];
#pragma unroll
        for (int q = 0; q < 2; ++q) { g2[q] = RG[m0 + q]; sl2[q] = *(const int2*)(SLOT + (size_t)(m0 + q) * 2); }
        u32x4 xv[2][2], ya[2][2], yb[2][2];
#pragma unroll
        for (int q = 0; q < 2; ++q) { const u32x4* xr = (const u32x4*)(XB + (size_t)(m0 + q) * DM) + lane;
            const u32x4* y0 = (const u32x4*)(YS + (size_t)(sl2[q].x < XROW0 ? sl2[q].x : 0) * DM) + lane; const u32x4* y1 = (const u32x4*)(YS + (size_t)(sl2[q].y < XROW0 ? sl2[q].y : 0) * DM) + lane;
#pragma unroll
            for (int j = 0; j < 2; ++j) { xv[q][j] = xr[64 * j]; ya[q][j] = y0[64 * j]; yb[q][j] = y1[64 * j]; } }
#pragma unroll
        for (int q = 0; q < 2; ++q) { const int m = m0 + q; const f32x2 g = g2[q];
            u32x4* xb = (u32x4*)(XB + (size_t)m * DM) + lane; f32x4* orow = (f32x4*)(out + (size_t)m * DM) + 2 * lane; float ss = 0.f;
            const int s0 = __builtin_amdgcn_readfirstlane(sl2[q].x), s1 = __builtin_amdgcn_readfirstlane(sl2[q].y);
#pragma unroll
            for (int j = 0; j < 2; ++j) { const u32x4 x0 = xv[q][j];
                f32x4 a0l, a0h, a1l, a1h;
                { const u32x4 w = ya[q][j]; a0l = (f32x4){bflo(w.x), bfhi(w.x), bflo(w.y), bfhi(w.y)}; a0h = (f32x4){bflo(w.z), bfhi(w.z), bflo(w.w), bfhi(w.w)}; }
                { const u32x4 w = yb[q][j]; a1l = (f32x4){bflo(w.x), bfhi(w.x), bflo(w.y), bfhi(w.y)}; a1h = (f32x4){bflo(w.z), bfhi(w.z), bflo(w.w), bfhi(w.w)}; }
                if (s0 >= XROW0) { a0l = (f32x4){0.f, 0.f, 0.f, 0.f}; a0h = a0l;
                    for (int ks = 0; ks < pg8::XSPLIT; ++ks) { f32x4 pl, ph; ld8(YSP + ((size_t)ks * pg8::XROWS + (s0 - XROW0)) * DM + 8 * lane + 512 * j, pl, ph); a0l += pl; a0h += ph; } }
                if (s1 >= XROW0) { a1l = (f32x4){0.f, 0.f, 0.f, 0.f}; a1h = a1l;
                    for (int ks = 0; ks < pg8::XSPLIT; ++ks) { f32x4 pl, ph; ld8(YSP + ((size_t)ks * pg8::XROWS + (s1 - XROW0)) * DM + 8 * lane + 512 * j, pl, ph); a1l += pl; a1h += ph; } }
                const f32x4 xl = (f32x4){bflo(x0.x), bfhi(x0.x), bflo(x0.y), bfhi(x0.y)}, xh = (f32x4){bflo(x0.z), bfhi(x0.z), bflo(x0.w), bfhi(x0.w)};
                const f32x4 v = xl + g.x * a0l + g.y * a1l, u = xh + g.x * a0h + g.y * a1h;
                if (FINAL) { orow[128 * j] = v; orow[128 * j + 1] = u; }
                else { u32x4 w; w.x = pk2(v.x, v.y); w.y = pk2(v.z, v.w); w.z = pk2(u.x, u.y); w.w = pk2(u.z, u.w); xb[64 * j] = w;
                    ss += ((v.x * v.x + v.y * v.y) + (v.z * v.z + v.w * v.w)) + ((u.x * u.x + u.y * u.y) + (u.z * u.z + u.w * u.w)); } }
            if (!FINAL) { ss = wave_sum(ss); if (lane == 0) *(f32x4*)(SSQ + (size_t)m * 4) = (f32x4){ss, 0.f, 0.f, 0.f}; } } }
}

__device__ __forceinline__ void headnorm_inplace(bf16_t* buf, int ld, int col0, int nheads, const float* gain, float scale) {
    const int tz = opaque_tid(), gl = (blockIdx.x * NTHREADS + tz) >> 3, NG = (gridDim.x * NTHREADS) >> 3, sub = tz & 7;
    f32x4 ga = *(const f32x4*)(gain + sub * 8), gb = *(const f32x4*)(gain + sub * 8 + 4);
    const long total = (long)NTOK * nheads;
    for (long it = gl; it < total; it += NG) { const int tok = (int)(it / nheads), h = (int)(it % nheads);
        u32x4* p = (u32x4*)(buf + (size_t)tok * ld + col0 + h * 64 + sub * 8); const u32x4 w = *p;
        float v[8] = {bflo(w.x), bfhi(w.x), bflo(w.y), bfhi(w.y), bflo(w.z), bfhi(w.z), bflo(w.w), bfhi(w.w)};
        float s = 0.f;
#pragma unroll
        for (int j = 0; j < 8; ++j) s += v[j] * v[j];
        s += __shfl_xor(s, 1); s += __shfl_xor(s, 2); s += __shfl_xor(s, 4);
        const float r = scale / sqrtf(s * (1.f / 64.f) + EPS);
        u32x4 o; o.x = pk2(v[0] * r * ga.x, v[1] * r * ga.y); o.y = pk2(v[2] * r * ga.z, v[3] * r * ga.w); o.z = pk2(v[4] * r * gb.x, v[5] * r * gb.y); o.w = pk2(v[6] * r * gb.z, v[7] * r * gb.w);
        *p = o; }
}
__device__ __forceinline__ void p_cmp_gather(const Args& a) {
    const bf16_t* KV = (const bf16_t*)(a.ws + WS_KVRAW); bf16_t* BLK = (bf16_t*)(a.ws + WS_BLK); const float* pos = a.in[I_CPOS];
    const long total = (long)2 * 16256 * 256;
    const int tz = opaque_tid();
    for (long it = (long)blockIdx.x * NTHREADS + tz; it < total; it += (long)gridDim.x * NTHREADS) {
        const int piece = (int)(it & 255), row = (int)((it >> 8) % 16256), w = (int)((it >> 8) / 16256);
        const int l = piece >> 3, d0 = (piece & 7) * 8, g = row & 3, bc = row >> 2, b = bc / NCMP, c = bc % NCMP;
        const u32x4 kv = *(const u32x4*)(KV + ((size_t)b * SEQ + 16 * c + l) * 1536 + w * 256 + g * 64 + d0);
        const f32x4 pa = *(const f32x4*)(pos + (w * 32 + l) * 64 + d0), pb = *(const f32x4*)(pos + (w * 32 + l) * 64 + d0 + 4);
        u32x4 o; o.x = pk2(bflo(kv.x) + pa.x, bfhi(kv.x) + pa.y); o.y = pk2(bflo(kv.y) + pa.z, bfhi(kv.y) + pa.w); o.z = pk2(bflo(kv.z) + pb.x, bfhi(kv.z) + pb.y); o.w = pk2(bflo(kv.w) + pb.z, bfhi(kv.w) + pb.w);
        *(u32x4*)(BLK + ((size_t)w * 16384 + row) * 2048 + l * 64 + d0) = o; }
}
__device__ __forceinline__ int vt_pos(int k) { return (k & ~12) | ((k & 4) << 1) | ((k & 8) >> 1); }
__device__ __forceinline__ void p_cmp_finish(const Args& a) {
    const float* CMP = (const float*)(a.ws + MS_CMPRAW); const float* gk0 = a.in[I_GK];
    bf16_t* KCF = (bf16_t*)(a.ws + WS_KCF); bf16_t* VCF = (bf16_t*)(a.ws + WS_VCF);
    const int tz = opaque_tid(), lane = tz & 63, gw = blockIdx.x * NWAVES + (tz >> 6), NGW = gridDim.x * NWAVES;
    for (int it = gw; it < 2 * 16384; it += NGW) { const int w = it >> 14, idx = it & 16383, g = idx & 3, bc = idx >> 2, b = bc >> 7, c = bc & 127;
        float s = 0.f;
        if (c < NCMP) { s = CMP[((size_t)w * 16384 + (size_t)(b * NCMP + c) * 4 + g) * 64 + lane];
            if (w == 0) { const float ss = wave_sum(s * s); s = s * (1.0f / sqrtf(ss * (1.f / 64.f) + EPS)) * gk0[lane]; } }
        const int d = lane, t2 = c >> 6, kk = c & 63;
        if (w == 0) KCF[(((size_t)(b * 4 + g) * 2 + t2) * 8 + (kk >> 5) * 4 + (d >> 4)) * 512 + (((d >> 3) & 1) * 32 + (kk & 31)) * 8 + (d & 7)] = (bf16_t)f2bf(s);
        else { const int ps = vt_pos(kk); VCF[(((size_t)(b * 4 + g) * 2 + t2) * 8 + ((ps >> 4) * 2 + (d >> 5))) * 512 + (((ps >> 3) & 1) * 32 + (d & 31)) * 8 + (ps & 7)] = (bf16_t)f2bf(s); } }
}
__device__ __forceinline__ void p_kv_frag(const Args& a) {
    const bf16_t* KV = (const bf16_t*)(a.ws + WS_KVRAW); bf16_t* KF = (bf16_t*)(a.ws + WS_KF); bf16_t* VF = (bf16_t*)(a.ws + WS_VF);
    const int tz = opaque_tid();
    const long total = (long)2 * NBATCH * 4 * 8 * SEQ;
    const int sub = tz & 7;
    for (long it = (long)blockIdx.x * NTHREADS + tz; it < total; it += (long)gridDim.x * NTHREADS) {
        { const int t = (int)((it >> 3) & 2047), g = (int)((it >> 14) & 3), b = (int)((it >> 16) & 31), w = (int)(it >> 21);
          const float* gain = a.in[I_GK] + 64 * (1 + w);
          const u32x4 wv = *(const u32x4*)(KV + ((size_t)b * SEQ + t) * 1536 + 512 + w * 512 + g * 64 + sub * 8);
          float v[8] = {bflo(wv.x), bfhi(wv.x), bflo(wv.y), bfhi(wv.y), bflo(wv.z), bfhi(wv.z), bflo(wv.w), bfhi(wv.w)};
          float ss = 0.f;
#pragma unroll
          for (int j = 0; j < 8; ++j) ss += v[j] * v[j];
          ss += __shfl_xor(ss, 1); ss += __shfl_xor(ss, 2); ss += __shfl_xor(ss, 4);
          const float r = 1.0f / sqrtf(ss * (1.f / 64.f) + EPS);
          const f32x4 ga = *(const f32x4*)(gain + sub * 8), gb = *(const f32x4*)(gain + sub * 8 + 4);
          u32x4 o; o.x = pk2(v[0] * r * ga.x, v[1] * r * ga.y); o.y = pk2(v[2] * r * ga.z, v[3] * r * ga.w); o.z = pk2(v[4] * r * gb.x, v[5] * r * gb.y); o.w = pk2(v[6] * r * gb.z, v[7] * r * gb.w);
          const int kk = t & 63;
          *(u32x4*)(KF + ((((size_t)w * 128 + b * 4 + g) * 32 + (t >> 6)) * 8 + (kk >> 5) * 4 + (sub >> 1)) * 512 + ((sub & 1) * 32 + (kk & 31)) * 8) = o; }
        { const int t = (int)(it & 2047), piece = (int)((it >> 11) & 7), g = (int)((it >> 14) & 3), b = (int)((it >> 16) & 31), w = (int)(it >> 21);
          const u32x4 v = *(const u32x4*)(KV + ((size_t)b * SEQ + t) * 1536 + 768 + w * 512 + g * 64 + piece * 8);
          const int ps = vt_pos(t & 63), d0 = piece * 8;
          bf16_t* dst = VF + ((((size_t)w * 128 + b * 4 + g) * 32 + (t >> 6)) * 8 + ((ps >> 4) * 2 + (d0 >> 5))) * 512 + (((ps >> 3) & 1) * 32 + (d0 & 31)) * 8 + (ps & 7);
          dst[0] = (bf16_t)(v.x & 0xffff); dst[8] = (bf16_t)(v.x >> 16); dst[16] = (bf16_t)(v.y & 0xffff); dst[24] = (bf16_t)(v.y >> 16);
          dst[32] = (bf16_t)(v.z & 0xffff); dst[40] = (bf16_t)(v.z >> 16); dst[48] = (bf16_t)(v.w & 0xffff); dst[56] = (bf16_t)(v.w >> 16); } }
}

__device__ __forceinline__ int rel_bucket(int n) {
    if (n < 16) return n;
    int lg = 16 + (int)(logf((float)n * (1.f / 16.f)) / logf(8.f) * 16.f);
    return lg < 31 ? lg : 31;
}
typedef float f32x16 __attribute__((ext_vector_type(16)));
#define MFMA32(a, b, c) __builtin_amdgcn_mfma_f32_32x32x16_bf16((a), (b), (c), 0, 0, 0)
__device__ __forceinline__ float xhalf(float v, int h) { (void)h; return __shfl_xor(v, 32); }
__device__ __forceinline__ float dpp_xor1(float v) { return __shfl_xor(v, 1); }
__device__ __forceinline__ float dpp_xor2(float v) { return __shfl_xor(v, 2); }
__device__ __forceinline__ void pv_tile(const bf16_t* VTp, const f32x16& p0, const f32x16& p1, f32x16 (&O)[2], int lane) {
#pragma unroll
    for (int bb = 0; bb < 2; ++bb)
#pragma unroll
        for (int s2 = 0; s2 < 2; ++s2) {
            u32x4 w;
            if (bb == 0) { w.x = cvt_pk_bf16(p0[8 * s2 + 0], p0[8 * s2 + 1]); w.y = cvt_pk_bf16(p0[8 * s2 + 2], p0[8 * s2 + 3]); w.z = cvt_pk_bf16(p0[8 * s2 + 4], p0[8 * s2 + 5]); w.w = cvt_pk_bf16(p0[8 * s2 + 6], p0[8 * s2 + 7]); }
            else         { w.x = cvt_pk_bf16(p1[8 * s2 + 0], p1[8 * s2 + 1]); w.y = cvt_pk_bf16(p1[8 * s2 + 2], p1[8 * s2 + 3]); w.z = cvt_pk_bf16(p1[8 * s2 + 4], p1[8 * s2 + 5]); w.w = cvt_pk_bf16(p1[8 * s2 + 6], p1[8 * s2 + 7]); }
            const bf16x8 Pf = __builtin_bit_cast(bf16x8, w);
#pragma unroll
            for (int db = 0; db < 2; ++db) {
                const bf16x8 vf = *(const bf16x8*)(VTp + (size_t)((((bb * 2 + s2) * 2 + db) * 64 + lane) * 8));
                O[db] = MFMA32(vf, Pf, O[db]); } }
}
constexpr float MINIT = -1e20f;
constexpr float DEFER_THR = 11.5f;
constexpr int BT_C = 384, BT_N = 512;
__device__ __forceinline__ void online_tile(f32x16& s0, f32x16& s1, const LAS float* bl  , float& m, float& l, f32x16 (&O)[2]) {
    float mx = m;
    { float b0[16];
#pragma unroll
      for (int r = 0; r < 16; ++r) b0[r] = bl[(r & 3) + 8 * (r >> 2)];
#pragma unroll
      for (int r = 0; r < 16; ++r) { const float v = s0[r] + b0[r]; s0[r] = v; mx = fmaxf(mx, v); } }
    { float b1[16];
#pragma unroll
      for (int r = 0; r < 16; ++r) b1[r] = bl[32 + (r & 3) + 8 * (r >> 2)];
#pragma unroll
      for (int r = 0; r < 16; ++r) { const float v = s1[r] + b1[r]; s1[r] = v; mx = fmaxf(mx, v); } }
    mx = fmaxf(mx, __shfl_xor(mx, 32));
    if (!__all(mx - m <= DEFER_THR)) { const float al = __builtin_amdgcn_exp2f(m - mx); m = mx; l *= al; O[0] *= al; O[1] *= al; }
}
__device__ __forceinline__ void online_tile_wedge(f32x16& s0, f32x16& s1, int tedge  , float cb, float& m, float& l, f32x16 (&O)[2]) {
    float mx = m;
#pragma unroll
    for (int r = 0; r < 16; ++r) { const float v = ((r & 3) + 8 * (r >> 2) >= tedge) ? s0[r] + cb : NEGF; s0[r] = v; mx = fmaxf(mx, v); }
#pragma unroll
    for (int r = 0; r < 16; ++r) { const float v = (32 + (r & 3) + 8 * (r >> 2) >= tedge) ? s1[r] + cb : NEGF; s1[r] = v; mx = fmaxf(mx, v); }
    mx = fmaxf(mx, __shfl_xor(mx, 32));
    if (!__all(mx - m <= DEFER_THR)) { const float al = __builtin_amdgcn_exp2f(m - mx); m = mx; l *= al; O[0] *= al; O[1] *= al; }
}
__device__ __forceinline__ void online_tile_far(f32x16& s0, f32x16& s1, float cb, float& m, float& l, f32x16 (&O)[2]) {
    float mx = m;
#pragma unroll
    for (int r = 0; r < 16; ++r) { s0[r] += cb; mx = fmaxf(mx, s0[r]); }
#pragma unroll
    for (int r = 0; r < 16; ++r) { s1[r] += cb; mx = fmaxf(mx, s1[r]); }
    mx = fmaxf(mx, __shfl_xor(mx, 32));
    if (!__all(mx - m <= DEFER_THR)) { const float al = __builtin_amdgcn_exp2f(m - mx); m = mx; l *= al; O[0] *= al; O[1] *= al; }
}
template <int MODE> __device__ __forceinline__ void p_attn(const Args& a, LAS unsigned char* lds) {
    LAS float* biasd = (LAS float*)lds;
    const float* relb = a.in[I_RELB];
    if (opaque_tid() >= 256) __builtin_amdgcn_s_setprio(1);
    for (int i = opaque_tid(); i < 16 * BT_N; i += NTHREADS) { const int head = i / BT_N, dist = BT_C - (i % BT_N); biasd[i] = dist < 0 ? NEGF : relb[rel_bucket(dist < 128 ? dist : 128) * 16 + head] * 1.44269504f; }
    __syncthreads();
    const bf16_t* QG = (const bf16_t*)(a.ws + WS_QGRAW);
    const bf16_t* KF = (const bf16_t*)(a.ws + WS_KF); const bf16_t* VF = (const bf16_t*)(a.ws + WS_VF);
    const bf16_t* KCF = (const bf16_t*)(a.ws + WS_KCF); const bf16_t* VCF = (const bf16_t*)(a.ws + WS_VCF);
    bf16_t* OUT = (bf16_t*)(a.ws + (MODE == 0 ? WS_H : WS_BLK));
    for (int unit = blockIdx.x; unit < NBATCH * 32 * 4; unit += gridDim.x) {
        const int tid = opaque_tid(), lane = tid & 63, wave = tid >> 6, c = lane & 31, h = lane >> 5;
        const int k = unit >> 8, idx = unit & 255, xg = idx & 7;
        const int b = 2 * k + (xg >> 2), g = xg & 3, qx = ((idx >> 3) + 4 * (k >> 1)) & 31, qt = (k & 1) ? 31 - qx : qx;
        const int ql = 8 * wave + (c >> 2), r = c & 3, head = 4 * g + r; int tq = qt * 64 + ql; asm volatile("" : "+v"(tq));
        const size_t tok = (size_t)b * SEQ + tq;
        const LAS float* bd = biasd + head * BT_N + BT_C;
        bf16x8 Qf[4];
        LAS bf16x8* qlds = (LAS bf16x8*)(lds + 32768) + wave * 256 + lane;
#pragma unroll
        for (int s = 0; s < 4; ++s) { Qf[s] = *(const bf16x8*)(QG + tok * 1280 + head * 64 + 16 * s + 8 * h); qlds[64 * s] = Qf[s]; }
        const bf16_t* gp = QG + tok * 1280 + 1024 + head * 3;
        const float gt0 = __builtin_amdgcn_rcpf(1.f + __expf(-bf2f(gp[0]))), gt1 = __builtin_amdgcn_rcpf(1.f + __expf(-bf2f(gp[1]))), gt2 = __builtin_amdgcn_rcpf(1.f + __expf(-bf2f(gp[2])));
        f32x16 OT[2];
        int jsel = -1;
        bf16x8 Kn[8];
        {
            const bf16_t* KC = KCF + (size_t)(b * 4 + g) * 2 * 4096; const bf16_t* VC = VCF + (size_t)(b * 4 + g) * 2 * 4096;
            f32x16 sc[4];
#pragma unroll
            for (int i = 0; i < 4; ++i) sc[i] = (f32x16){0.f, 0.f, 0.f, 0.f, 0.f, 0.f, 0.f, 0.f, 0.f, 0.f, 0.f, 0.f, 0.f, 0.f, 0.f, 0.f};
            { bf16x8 kf[16];
#pragma unroll
              for (int t2 = 0; t2 < 2; ++t2)
#pragma unroll
                for (int s2 = 0; s2 < 4; ++s2) { kf[t2 * 8 + 2 * s2] = *(const bf16x8*)(KC + t2 * 4096 + (s2 * 64 + lane) * 8); kf[t2 * 8 + 2 * s2 + 1] = *(const bf16x8*)(KC + t2 * 4096 + ((4 + s2) * 64 + lane) * 8); }
              __builtin_amdgcn_sched_barrier(0);
#pragma unroll
              for (int t2 = 0; t2 < 2; ++t2)
#pragma unroll
                for (int s2 = 0; s2 < 4; ++s2) { sc[2 * t2] = MFMA32(kf[t2 * 8 + 2 * s2], Qf[s2], sc[2 * t2]); sc[2 * t2 + 1] = MFMA32(kf[t2 * 8 + 2 * s2 + 1], Qf[s2], sc[2 * t2 + 1]); } }
            bf16x8 vcf[8];
#pragma unroll
            for (int i = 0; i < 8; ++i) vcf[i] = *(const bf16x8*)(VC + (i * 64 + lane) * 8);
            __builtin_amdgcn_sched_barrier(0);
            float mx = NEGF;
            const int tq0 = qt * 64 + 8 * __builtin_amdgcn_readfirstlane(wave); const float cbf = bd[-128];
#pragma unroll
            for (int kb = 0; kb < 4; ++kb) {
                if ((tq0 - 31 - 64) - 16 * (32 * kb + 27) >= 128) {
#pragma unroll
                    for (int rr = 0; rr < 16; ++rr) { const float v = sc[kb][rr] + cbf; sc[kb][rr] = v; mx = fmaxf(mx, v); }
                } else if ((tq0 + 7 - 31) - 16 * (32 * kb) < 0) {
#pragma unroll
                    for (int rr = 0; rr < 16; ++rr) sc[kb][rr] = NEGF;
                } else {
                    float bb[16];
#pragma unroll
                    for (int rr = 0; rr < 16; ++rr) { const int dc = (tq - 31 - 64 * h) - 16 * (32 * kb + (rr & 3) + 8 * (rr >> 2)); bb[rr] = bd[-min(max(dc, 0), 128)]; }
#pragma unroll
                    for (int rr = 0; rr < 16; ++rr) { const int dc = (tq - 31 - 64 * h) - 16 * (32 * kb + (rr & 3) + 8 * (rr >> 2));
                        const float v = (dc >= 0) ? sc[kb][rr] + bb[rr] : NEGF; sc[kb][rr] = v; mx = fmaxf(mx, v); } } }
            mx = fmaxf(fmaxf(mx, __shfl_xor(mx, 32)), MINIT);
            float ps = 0.f;
#pragma unroll
            for (int kb = 0; kb < 4; ++kb)
#pragma unroll
                for (int rr = 0; rr < 16; ++rr) { const float p = __builtin_amdgcn_exp2f(sc[kb][rr] - mx); sc[kb][rr] = p; ps += p; }
            ps += __shfl_xor(ps, 32);
            const float inv = __builtin_amdgcn_rcpf(fmaxf(ps, TINYF));
#pragma unroll
            for (int kb = 0; kb < 4; ++kb) sc[kb] *= inv;
            OT[0] = (f32x16){0.f, 0.f, 0.f, 0.f, 0.f, 0.f, 0.f, 0.f, 0.f, 0.f, 0.f, 0.f, 0.f, 0.f, 0.f, 0.f}; OT[1] = OT[0];
#define CMP_PV(t2) do { _Pragma("unroll") for (int bb = 0; bb < 2; ++bb) _Pragma("unroll") for (int s2 = 0; s2 < 2; ++s2) { const f32x16& p = sc[2 * (t2) + bb]; \
                u32x4 w; w.x = cvt_pk_bf16(p[8 * s2 + 0], p[8 * s2 + 1]); w.y = cvt_pk_bf16(p[8 * s2 + 2], p[8 * s2 + 3]); w.z = cvt_pk_bf16(p[8 * s2 + 4], p[8 * s2 + 5]); w.w = cvt_pk_bf16(p[8 * s2 + 6], p[8 * s2 + 7]); \
                const bf16x8 Pf = __builtin_bit_cast(bf16x8, w); \
                _Pragma("unroll") for (int db = 0; db < 2; ++db) OT[db] = MFMA32(vcf[(bb * 2 + s2) * 2 + db], Pf, OT[db]); } } while (0)
            CMP_PV(0);
            { const bf16_t* Kp = KF + (size_t)(b * 4 + g) * 32 * 4096;
#pragma unroll
              for (int s2 = 0; s2 < 4; ++s2) { Kn[2 * s2] = *(const bf16x8*)(Kp + (s2 * 64 + lane) * 8); Kn[2 * s2 + 1] = *(const bf16x8*)(Kp + ((4 + s2) * 64 + lane) * 8); } }
#pragma unroll
            for (int i = 0; i < 8; ++i) vcf[i] = *(const bf16x8*)(VC + 4096 + (i * 64 + lane) * 8);
            __builtin_amdgcn_sched_barrier(0);
            float best = -1.f; int bj = -1; const int jmax = qt - 2;
            float prev_recv = 0.f;
#pragma unroll
            for (int v = 0; v < 16; ++v) if (2 * v <= jmax) { const int kb = v >> 2, aa = v & 3;
                const float p3 = sc[kb][4 * aa + 3];
                const float av = (sc[kb][4 * aa] + sc[kb][4 * aa + 1]) + (sc[kb][4 * aa + 2] + 0.5f * p3);
                const float recv = xhalf(0.5f * p3, h);
                float iv = av + (h ? recv : prev_recv);
                prev_recv = recv;
                iv += dpp_xor1(iv); iv += dpp_xor2(iv);
                const int jj = 2 * v + h;
                if (jj >= 1 && jj <= jmax && iv > best) { best = iv; bj = jj; } }
            { const float ob = xhalf(best, h); const int oj = __builtin_bit_cast(int, xhalf(__builtin_bit_cast(float, bj), h));
              if (oj >= 0 && (bj < 0 || ob > best || (ob == best && oj < bj))) { best = ob; bj = oj; } }
            jsel = bj;
            CMP_PV(1);
#undef CMP_PV
            LAS f32x4* otl0 = (LAS f32x4*)(lds + 65536) + wave * 512 + lane;
#pragma unroll
            for (int db = 0; db < 2; ++db)
#pragma unroll
                for (int r4 = 0; r4 < 4; ++r4) otl0[(db * 4 + r4) * 64] = (f32x4){OT[db][4 * r4], OT[db][4 * r4 + 1], OT[db][4 * r4 + 2], OT[db][4 * r4 + 3]} * gt0;
        }
        {
            float m = MINIT, l = 0.f; f32x16 O[2];
            LAS f32x4* otl = (LAS f32x4*)(lds + 65536) + wave * 512 + lane;
            O[0] = (f32x16){0.f, 0.f, 0.f, 0.f, 0.f, 0.f, 0.f, 0.f, 0.f, 0.f, 0.f, 0.f, 0.f, 0.f, 0.f, 0.f}; O[1] = O[0];
            const bf16_t* KbS = KF + (size_t)(b * 4 + g) * 32 * 4096; const bf16_t* VbS = VF + (size_t)(b * 4 + g) * 32 * 4096;
#define ATT_NEXT(nx, kt, pq, win, ok) do { pq = 0; win = 0; ok = false; \
                while ((nx) < 16) { \
                    if ((nx) < 3) { kt = ((nx) == 1) ? qt - 1 : qt; if (kt > 0) { ok = true; break; } ++(nx); } \
                    else if ((nx) == 3) { if (rem == 0ull) { (nx) = 11; continue; } \
                        kt = __builtin_amdgcn_readlane(jsel, (int)__builtin_ctzll(rem)); rem &= ~__ballot(jsel == kt); pq = 1; ok = true; break; } \
                    else { kt = qt - 15 + (nx); win = 1; if (kt >= 0) { ok = true; break; } ++(nx); } } } while (0)
#define ATT_KPTR(kt, win) (KbS + (size_t)(win) * ((size_t)128 * 32 * 4096) + (size_t)(kt) * 4096)
#define ATT_VPTR(kt, win) (VbS + (size_t)(win) * ((size_t)128 * 32 * 4096) + (size_t)(kt) * 4096)
            int st = 0, kt = 0, pq = 0, win = 0;
            unsigned long long rem = __ballot(jsel >= 1);
            int curwin = 0;
            for (;;) {
                int nx = (st == 3) ? 3 : st + 1, nkt = 0, npq = 0, nwin = 0; bool nok = false;
                ATT_NEXT(nx, nkt, npq, nwin, nok);
                bf16x8 Vc[8];
                { const bf16_t* Vp = ATT_VPTR(kt, win);
#pragma unroll
                  for (int bb = 0; bb < 2; ++bb)
#pragma unroll
                    for (int s2 = 0; s2 < 2; ++s2)
#pragma unroll
                        for (int db = 0; db < 2; ++db) Vc[(bb * 2 + s2) * 2 + db] = *(const bf16x8*)(Vp + ((((bb * 2 + s2) * 2 + db) * 64 + lane) * 8)); }
                if (win != curwin) {
                    const float scl = gt1 * __builtin_amdgcn_rcpf(fmaxf(l, TINYF));
#pragma unroll
                    for (int db = 0; db < 2; ++db)
#pragma unroll
                        for (int r4 = 0; r4 < 4; ++r4) otl[(db * 4 + r4) * 64] += (f32x4){O[db][4 * r4], O[db][4 * r4 + 1], O[db][4 * r4 + 2], O[db][4 * r4 + 3]} * scl;
                    m = MINIT; l = 0.f; O[0] = (f32x16){0.f, 0.f, 0.f, 0.f, 0.f, 0.f, 0.f, 0.f, 0.f, 0.f, 0.f, 0.f, 0.f, 0.f, 0.f, 0.f}; O[1] = O[0]; curwin = win; }
                f32x16 s0 = (f32x16){0.f, 0.f, 0.f, 0.f, 0.f, 0.f, 0.f, 0.f, 0.f, 0.f, 0.f, 0.f, 0.f, 0.f, 0.f, 0.f}, s1 = s0;
#pragma unroll
                for (int s2 = 0; s2 < 4; ++s2) { const bf16x8 qf = qlds[64 * s2]; s0 = MFMA32(Kn[2 * s2], qf, s0); s1 = MFMA32(Kn[2 * s2 + 1], qf, s1); }
                { const bf16_t* Kp = nok ? ATT_KPTR(nkt, nwin) : ATT_KPTR(kt, win);
#pragma unroll
                  for (int s2 = 0; s2 < 4; ++s2) { Kn[2 * s2] = *(const bf16x8*)(Kp + (s2 * 64 + lane) * 8); Kn[2 * s2 + 1] = *(const bf16x8*)(Kp + ((4 + s2) * 64 + lane) * 8); } }
                const bool colok = !pq || (jsel == kt);
                const int dq = qt - kt;
                if (win ? (dq == 3) : (dq >= 3)) online_tile_far(s0, s1, colok ? bd[-128] : NEGF, m, l, O);
                else if (win && dq == 4) online_tile_wedge(s0, s1, (tq - kt * 64 - 4 * h) - 255, bd[-128], m, l, O);
                else online_tile(s0, s1, bd - (colok ? (tq - kt * 64 - 4 * h) : -64), m, l, O);
                { float ps = 0.f;
#pragma unroll
                  for (int bb = 0; bb < 2; ++bb) {
                      f32x16& sb = bb ? s1 : s0;
#pragma unroll
                      for (int r = 0; r < 16; ++r) { const float p = __builtin_amdgcn_exp2f(sb[r] - m); sb[r] = p; ps += p; }
#pragma unroll
                      for (int s2 = 0; s2 < 2; ++s2) {
                          u32x4 w; w.x = cvt_pk_bf16(sb[8 * s2 + 0], sb[8 * s2 + 1]); w.y = cvt_pk_bf16(sb[8 * s2 + 2], sb[8 * s2 + 3]); w.z = cvt_pk_bf16(sb[8 * s2 + 4], sb[8 * s2 + 5]); w.w = cvt_pk_bf16(sb[8 * s2 + 6], sb[8 * s2 + 7]);
                          const bf16x8 Pf = __builtin_bit_cast(bf16x8, w);
#pragma unroll
                          for (int db = 0; db < 2; ++db) O[db] = MFMA32(Vc[(bb * 2 + s2) * 2 + db], Pf, O[db]); }
                      __builtin_amdgcn_sched_barrier(0); }
                  ps += __shfl_xor(ps, 32); l += ps; }
                if (!nok) break;
                st = nx; kt = nkt; pq = npq; win = nwin;
            }
#undef ATT_NEXT
#undef ATT_KPTR
#undef ATT_VPTR
            const float scl = gt2 * __builtin_amdgcn_rcpf(fmaxf(l, TINYF));
#pragma unroll
            for (int db = 0; db < 2; ++db)
#pragma unroll
                for (int r4 = 0; r4 < 4; ++r4) { const f32x4 p = otl[(db * 4 + r4) * 64];
#pragma unroll
                    for (int j = 0; j < 4; ++j) OT[db][4 * r4 + j] = p[j] + O[db][4 * r4 + j] * scl; }
        }
        bf16_t* op = OUT + tok * DM + head * 64;
#pragma unroll
        for (int db = 0; db < 2; ++db)
#pragma unroll
            for (int kk = 0; kk < 2; ++kk) {
                const unsigned ax = cvt_pk_bf16(OT[db][8 * kk], OT[db][8 * kk + 1]), ay = cvt_pk_bf16(OT[db][8 * kk + 2], OT[db][8 * kk + 3]);
                const unsigned bx = cvt_pk_bf16(OT[db][8 * kk + 4], OT[db][8 * kk + 5]), by = cvt_pk_bf16(OT[db][8 * kk + 6], OT[db][8 * kk + 7]);
                const auto r0 = __builtin_amdgcn_permlane32_swap(ax, bx, false, false);
                const auto r1 = __builtin_amdgcn_permlane32_swap(ay, by, false, false);
                u32x4 w; w.x = r0[0]; w.y = r1[0]; w.z = r0[1]; w.w = r1[1];
                *(u32x4*)(op + 32 * db + 16 * kk + 8 * h) = w; }
    }
    __builtin_amdgcn_s_setprio(0);
}

constexpr int MOE_CHUNK_TILES = 64, MOE_NCHUNK = 8, MOE_LAST_TILES = 72, DENSE_NCHUNK = 4, DENSE_CHUNK_ROWS = 16384;
__host__ __device__ constexpr int n_phases() {
    int pc = 0;
    for (int L = 0; L < 4; ++L) {
        if (L < 2) pc += 2; else { pc += (L == 2) ? 6 : 3; }
        if (L % 2 == 0) pc += 2 * DENSE_NCHUNK; else pc += 2 + 2 * MOE_NCHUNK + 1;
    }
    return pc;
}

typedef __attribute__((address_space(4))) const Args* KArgsPtr;
__device__ __forceinline__ Args load_args() {
    Args r{};
#if defined(__HIP_DEVICE_COMPILE__)
    KArgsPtr kp = (KArgsPtr)__builtin_amdgcn_kernarg_segment_ptr(); asm volatile("" : "+s"(kp));
#pragma unroll
    for (int i = 0; i < 22; ++i) r.in[i] = kp->in[i];
    r.out = kp->out; r.ws = kp->ws; r.ph_lo = kp->ph_lo; r.ph_hi = kp->ph_hi;
#endif
    return r;
}
__global__ void __launch_bounds__(NTHREADS, 2) yoco_fwd(Args kargs) {
    extern __shared__ __attribute__((aligned(16))) unsigned char lds_raw[];
    LAS unsigned char* lds = (LAS unsigned char*)lds_raw;
    volatile LAS unsigned* MISC = (volatile LAS unsigned*)(lds + MISC_OFF);
    const int tid = threadIdx.x, G = gridDim.x, cid = blockIdx.x;
    if (tid < 64) MISC[tid] = 0u;
    __syncthreads();
#if MK_SINGLE_LAUNCH
    constexpr int lo = 0, hi = n_phases();
#else
    const int lo = kargs.ph_lo, hi = kargs.ph_hi;
#endif
    unsigned char* ws = kargs.ws;
    const bool SPLIT_OK = (lo == 0 && hi == n_phases());
    if (hi - lo > 1) (void)xcd_barrier_post((unsigned*)(ws + WS_CTL), MISC + 8);
    if (tid == 0) atomicOr((unsigned*)(ws + WS_CTL + CTL_XMASK) + (cid & 7), 1u << xb_xcc_id());
    int pc = 0;
#define PH_BEGIN if (pc >= lo && pc < hi) { const Args args = load_args();
#define PH_JOIN }
#define PH_END_SPLIT(split) } if (pc >= lo && pc + 1 < hi) { XcdBarrier bb; bb.bar = (unsigned*)(load_args().ws + WS_CTL); bb.x = xb_xcc_id(); bb.st = (volatile LAS unsigned*)(lds + MISC_OFF) + 8; if (split) xcd_arrive(bb); else xcd_barrier(bb); } ++pc;
#define PH_END_GROUP(grp) } if (pc >= lo && pc + 1 < hi) { XcdBarrier bb; bb.bar = (unsigned*)(load_args().ws + WS_CTL); bb.x = xb_xcc_id(); bb.st = (volatile LAS unsigned*)(lds + MISC_OFF) + 8; if (grp) group_barrier(bb, cid); else xcd_barrier(bb); } ++pc;
#define PH_END } if (pc >= lo && pc + 1 < hi) { XcdBarrier bb; bb.bar = (unsigned*)(load_args().ws + WS_CTL); bb.x = xb_xcc_id(); bb.st = (volatile LAS unsigned*)(lds + MISC_OFF) + 8; xcd_barrier(bb); if (PROBE_BAR) xcd_barrier(bb); } ++pc;

    bf16_t* XB = (bf16_t*)(ws + WS_KVRAW);
    bf16_t* HID = (bf16_t*)(ws + WS_H);
    float* SSQ = (float*)(ws + MS_SSQ);
    LAS float* EPIP = (LAS float*)(lds + MISC_OFF + LX_P); LAS float* EPISQ = (LAS float*)(lds + MISC_OFF + LX_SQ);
    LAS float* LGAIN = (LAS float*)(lds + MISC_OFF + LX_GAIN); LAS float* LPOS = (LAS float*)(lds + MISC_OFF + LX_POS);


#pragma clang loop unroll(full)
    for (int L = 0; L < 4; ++L) {
        const bf16_t* XBin = XB;
        if (L < 2) {
            PH_BEGIN
                if (L == 0) { p_convert_static(args, lds); p_convert_moe(args, lds, 0); __syncthreads();
                              p_pool_diff(args.in[I_X], (const float*)nullptr, HID, lds); }
                else p_pool_diff((const bf16_t*)XB, (const float*)SSQ, HID, lds);
            PH_END
            PH_BEGIN
                pg8::Gemm g{256, DM, 256};
                pg8::GridSched S{NTOK / 256, 4, G, cid, (const char*)HID, (size_t)256 * DM * 2, (size_t)256 * 2, (const char*)(ws + W_POOL) + (size_t)L * 4 * 65536 * 2, (size_t)65536 * 2, 0, 1 << 30};
                if (L == 0) { pg8::EpiResid<float> E{args.in[I_X], XB, SSQ, DM, 0, EPIP, 1.f}; pg8::gemm_phase(lds, g, S, E); }
                else { pg8::EpiResid<bf16_t> E{XB, XB, SSQ, DM, 0, EPIP, 1.f}; pg8::gemm_phase(lds, g, S, E); }
            PH_END
        } else {
            const int j = L - 2;
            if (j == 0) {
                PH_BEGIN
                    { const int t = opaque_tid();
                      if (t < 192) LGAIN[t] = args.in[I_GK][t];
                      for (int i = t; i < 2 * 32 * 64; i += NTHREADS) LPOS[i] = args.in[I_CPOS][i];
                      __syncthreads(); }
                    pg8::Gemm g{DM, DM, DM};
                    pg8::GridSched S{NTOK / 256, 6, G, cid, (const char*)XBin, (size_t)256 * DM * 2, 0, (const char*)(ws + W_KV), (size_t)256 * DM * 2, 0, 1 << 30};
                    pg8::EpiKV E{pg8::RowScale{SSQ, 0, EPISQ}, (bf16_t*)(ws + WS_BLK), (bf16_t*)(ws + WS_KF), (bf16_t*)(ws + WS_VF), LGAIN, LPOS};
                    DUP(7) pg8::gemm_phase(lds, g, S, E);
                PH_JOIN
            }
            PH_BEGIN
                { const int t = opaque_tid(); if (t < 64) LGAIN[192 + t] = args.in[I_GQ][j * 64 + t]; __syncthreads(); }
                pg8::Gemm g{DM, DM, DM};
                pg8::GridSched S{NTOK / 256, 5, G, cid, (const char*)XBin, (size_t)256 * DM * 2, 0, (const char*)(ws + W_QG) + (size_t)j * 1280 * DM * 2, (size_t)256 * DM * 2, 0, 1 << 30};
                pg8::EpiQG E{pg8::RowScale{SSQ, 0, EPISQ}, (bf16_t*)(ws + WS_QGRAW), 1280, LGAIN + 192, 0.125f * 1.44269504f};
                DUP(7) pg8::gemm_phase(lds, g, S, E);
            PH_END
            if (j == 0) {
                PH_BEGIN
                    pg8::Gemm g{2048, 2048, 2048};
                    pg8::GridSched S{128, 1, G, cid, (const char*)(ws + WS_BLK), (size_t)256 * 2048 * 2, 0, (const char*)(ws + W_C1), 0, (size_t)256 * 2048 * 2, 64};
                    pg8::EpiBf16<1, false> E{HID, 256, pg8::RowScale{nullptr, 0, nullptr}, 1.f};
                    DUP(7) pg8::gemm_phase(lds, g, S, E);
                PH_END
                PH_BEGIN
                    pg8::Gemm g{256, 256, 256};
                    pg8::GridSched S{128, 1, G, cid, (const char*)HID, (size_t)256 * 256 * 2, 0, (const char*)(ws + W_C2), 0, (size_t)256 * 256 * 2, 64};
                    pg8::EpiCmp2 E{(float*)(ws + MS_CMPRAW)};
                    DUP(7) pg8::gemm_phase(lds, g, S, E);
                PH_END
                PH_BEGIN
                    DUP(6) p_cmp_finish(args);
                PH_END
            }
            PH_BEGIN
                p_attn<0>(args, lds);
#if PROBE_ATTN
                p_attn<PROBE_ATTN>(args, lds);
#endif
            PH_END
            PH_BEGIN
                pg8::Gemm g{DM, DM, DM};
                pg8::GridSched S{NTOK / 256, 4, G, cid, (const char*)HID, (size_t)256 * DM * 2, 0, (const char*)(ws + W_O) + (size_t)j * DM * DM * 2, (size_t)256 * DM * 2, 0, 1 << 30};
                pg8::EpiResid<bf16_t> E{XB, XB, SSQ, DM, 0, EPIP, 1.f};
                pg8::gemm_phase(lds, g, S, E);
            PH_END
        }
        if ((L & 1) == 0) {
            const int i = L >> 1;
            for (int ch = 0; ch < DENSE_NCHUNK; ++ch) {
                PH_BEGIN
                    pg8::Gemm g{DM, DM, DM};
                    pg8::GridSched S{DENSE_CHUNK_ROWS / 256, 28, G, cid, (const char*)(XB + (size_t)ch * DENSE_CHUNK_ROWS * DM), (size_t)256 * DM * 2, 0, (const char*)(ws + W_GU) + (size_t)i * 7168 * DM * 2, (size_t)256 * DM * 2, 0, 1 << 30};
                    pg8::EpiSwiGLU<true> E{HID, FFD, pg8::RowScale{SSQ, ch * DENSE_CHUNK_ROWS, EPISQ}, (unsigned*)(ws + MS_CMPRAW)};
                    pg8::gemm_phase(lds, g, S, E, WaitHook{SPLIT_OK && ch > 0, (unsigned*)(args.ws + WS_CTL), (volatile LAS unsigned*)(lds + MISC_OFF) + 8});
                PH_END_GROUP(SPLIT_OK)
                PH_BEGIN
                    pg8::Gemm g{FFD / 2, FFD / 2, FFD / 2};
                    pg8::GridSched S{DENSE_CHUNK_ROWS / 256, 4, G, cid, (const char*)HID, (size_t)256 * FFD, 0, (const char*)(ws + W_D) + (size_t)i * DM * FFD, (size_t)256 * FFD, 0, 1 << 30};
                    pg8::EpiResid<bf16_t> E{XB, XB, SSQ, DM, ch * DENSE_CHUNK_ROWS, EPIP, pg8::F8_OSC};
                    pg8::gemm_phase<pg8::EpiResid<bf16_t>, pg8::GridSched, pg8::NoHook, true, true>(lds, g, S, E);
                PH_END_SPLIT(SPLIT_OK && ch + 1 < DENSE_NCHUNK)
            }
        } else {
            const int l = L >> 1;
            PH_BEGIN
                if (l == 1) { p_convert_moe(args, lds, 1); __syncthreads(); }
                p_router_a(args, XB, l, lds);
            PH_END
            PH_BEGIN
                DUP(5) p_router_b(args, XB, lds);
            PH_END
            for (int ch = 0; ch < MOE_NCHUNK; ++ch) {
                PH_BEGIN
                    const int NT = *(const int*)(ws + CTL_NT), capT = (ch == MOE_NCHUNK - 1) ? MOE_LAST_TILES : MOE_CHUNK_TILES; int nT = NT - ch * MOE_CHUNK_TILES; nT = nT < 0 ? 0 : (nT > capT ? capT : nT);
                    LAS int* LTE = (LAS int*)(lds + MISC_OFF + 14336);
                    { const int t = opaque_tid(); if (t < nT) LTE[t] = ((const int*)(ws + CTL_TILEE))[ch * MOE_CHUNK_TILES + t]; __syncthreads(); }
                    pg8::Gemm g{DM / 2, DM / 2, DM / 2};
                    pg8::MoeSched S{nT, 28, G, cid, LTE, (const char*)(ws + WS_A + 128 * MiB) + (size_t)ch * MOE_CHUNK_TILES * 256 * DM, (size_t)256 * DM, (const char*)(ws + WS_WMOE), (size_t)256 * DM, 28};
                    pg8::EpiSwiGLU<false> E{HID, FFD, pg8::RowScale{nullptr, 0, nullptr}, (unsigned*)(ws + MS_CMPRAW)};
                    pg8::gemm_phase<pg8::EpiSwiGLU<false>, pg8::MoeSched, WaitHook, false, true>(lds, g, S, E, WaitHook{SPLIT_OK && ch > 0, (unsigned*)(args.ws + WS_CTL), (volatile LAS unsigned*)(lds + MISC_OFF) + 8});
                PH_END_GROUP(SPLIT_OK && ch + 1 < MOE_NCHUNK)
                PH_BEGIN
                    const int NT = *(const int*)(ws + CTL_NT), capT = (ch == MOE_NCHUNK - 1) ? MOE_LAST_TILES : MOE_CHUNK_TILES; int nT = NT - ch * MOE_CHUNK_TILES; nT = nT < 0 ? 0 : (nT > capT ? capT : nT);
                    LAS int* LTE = (LAS int*)(lds + MISC_OFF + 14336);
                    { const int t = opaque_tid(); if (t < nT) LTE[t] = ((const int*)(ws + CTL_TILEE))[ch * MOE_CHUNK_TILES + t]; __syncthreads(); }
                    { pg8::Gemm g{FFD / 2, FFD / 2, FFD / 2};
                      pg8::MoeSched S{nT, 4, G, cid, LTE, (const char*)HID, (size_t)256 * FFD, (const char*)(ws + WMOE_D), (size_t)256 * FFD, 4};
                      pg8::EpiBf16<0, false> E{(bf16_t*)(ws + WS_A) + (size_t)ch * MOE_CHUNK_TILES * 256 * DM, DM, pg8::RowScale{nullptr, 0, nullptr}, pg8::F8_OSC};
                      pg8::gemm_phase<pg8::EpiBf16<0, false>, pg8::MoeSched, pg8::NoHook, true, true>(lds, g, S, E); }
                PH_END_SPLIT(SPLIT_OK && ch + 1 < MOE_NCHUNK)
            }
            PH_BEGIN
                if (L == 3) p_moe_combine<true>(args, XB, SSQ, kargs.out); else p_moe_combine<false>(args, XB, SSQ, nullptr);
            PH_END
        }
    }
#undef PH_BEGIN
#undef PH_END
}

extern "C" void kernel_launch(void* const* d_in, const int* in_sizes, int n_in, void* d_out, int out_size, void* d_ws, size_t ws_size, hipStream_t stream) {
    static int grid = 0;
    if (grid == 0) {
        if (n_in != 22 || in_sizes[0] != NTOK * DM || out_size != NTOK * DM || ws_size < WS_END) {
            fprintf(stderr, "kernel_launch: unexpected problem: n_in %d in0 %d out %d ws %zu (need %zu)\n", n_in, n_in > 0 ? in_sizes[0] : -1, out_size, ws_size, (size_t)WS_END); grid = -1; return; }
        int dev = 0, cus = 0;
        if (hipGetDevice(&dev) != hipSuccess || hipDeviceGetAttribute(&cus, hipDeviceAttributeMultiprocessorCount, dev) != hipSuccess) { grid = -1; return; }
        if (hipFuncSetAttribute((const void*)yoco_fwd, hipFuncAttributeMaxDynamicSharedMemorySize, LDS_BYTES) != hipSuccess) { fprintf(stderr, "kernel_launch: hipFuncSetAttribute failed\n"); grid = -1; return; }
        int per_cu = 0;
        if (hipOccupancyMaxActiveBlocksPerMultiprocessor(&per_cu, (const void*)yoco_fwd, NTHREADS, LDS_BYTES) != hipSuccess || per_cu < 1)
            fprintf(stderr, "kernel_launch: note: occupancy query says %d\n", per_cu);
        (void)hipGetLastError();
        grid = cus;
    }
    if (grid < 0) return;
    (void)hipMemsetAsync((char*)d_ws + WS_CTL, 0, CTL_ZERO_BYTES, stream);
    Args a{};
    for (int i = 0; i < 22; ++i) a.in[i] = (const float*)d_in[i];
    a.out = (float*)d_out; a.ws = (unsigned char*)d_ws;
    constexpr int NPH = n_phases();
#if MK_SINGLE_LAUNCH
    a.ph_lo = 0; a.ph_hi = NPH;
    hipLaunchKernelGGL(yoco_fwd, dim3(grid), dim3(NTHREADS), LDS_BYTES, stream, a);
#else
    for (int p = 0; p < NPH; ++p) { a.ph_lo = p; a.ph_hi = p + 1; hipLaunchKernelGGL(yoco_fwd, dim3(grid), dim3(NTHREADS), LDS_BYTES, stream, a); }
#endif
}
```

```cpp
#include <hip/hip_runtime.h>
#include <cstdio>
#include <cstdint>

#ifndef MK_SINGLE_LAUNCH
#define MK_SINGLE_LAUNCH 1
#endif

#ifndef PROBE_BAR
#define PROBE_BAR 0
#endif
#ifndef PROBE_ATTN
#define PROBE_ATTN 0
#endif
#ifndef PROBE_DUP
#define PROBE_DUP 0
#endif
#define DUP(bit) for (int _rep = 0; _rep < (((PROBE_DUP) >> (bit)) & 1) + 1; ++_rep)
#define LAS __attribute__((address_space(3)))
typedef unsigned short bf16_t;
typedef short bf16x8 __attribute__((ext_vector_type(8)));
typedef float f32x4 __attribute__((ext_vector_type(4)));
typedef float f32x2 __attribute__((ext_vector_type(2)));
typedef unsigned u32x4 __attribute__((ext_vector_type(4)));
typedef int v8i32 __attribute__((ext_vector_type(8)));
typedef int v4i32 __attribute__((ext_vector_type(4)));
typedef unsigned u32x2 __attribute__((ext_vector_type(2)));

constexpr int NTOK = 65536, DM = 1024, FFD = 3584, NEXP = 8, SEQ = 2048, NBATCH = 32;
constexpr int NCMP = 127, NSLC = 32;
constexpr float EPS = 1e-6f;
constexpr float NEGF = -1e30f, TINYF = 1e-30f;

constexpr size_t MiB = (size_t)1 << 20;
constexpr size_t WS_CTL = 0;
constexpr size_t CTL_ZERO_BYTES = 64 * 1024;
constexpr size_t CTL_CNT = 64 * 1024;
constexpr size_t CTL_TILEE = 80 * 1024;
constexpr size_t CTL_NT = 88 * 1024;
constexpr size_t WS_W = 1 * MiB;
constexpr size_t W_POOL = WS_W;
constexpr size_t W_GU = W_POOL + (size_t)2 * 4 * 256 * 256 * 2;
constexpr size_t W_D = W_GU + (size_t)2 * 7168 * 1024 * 2;
constexpr size_t W_KV = W_D + (size_t)2 * 1024 * 3584 * 2;
constexpr size_t W_QG = W_KV + (size_t)1536 * 1024 * 2;
constexpr size_t W_O = W_QG + (size_t)2 * 1280 * 1024 * 2;
constexpr size_t W_C1 = W_O + (size_t)2 * 1024 * 1024 * 2;
constexpr size_t W_C2 = W_C1 + (size_t)2 * 256 * 2048 * 2;
constexpr size_t W_END = W_C2 + (size_t)2 * 256 * 256 * 2;
constexpr size_t WS_WMOE = 60 * MiB;
constexpr size_t WMOE_D = WS_WMOE + (size_t)8 * 7168 * 1024 * 2;
constexpr size_t WS_A = 228 * MiB;
constexpr size_t WS_BLK = WS_A + 128 * MiB;
constexpr size_t WS_KF = WS_WMOE;
constexpr size_t WS_VF = WS_WMOE + 64 * MiB;
constexpr size_t WS_KCF = WS_WMOE + 128 * MiB;
constexpr size_t WS_VCF = WS_KCF + 2 * MiB;
constexpr size_t WS_H = 488 * MiB;
constexpr size_t WS_KVRAW = 616 * MiB;
constexpr size_t WS_QGRAW = 808 * MiB;
constexpr size_t WS_MISC = 968 * MiB;
constexpr size_t MS_CMPRAW = WS_MISC;
constexpr size_t MS_RE = WS_MISC + 8 * MiB;
constexpr size_t MS_RG = MS_RE + 256 * 1024;
constexpr size_t MS_RSTD = MS_RG + 512 * 1024;
constexpr size_t MS_SLOT = MS_RSTD + 256 * 1024;
constexpr size_t MS_SSQ = MS_SLOT + 512 * 1024;
constexpr size_t WS_END = WS_MISC + 12 * MiB;
static_assert(W_END <= WS_WMOE, "weights region");

__device__ __forceinline__ unsigned f2bf(float f) { unsigned u = __builtin_bit_cast(unsigned, f); return (u + 0x7fffu + ((u >> 16) & 1u)) >> 16; }
__device__ __forceinline__ unsigned pk2(float lo, float hi) { return f2bf(lo) | (f2bf(hi) << 16); }
__device__ __forceinline__ float bf2f(unsigned short b) { return __builtin_bit_cast(float, (unsigned)b << 16); }
__device__ __forceinline__ float bflo(unsigned w) { return __builtin_bit_cast(float, w << 16); }
__device__ __forceinline__ float bfhi(unsigned w) { return __builtin_bit_cast(float, w & 0xffff0000u); }
__device__ __forceinline__ unsigned cvt_pk_bf16(float lo, float hi) { unsigned r; asm volatile("v_cvt_pk_bf16_f32 %0, %1, %2" : "=v"(r) : "v"(lo), "v"(hi)); return r; }
__device__ __forceinline__ f32x4 ld4(const float* p) { return *(const f32x4*)p; }
__device__ __forceinline__ f32x4 ld4(const bf16_t* p) { const u32x2 w = *(const u32x2*)p; return (f32x4){bflo(w.x), bfhi(w.x), bflo(w.y), bfhi(w.y)}; }
__device__ __forceinline__ void ld8(const float* p, f32x4& a, f32x4& b) { a = *(const f32x4*)p; b = *(const f32x4*)(p + 4); }
__device__ __forceinline__ void ld8(const bf16_t* p, f32x4& a, f32x4& b) { const u32x4 w = *(const u32x4*)p; a = (f32x4){bflo(w.x), bfhi(w.x), bflo(w.y), bfhi(w.y)}; b = (f32x4){bflo(w.z), bfhi(w.z), bflo(w.w), bfhi(w.w)}; }
__device__ __forceinline__ float wave_sum(float v) {
#pragma unroll
    for (int o = 1; o < 64; o <<= 1) v += __shfl_xor(v, o);
    return v;
}
__device__ __forceinline__ int opaque_tid() { int t = threadIdx.x; asm volatile("" : "+v"(t)); return t; }
__device__ __forceinline__ float silu_f(float g) { return g * __builtin_amdgcn_rcpf(1.f + __expf(-g)); }

namespace pg8 {
constexpr int BM = 256, BK = 64, HALF = 128, HTB = HALF * BK * 2, STAGE_BYTES = 8 * HTB, NXCD = 8, WGM = 8;
__host__ __device__ __forceinline__ int lds_byte(int r, int c) { const int st = (r >> 4) * 2 + (c >> 5), rr = r & 15, cc = c & 31, ob = rr * 64 + cc * 2; return st * 1024 + (ob ^ (((ob >> 9) & 1) << 5)); }
__host__ __device__ __forceinline__ void stage_rc(int b, int& R, int& C) { const int st = b / 1024, sb = b % 1024, swz = sb ^ (((sb >> 9) & 1) << 5); R = (st >> 1) * 16 + swz / 64; C = (st & 1) * 32 + (swz % 64) / 2; }
__host__ __device__ __forceinline__ int perm32(int rho) { const int n = rho >> 4, i = rho & 15; return 8 * (i >> 2) + 4 * n + (i & 3); }

struct Unit { int pm, pn; };
struct Gemm { int K, lda, ldb; };

__device__ __forceinline__ bool grid_order(int nM, int nN, int G, int c, int i, Unit& u) {
    const int nwg = nM * nN; const long L = (long)i * G + c; if (L >= nwg) return false;
    int wgid = (int)L; { const int q = nwg / NXCD, r = nwg % NXCD, xcd = wgid % NXCD, off = wgid / NXCD; wgid = (xcd < r ? xcd * (q + 1) : r * (q + 1) + (xcd - r) * q) + off; }
    const int nig = WGM * nN, gid = wgid / nig, fm = gid * WGM, gsz = (nM - fm) < WGM ? (nM - fm) : WGM;
    u.pm = fm + ((wgid % nig) % gsz); u.pn = (wgid % nig) / gsz; return true;
}
struct GridSched {
    int nM, nN, G, c; const char* A; size_t a_sm, a_sn; const char* B; size_t b_sn, b_sm; int b_div;
    __device__ __forceinline__ bool next(int i, Unit& u) const { return grid_order(nM, nN, G, c, i, u); }
    __device__ __forceinline__ const char* a_tile(const Unit& u) const { return A + (size_t)u.pm * a_sm + (size_t)u.pn * a_sn; }
    __device__ __forceinline__ const char* b_tile(const Unit& u) const { return B + (size_t)u.pn * b_sn + (size_t)(u.pm / b_div) * b_sm; }
};
struct MoeSched {
    int nM, nN, G, c; const LAS int* tile_e; const char* A; size_t a_sm; const char* B; size_t b_tile_bytes; int tiles_per_e;
    __device__ __forceinline__ bool next(int i, Unit& u) const { return grid_order(nM, nN, G, c, i, u); }
    __device__ __forceinline__ const char* a_tile(const Unit& u) const { return A + (size_t)u.pm * a_sm; }
    __device__ __forceinline__ const char* b_tile(const Unit& u) const { const int e = __builtin_amdgcn_readfirstlane(tile_e[u.pm]); return B + ((size_t)e * tiles_per_e + u.pn) * b_tile_bytes; }
};

constexpr int XSPLIT = 7, XK = 512, XROWS = 8 * 256;
constexpr float F8_HS = 8.f, F8_WS = 64.f, F8_OSC = 1.f / (F8_HS * F8_WS);
constexpr float F8_XS = 8.f, F8_GUS = 1.f / (F8_XS * F8_WS);
constexpr int XKE = XK / 2;
struct MoeSplitSched {
    int nX, G, c; const LAS int* tile_e; const char* A; size_t a_sm; const char* B; size_t b_tile_bytes;
    __device__ __forceinline__ bool next(int i, Unit& u) const { return grid_order(nX, 4 * XSPLIT, G, c, i, u); }
    __device__ __forceinline__ const char* a_tile(const Unit& u) const { return A + (size_t)u.pm * a_sm + (size_t)(u.pn >> 2) * (XK / 64) * 1024; }
    __device__ __forceinline__ const char* b_tile(const Unit& u) const { const int e = __builtin_amdgcn_readfirstlane(tile_e[u.pm]); return B + ((size_t)e * 4 + (u.pn & 3)) * b_tile_bytes + (size_t)(u.pn >> 2) * (XK / 64) * 1024; }
};
struct RowScale {
    const float* SSQ; int row_off; LAS float* SQ;
    __device__ __forceinline__ void pre_dma(const Unit& u, int slot, int wid, int lane) const {
        const float* g = SSQ + (size_t)(row_off + u.pm * BM) * 4 + wid * 64 + lane;
#pragma unroll
        for (int i = 0; i < 2; ++i) __builtin_amdgcn_global_load_lds((const unsigned*)(g + i * 512), (LAS unsigned*)(SQ + slot * 1024 + i * 512 + wid * 64), 4, 0, 0);
    }
    __device__ __forceinline__ float msq(int slot, int lrow) const { const f32x4 p = *(const LAS f32x4*)(SQ + slot * 1024 + lrow * 4); return ((p.x + p.y) + (p.z + p.w)) * (1.f / DM) + EPS; }
    __device__ __forceinline__ float get(int slot, int lrow) const { const f32x4 p = *(const LAS f32x4*)(SQ + slot * 1024 + lrow * 4); return __builtin_amdgcn_rsqf(((p.x + p.y) + (p.z + p.w)) * (1.f / DM) + EPS); }
};
template <typename TS> struct EpiResid {
    static constexpr bool PERM = true, PRE = false; static constexpr int NSTORE = 0;
    __device__ __forceinline__ void pre_dma(const Unit&, int, int, int) const {}
    const TS* src; bf16_t* XB; float* SSQ; int ld; int row_off; LAS float* P; float osc;
    __device__ __forceinline__ void operator()(const f32x4 (&acc)[2][2][4][2], const Unit& u, int wr, int wc, int fr, int fq, int) const {
        const int row0 = row_off + u.pm * BM + wr * 64 + fr, col0 = u.pn * BM + wc * 32 + 8 * fq;
#pragma unroll
        for (int ai = 0; ai < 2; ++ai)
#pragma unroll
            for (int m = 0; m < 4; ++m) { const size_t ro = (size_t)(row0 + ai * HALF + m * 16) * ld + col0; float ss = 0.f;
#pragma unroll
                for (int bj = 0; bj < 2; ++bj) { f32x4 v0, v1; ld8(src + ro + bj * HALF, v0, v1); v0 += acc[ai][bj][m][0] * osc; v1 += acc[ai][bj][m][1] * osc;
                        u32x4 w; w.x = cvt_pk_bf16(v0.x, v0.y); w.y = cvt_pk_bf16(v0.z, v0.w); w.z = cvt_pk_bf16(v1.x, v1.y); w.w = cvt_pk_bf16(v1.z, v1.w); *(u32x4*)(XB + ro + bj * HALF) = w;
                        ss += ((v0.x * v0.x + v0.y * v0.y) + (v0.z * v0.z + v0.w * v0.w)) + ((v1.x * v1.x + v1.y * v1.y) + (v1.z * v1.z + v1.w * v1.w)); }
                ss += __shfl_xor(ss, 16); ss += __shfl_xor(ss, 32);
                if (fq == 0) P[(ai * HALF + wr * 64 + m * 16 + fr) * 4 + wc] = ss; }
        asm volatile("s_waitcnt lgkmcnt(0)" ::: "memory"); __builtin_amdgcn_s_barrier(); asm volatile("" ::: "memory");
        const int t = opaque_tid();
        if (t < 256) { const f32x4 p = *(const LAS f32x4*)(P + t * 4); SSQ[(size_t)(row_off + u.pm * BM + t) * 4 + u.pn] = (p.x + p.y) + (p.z + p.w); }
    }
};
template <bool SCALE> struct EpiSwiGLU {
    static constexpr bool PERM = true, PRE = SCALE; static constexpr int NSTORE = 0;
    bf16_t* O; int ldc; RowScale R; unsigned* sink;
    __device__ __forceinline__ unsigned* dummy() const { return sink + (size_t)blockIdx.x * 4096; }
    __device__ __forceinline__ void pre_dma(const Unit& u, int slot, int wid, int lane) const { if (SCALE) R.pre_dma(u, slot, wid, lane); }
    __device__ __forceinline__ void operator()(const f32x4 (&acc)[2][2][4][2], const Unit& u, int wr, int wc, int fr, int fq, int slot) const {
        const int rb0 = u.pm * 16 + wr * 4, cb = u.pn * 2 + (wc >> 1), ncb = ldc >> 6;
        const int odd = fq & 1;
#pragma unroll
        for (int ai = 0; ai < 2; ++ai)
#pragma unroll
            for (int mp = 0; mp < 2; ++mp) {
                u32x2 wv[2];
#pragma unroll
                for (int mm = 0; mm < 2; ++mm) { const int m = 2 * mp + mm;
                    float nr = SCALE ? -1.44269504f : -1.44269504f * F8_GUS, ir2 = 1.f;
                    if (SCALE) { ir2 = R.msq(slot, ai * HALF + wr * 64 + m * 16 + fr); nr = -1.44269504f * __builtin_amdgcn_rsqf(ir2); }
                    u32x2 w = (u32x2){0u, 0u};
#pragma unroll
                    for (int n = 0; n < 2; ++n) {
#pragma unroll
                        for (int hh = 0; hh < 2; ++hh) { const f32x2 g = (f32x2){acc[ai][0][m][n][2 * hh], acc[ai][0][m][n][2 * hh + 1]}, u = (f32x2){acc[ai][1][m][n][2 * hh], acc[ai][1][m][n][2 * hh + 1]};
                            const f32x2 t = g * nr; f32x2 e; e.x = __builtin_amdgcn_exp2f(t.x); e.y = __builtin_amdgcn_exp2f(t.y);
                            f32x2 d; if (SCALE) d = e * ir2 + ir2; else d = e + 1.0f;
                            f32x2 q; q.x = __builtin_amdgcn_rcpf(d.x); q.y = __builtin_amdgcn_rcpf(d.y);
                            const f32x2 hv = (g * u) * q;
                            const f32x2 h8 = hv * (SCALE ? F8_HS : F8_HS * F8_GUS * F8_GUS);
                            if (n == 0 && hh == 0) w.x = (unsigned)__builtin_amdgcn_cvt_pk_fp8_f32(h8.x, h8.y, (int)w.x, false); else if (n == 0) w.x = (unsigned)__builtin_amdgcn_cvt_pk_fp8_f32(h8.x, h8.y, (int)w.x, true);
                            else if (hh == 0) w.y = (unsigned)__builtin_amdgcn_cvt_pk_fp8_f32(h8.x, h8.y, (int)w.y, false); else w.y = (unsigned)__builtin_amdgcn_cvt_pk_fp8_f32(h8.x, h8.y, (int)w.y, true); } }
                    wv[mm] = w; }
                const unsigned sx = odd ? wv[0].x : wv[1].x, sy = odd ? wv[0].y : wv[1].y;
                const unsigned rx = (unsigned)__shfl_xor((int)sx, 16), ry = (unsigned)__shfl_xor((int)sy, 16);
                u32x4 o; o.x = odd ? rx : wv[0].x; o.y = odd ? ry : wv[0].y; o.z = odd ? wv[1].x : rx; o.w = odd ? wv[1].y : ry;
                char* rowp = (char*)O + ((size_t)(rb0 + ai * 8 + 2 * mp + odd) * ncb + cb) * 1024 + fr * 64 + (wc & 1) * 32 + (fq & 2) * 8;
                *(u32x4*)rowp = o; }
    }
};
template <int ACT  , bool SCALE> struct EpiBf16 {
    static constexpr bool PERM = true, PRE = SCALE; static constexpr int NSTORE = 0;
    bf16_t* O; int ldc; RowScale R; float osc;
    __device__ __forceinline__ void pre_dma(const Unit& u, int slot, int wid, int lane) const { if (SCALE) R.pre_dma(u, slot, wid, lane); }
    __device__ __forceinline__ void operator()(const f32x4 (&acc)[2][2][4][2], const Unit& u, int wr, int wc, int fr, int fq, int slot) const {
        const int row0 = u.pm * BM + wr * 64 + fr, col0 = u.pn * BM + wc * 32 + 8 * fq;
#pragma unroll
        for (int ai = 0; ai < 2; ++ai)
#pragma unroll
            for (int m = 0; m < 4; ++m) { bf16_t* rowp = O + (size_t)(row0 + ai * HALF + m * 16) * ldc + col0;
                const float r = (SCALE ? R.get(slot, ai * HALF + wr * 64 + m * 16 + fr) : 1.f) * osc;
#pragma unroll
                for (int bj = 0; bj < 2; ++bj) { f32x4 v0 = acc[ai][bj][m][0] * r, v1 = acc[ai][bj][m][1] * r;
                    if (ACT == 1) {
#pragma unroll
                        for (int j = 0; j < 4; ++j) { v0[j] = silu_f(v0[j]); v1[j] = silu_f(v1[j]); } }
                    u32x4 w; w.x = cvt_pk_bf16(v0[0], v0[1]); w.y = cvt_pk_bf16(v0[2], v0[3]); w.z = cvt_pk_bf16(v1[0], v1[1]); w.w = cvt_pk_bf16(v1[2], v1[3]);
                    *(u32x4*)(rowp + bj * HALF) = w; } }
    }
};

struct EpiPart {
    static constexpr bool PERM = true, PRE = false; static constexpr int NSTORE = 0;
    bf16_t* P;
    __device__ __forceinline__ void pre_dma(const Unit&, int, int, int) const {}
    __device__ __forceinline__ void operator()(const f32x4 (&acc)[2][2][4][2], const Unit& u, int wr, int wc, int fr, int fq, int) const {
        const int row0 = u.pm * BM + wr * 64 + fr, col0 = (u.pn & 3) * BM + wc * 32 + 8 * fq; bf16_t* O = P + (size_t)(u.pn >> 2) * XROWS * DM;
#pragma unroll
        for (int ai = 0; ai < 2; ++ai)
#pragma unroll
            for (int m = 0; m < 4; ++m) { bf16_t* rowp = O + (size_t)(row0 + ai * HALF + m * 16) * DM + col0;
#pragma unroll
                for (int bj = 0; bj < 2; ++bj) { const f32x4 v0 = acc[ai][bj][m][0] * F8_OSC, v1 = acc[ai][bj][m][1] * F8_OSC;
                    u32x4 w; w.x = cvt_pk_bf16(v0[0], v0[1]); w.y = cvt_pk_bf16(v0[2], v0[3]); w.z = cvt_pk_bf16(v1[0], v1[1]); w.w = cvt_pk_bf16(v1[2], v1[3]);
                    *(u32x4*)(rowp + bj * HALF) = w; } }
    }
};

__device__ __forceinline__ int vt_pos_(int k) { return (k & ~12) | ((k & 4) << 1) | ((k & 8) >> 1); }
struct EpiKV {
    static constexpr bool PERM = true, PRE = true; static constexpr int NSTORE = 0;
    RowScale R; bf16_t* BLK; bf16_t* KF; bf16_t* VF; const LAS float* gain; const LAS float* pos;
    __device__ __forceinline__ void pre_dma(const Unit& u, int slot, int wid, int lane) const { R.pre_dma(u, slot, wid, lane); }
    __device__ __forceinline__ void operator()(const f32x4 (&acc)[2][2][4][2], const Unit& u, int wr, int wc, int fr, int fq, int slot) const {
        const int kind = u.pn, w = kind >> 1, g = wc;
#pragma unroll
        for (int ai = 0; ai < 2; ++ai)
#pragma unroll
            for (int m = 0; m < 4; ++m) {
                const int lrow = ai * HALF + wr * 64 + m * 16 + fr, row = u.pm * BM + lrow, b = row >> 11, t = row & 2047;
                const float rs = R.get(slot, lrow);
                f32x4 v[2][2];
#pragma unroll
                for (int bj = 0; bj < 2; ++bj)
#pragma unroll
                    for (int n = 0; n < 2; ++n) v[bj][n] = acc[ai][bj][m][n] * rs;
                if (kind < 2) {
#pragma unroll
                    for (int which = 0; which < 2; ++which) { const int c = (t >> 4) - which, l = (t & 15) + 16 * which;
                        if (c >= 0 && c < NCMP) { bf16_t* dst = BLK + ((size_t)kind * 16384 + (size_t)(b * NCMP + c) * 4 + g) * 2048 + l * 64;
#pragma unroll
                            for (int bj = 0; bj < 2; ++bj) { const int d0 = 32 * bj + 8 * fq; const LAS float* pp = pos + (kind * 32 + l) * 64 + d0;
                                const f32x4 p0 = *(const LAS f32x4*)pp, p1 = *(const LAS f32x4*)(pp + 4); const f32x4 x0 = v[bj][0] + p0, x1 = v[bj][1] + p1;
                                u32x4 o; o.x = cvt_pk_bf16(x0[0], x0[1]); o.y = cvt_pk_bf16(x0[2], x0[3]); o.z = cvt_pk_bf16(x1[0], x1[1]); o.w = cvt_pk_bf16(x1[2], x1[3]);
                                *(u32x4*)(dst + d0) = o; } } }
                } else if ((kind & 1) == 0) {
                    float ss = 0.f;
#pragma unroll
                    for (int bj = 0; bj < 2; ++bj)
#pragma unroll
                        for (int n = 0; n < 2; ++n) ss += (v[bj][n][0] * v[bj][n][0] + v[bj][n][1] * v[bj][n][1]) + (v[bj][n][2] * v[bj][n][2] + v[bj][n][3] * v[bj][n][3]);
                    ss += __shfl_xor(ss, 16); ss += __shfl_xor(ss, 32);
                    const float rn = __builtin_amdgcn_rsqf(ss * (1.f / 64.f) + EPS);
                    const int kk = t & 63; bf16_t* tile = KF + (((size_t)(w - 1) * 128 + b * 4 + g) * 32 + (t >> 6)) * 4096;
#pragma unroll
                    for (int bj = 0; bj < 2; ++bj) { const int d0 = 32 * bj + 8 * fq; const LAS float* gp = gain + w * 64 + d0;
                        const f32x4 g0 = *(const LAS f32x4*)gp, g1 = *(const LAS f32x4*)(gp + 4); const f32x4 x0 = v[bj][0] * rn * g0, x1 = v[bj][1] * rn * g1;
                        u32x4 o; o.x = cvt_pk_bf16(x0[0], x0[1]); o.y = cvt_pk_bf16(x0[2], x0[3]); o.z = cvt_pk_bf16(x1[0], x1[1]); o.w = cvt_pk_bf16(x1[2], x1[3]);
                        *(u32x4*)(tile + (((kk >> 5) * 4 + (d0 >> 4)) * 64 + ((d0 >> 3) & 1) * 32 + (kk & 31)) * 8) = o; }
                } else {
                    const int kk = t & 63, ps = vt_pos_(kk); bf16_t* tile = VF + (((size_t)(w - 1) * 128 + b * 4 + g) * 32 + (t >> 6)) * 4096 + (((ps >> 4) * 2) * 64 + ((ps >> 3) & 1) * 32) * 8 + (ps & 7);
#pragma unroll
                    for (int bj = 0; bj < 2; ++bj)
#pragma unroll
                        for (int n = 0; n < 2; ++n)
#pragma unroll
                            for (int jj = 0; jj < 4; ++jj) { const int cc = 8 * fq + 4 * n + jj;
                                tile[(bj * 64 + cc) * 8] = (bf16_t)(cvt_pk_bf16(v[bj][n][jj], 0.f) & 0xffffu); }
                } }
    }
};
struct EpiQG {
    static constexpr bool PERM = true, PRE = true; static constexpr int NSTORE = 0;
    RowScale R; bf16_t* Q; int ldq; const LAS float* gain; float qscale;
    __device__ __forceinline__ void pre_dma(const Unit& u, int slot, int wid, int lane) const { R.pre_dma(u, slot, wid, lane); }
    __device__ __forceinline__ void operator()(const f32x4 (&acc)[2][2][4][2], const Unit& u, int wr, int wc, int fr, int fq, int slot) const {
#pragma unroll
        for (int ai = 0; ai < 2; ++ai)
#pragma unroll
            for (int m = 0; m < 4; ++m) {
                const int lrow = ai * HALF + wr * 64 + m * 16 + fr, row = u.pm * BM + lrow;
                const float rs = R.get(slot, lrow);
                f32x4 v[2][2];
#pragma unroll
                for (int bj = 0; bj < 2; ++bj)
#pragma unroll
                    for (int n = 0; n < 2; ++n) v[bj][n] = acc[ai][bj][m][n] * rs;
                if (u.pn < 4) {
                    float ss = 0.f;
#pragma unroll
                    for (int bj = 0; bj < 2; ++bj)
#pragma unroll
                        for (int n = 0; n < 2; ++n) ss += (v[bj][n][0] * v[bj][n][0] + v[bj][n][1] * v[bj][n][1]) + (v[bj][n][2] * v[bj][n][2] + v[bj][n][3] * v[bj][n][3]);
                    ss += __shfl_xor(ss, 16); ss += __shfl_xor(ss, 32);
                    const float rn = qscale * __builtin_amdgcn_rsqf(ss * (1.f / 64.f) + EPS);
                    bf16_t* dst = Q + (size_t)row * ldq + (4 * u.pn + wc) * 64;
#pragma unroll
                    for (int bj = 0; bj < 2; ++bj) { const int d0 = 32 * bj + 8 * fq; const LAS float* gp = gain + d0;
                        const f32x4 g0 = *(const LAS f32x4*)gp, g1 = *(const LAS f32x4*)(gp + 4); const f32x4 x0 = v[bj][0] * rn * g0, x1 = v[bj][1] * rn * g1;
                        u32x4 o; o.x = cvt_pk_bf16(x0[0], x0[1]); o.y = cvt_pk_bf16(x0[2], x0[3]); o.z = cvt_pk_bf16(x1[0], x1[1]); o.w = cvt_pk_bf16(x1[2], x1[3]);
                        *(u32x4*)(dst + d0) = o; }
                } else {
#pragma unroll
                    for (int bj = 0; bj < 2; ++bj) { const int o0 = 64 * wc + 32 * bj + 8 * fq;
                        if (o0 < 48) { u32x4 o; o.x = cvt_pk_bf16(v[bj][0][0], v[bj][0][1]); o.y = cvt_pk_bf16(v[bj][0][2], v[bj][0][3]); o.z = cvt_pk_bf16(v[bj][1][0], v[bj][1][1]); o.w = cvt_pk_bf16(v[bj][1][2], v[bj][1][3]);
                            *(u32x4*)(Q + (size_t)row * ldq + 1024 + o0) = o; } }
                } }
    }
};

struct EpiCmp2 {
    static constexpr bool PERM = true, PRE = false; static constexpr int NSTORE = 0;
    float* CMP;
    __device__ __forceinline__ void pre_dma(const Unit&, int, int, int) const {}
    __device__ __forceinline__ void operator()(const f32x4 (&acc)[2][2][4][2], const Unit& u, int wr, int wc, int fr, int fq, int) const {
        if (wc != 0) return;
#pragma unroll
        for (int ai = 0; ai < 2; ++ai)
#pragma unroll
            for (int m = 0; m < 4; ++m) { float* rowp = CMP + (size_t)(u.pm * BM + ai * HALF + wr * 64 + m * 16 + fr) * 64 + 8 * fq;
#pragma unroll
                for (int bj = 0; bj < 2; ++bj) { *(f32x4*)(rowp + 32 * bj) = acc[ai][bj][m][0]; *(f32x4*)(rowp + 32 * bj + 4) = acc[ai][bj][m][1]; } }
    }
};

struct NoHook { static constexpr bool ON = false; __device__ __forceinline__ void operator()() const {} };
template <class Epi, class Sched, class Hook = NoHook, bool ATILED = false, bool FP8 = false>
__device__ __forceinline__ void gemm_phase(LAS unsigned char* lds, const Gemm g, const Sched& S, const Epi& E, const Hook hook = Hook()) {
    const int tid = opaque_tid(), wid = __builtin_amdgcn_readfirstlane(tid >> 6), lane = tid & 63, wr = wid >> 2, wc = wid & 3, fr = lane & 15, fq = lane >> 4;
    int nt = g.K / BK; asm volatile("" : "+s"(nt));
    unsigned voffA[2], voffB[2];
#pragma unroll
    for (int i = 0; i < 2; ++i) { int R, C; stage_rc(tid * 16 + i * 8192, R, C); const int Rb = Epi::PERM ? ((R & ~31) + perm32(R & 31)) : R;
        voffA[i] = ATILED ? (unsigned)((((R >> 4) * (g.lda >> 5) + (C >> 5)) << 10) + (R & 15) * 64 + (C & 31) * 2) : (unsigned)(R * g.lda + C) * 2u;
        static_assert(Epi::PERM, "the converted weights are stored in the PERM row order"); (void)Rb;
        voffB[i] = (unsigned)((((R >> 4) * (g.ldb >> 5) + (C >> 5)) << 10) + (R & 15) * 64 + (C & 31) * 2); }
    const size_t voffA_step = ATILED ? (size_t)4 * (g.lda >> 5) * 1024 : (size_t)64 * g.lda * 2, voffB_step = (size_t)4 * (g.ldb >> 5) * 1024;
    const size_t kstep = (size_t)2048, kstepA = ATILED ? (size_t)2048 : (size_t)(BK * 2);
    const size_t hstepA = ATILED ? (size_t)(HALF / 16) * (g.lda >> 5) * 1024 : (size_t)HALF * g.lda * 2, hstepB = (size_t)(HALF / 16) * (g.ldb >> 5) * 1024;
    const unsigned ldsw = (unsigned)wid * 1024u;
    const int lanep = lds_byte(fr, fq * 8), aoffs = wr * 8192, boffs = wc * 4096;
#define aoff (__extension__({ int o_ = lanep; asm volatile("" : "+v"(o_)); o_ + aoffs; }))
#define boff (__extension__({ int o_ = lanep; asm volatile("" : "+v"(o_)); o_ + boffs; }))
#define PG8_SA(b, h) (((b) * 2 + (h)) * HTB)
#define PG8_SB(b, h) ((4 + (b) * 2 + (h)) * HTB)
#define PG8_STAGE(bufoff, gbase, voff) do { _Pragma("unroll") for (int _i = 0; _i < 2; ++_i) \
        { unsigned vo_ = (voff)[0]; asm volatile("" : "+v"(vo_)); __builtin_amdgcn_global_load_lds((const unsigned*)((const char*)(gbase) + _i * voff##_step + vo_), (LAS unsigned*)(lds + (bufoff) + ldsw + _i * 8192), 16, 0, 0); } } while (0)
#define PG8_LDA(dst, b, h) do { const int aoff_ = aoff; _Pragma("unroll") for (int m = 0; m < 4; ++m) { \
        if constexpr (FP8) { const v4i32 l_ = *(const LAS v4i32*)(lds + PG8_SA(b, h) + aoff_ + m * 2048), h_ = *(const LAS v4i32*)(lds + PG8_SA(b, h) + aoff_ + m * 2048 + 1024); dst##8[m] = __builtin_shufflevector(l_, h_, 0, 1, 2, 3, 4, 5, 6, 7); } \
        else { _Pragma("unroll") for (int k = 0; k < 2; ++k) dst[m][k] = *(const LAS bf16x8*)(lds + PG8_SA(b, h) + aoff_ + m * 2048 + k * 1024); } } } while (0)
#define PG8_LDB(dst, b, h) do { const int boff_ = boff; _Pragma("unroll") for (int n = 0; n < 2; ++n) { \
        if constexpr (FP8) { const v4i32 l_ = *(const LAS v4i32*)(lds + PG8_SB(b, h) + boff_ + n * 2048), h_ = *(const LAS v4i32*)(lds + PG8_SB(b, h) + boff_ + n * 2048 + 1024); dst##8[n] = __builtin_shufflevector(l_, h_, 0, 1, 2, 3, 4, 5, 6, 7); } \
        else { _Pragma("unroll") for (int k = 0; k < 2; ++k) dst[n][k] = *(const LAS bf16x8*)(lds + PG8_SB(b, h) + boff_ + n * 2048 + k * 1024); } } } while (0)
#define PG8_MMA(ai, bj, At, Bt) do { __builtin_amdgcn_s_setprio(1); _Pragma("unroll") for (int m = 0; m < 4; ++m) _Pragma("unroll") for (int n = 0; n < 2; ++n) { \
        if constexpr (FP8) { acc[ai][bj][m][n] = __builtin_amdgcn_mfma_scale_f32_16x16x128_f8f6f4(Bt##8[n], At##8[m], acc[ai][bj][m][n], 0, 0, 0, 0x7f7f7f7f, 0, 0x7f7f7f7f); } \
        else { _Pragma("unroll") for (int k = 0; k < 2; ++k) acc[ai][bj][m][n] = __builtin_amdgcn_mfma_f32_16x16x32_bf16(Bt[n][k], At[m][k], acc[ai][bj][m][n], 0, 0, 0); } } \
        __builtin_amdgcn_s_setprio(0); } while (0)
#define PG8_WAIT_V(n) asm volatile("s_waitcnt vmcnt(" #n ")" ::: "memory")
#define PG8_WAIT_L(n) asm volatile("s_waitcnt lgkmcnt(" #n ")" ::: "memory")
#define PG8_BAR __builtin_amdgcn_s_barrier()
#define PG8_SCHED __builtin_amdgcn_sched_barrier(0)
    Unit cur, nxt; int ui = 0;
    static_assert(Epi::NSTORE == 0 || Epi::NSTORE == 8, "the relaxed waits are written for 8 epilogue stores");
    if (!S.next(0, cur)) { if constexpr (Hook::ON) hook(); return; }
    f32x4 acc[2][2][4][2];
#pragma unroll
    for (int a = 0; a < 2; ++a)
#pragma unroll
        for (int b = 0; b < 2; ++b)
#pragma unroll
            for (int m = 0; m < 4; ++m)
#pragma unroll
                for (int n = 0; n < 2; ++n) acc[a][b][m][n] = (f32x4){0.f, 0.f, 0.f, 0.f};
    bf16x8 At[4][2], B0[2][2], B1[2][2]; v8i32 At8[4], B08[2], B18[2];
    const char* cA = S.a_tile(cur); const char* cB = S.b_tile(cur);
    if constexpr (Epi::PRE) E.pre_dma(cur, 0, wid, lane);
    PG8_STAGE(PG8_SB(0, 0), cB, voffB); PG8_STAGE(PG8_SB(0, 1), cB + hstepB, voffB); PG8_STAGE(PG8_SA(0, 0), cA, voffA); PG8_STAGE(PG8_SA(0, 1), cA + hstepA, voffA);
    if (wr == 1) PG8_BAR;
    PG8_WAIT_V(2); PG8_BAR;
    PG8_STAGE(PG8_SB(1, 0), cB + kstep, voffB); PG8_STAGE(PG8_SA(1, 0), cA + kstepA, voffA); PG8_STAGE(PG8_SB(1, 1), cB + hstepB + kstep, voffB);
    PG8_WAIT_V(6); PG8_BAR;
    if constexpr (Epi::NSTORE == 8) {
        PG8_STAGE(PG8_SA(1, 1), cA + kstepA + hstepA, voffA);
        unsigned* dz = E.dummy() + tid;
#pragma unroll
        for (int i = 0; i < 8; ++i) __builtin_nontemporal_store(0u, dz + i * 512); }
    for (;;) {
        const bool has_next = S.next(ui + 1, nxt);
        const char* nA = has_next ? S.a_tile(nxt) : cA; const char* nB = has_next ? S.b_tile(nxt) : cB;
        int t = 0;
        if constexpr (Epi::NSTORE == 8) {
            const bool last = (t == nt - 2);
            const char* a2 = last ? nA : cA + (size_t)(t + 2) * kstepA; const char* b2 = last ? nB : cB + (size_t)(t + 2) * kstep;
            const char* a3 = a2 + kstepA; const char* b3 = b2 + kstep;
            if constexpr (Epi::PRE) { if (last && has_next) E.pre_dma(nxt, (ui + 1) & 1, wid, lane); }
            PG8_LDB(B0, 0, 0); PG8_LDB(B1, 0, 1); PG8_SCHED; PG8_LDA(At, 0, 0);
            PG8_WAIT_V(16); PG8_WAIT_L(0); PG8_BAR; PG8_MMA(0, 0, At, B0); PG8_MMA(0, 1, At, B1); PG8_BAR; PG8_SCHED;
            PG8_LDA(At, 0, 1); PG8_STAGE(PG8_SB(0, 0), b2, voffB); PG8_STAGE(PG8_SB(0, 1), b2 + hstepB, voffB); PG8_STAGE(PG8_SA(0, 0), a2, voffA);
            PG8_WAIT_V(16); PG8_WAIT_L(0); PG8_BAR; PG8_MMA(1, 0, At, B0); PG8_MMA(1, 1, At, B1); PG8_BAR; PG8_SCHED;
            PG8_LDB(B0, 1, 0); PG8_LDB(B1, 1, 1); PG8_SCHED; PG8_LDA(At, 1, 0); PG8_STAGE(PG8_SA(0, 1), a2 + hstepA, voffA);
            PG8_WAIT_V(16); PG8_WAIT_L(0); PG8_BAR; PG8_MMA(0, 0, At, B0); PG8_MMA(0, 1, At, B1); PG8_BAR; PG8_SCHED;
            PG8_LDA(At, 1, 1); PG8_STAGE(PG8_SB(1, 0), b3, voffB); PG8_STAGE(PG8_SB(1, 1), b3 + hstepB, voffB); PG8_STAGE(PG8_SA(1, 0), a3, voffA);
            PG8_WAIT_V(8); PG8_WAIT_L(0); PG8_BAR; PG8_MMA(1, 0, At, B0); PG8_MMA(1, 1, At, B1); PG8_BAR; PG8_SCHED;
            t = 2; }
        for (; t < nt; t += 2) {
            const bool last = (t == nt - 2);
            const char* a1 = cA + (size_t)(t + 1) * kstepA;
            const char* a2 = last ? nA : cA + (size_t)(t + 2) * kstepA; const char* b2 = last ? nB : cB + (size_t)(t + 2) * kstep;
            const char* a3 = a2 + kstepA; const char* b3 = b2 + kstep;
            if constexpr (Epi::PRE) { if (last && has_next) E.pre_dma(nxt, (ui + 1) & 1, wid, lane); }
            PG8_LDB(B0, 0, 0); PG8_LDB(B1, 0, 1); PG8_SCHED; PG8_LDA(At, 0, 0); PG8_STAGE(PG8_SA(1, 1), a1 + hstepA, voffA);
            PG8_WAIT_V(8); PG8_WAIT_L(0); PG8_BAR; PG8_MMA(0, 0, At, B0); PG8_MMA(0, 1, At, B1); PG8_BAR; PG8_SCHED;
            PG8_LDA(At, 0, 1); PG8_STAGE(PG8_SB(0, 0), b2, voffB); PG8_STAGE(PG8_SB(0, 1), b2 + hstepB, voffB); PG8_STAGE(PG8_SA(0, 0), a2, voffA);
            PG8_WAIT_V(8); PG8_WAIT_L(0); PG8_BAR; PG8_MMA(1, 0, At, B0); PG8_MMA(1, 1, At, B1); PG8_BAR; PG8_SCHED;
            PG8_LDB(B0, 1, 0); PG8_LDB(B1, 1, 1); PG8_SCHED; PG8_LDA(At, 1, 0); PG8_STAGE(PG8_SA(0, 1), a2 + hstepA, voffA);
            PG8_WAIT_V(8); PG8_WAIT_L(0); PG8_BAR; PG8_MMA(0, 0, At, B0); PG8_MMA(0, 1, At, B1); PG8_BAR; PG8_SCHED;
            PG8_LDA(At, 1, 1); PG8_STAGE(PG8_SB(1, 0), b3, voffB); PG8_STAGE(PG8_SB(1, 1), b3 + hstepB, voffB); PG8_STAGE(PG8_SA(1, 0), a3, voffA);
            PG8_WAIT_V(8); PG8_WAIT_L(0); PG8_BAR; PG8_MMA(1, 0, At, B0); PG8_MMA(1, 1, At, B1); PG8_BAR; PG8_SCHED;
        }
        if (wr == 0) PG8_BAR;
        if constexpr (Hook::ON) { if (ui == 0) hook(); }
        if constexpr (Epi::NSTORE == 8) {
            if (has_next) PG8_STAGE(PG8_SA(1, 1), nA + kstepA + hstepA, voffA); }
        { const int tz = opaque_tid(), lz = tz & 63;
          E(acc, cur, wr, wc, lz & 15, lz >> 4, ui & 1); }
        if (!has_next) break;
#pragma unroll
        for (int a = 0; a < 2; ++a)
#pragma unroll
            for (int b = 0; b < 2; ++b)
#pragma unroll
                for (int m = 0; m < 4; ++m)
#pragma unroll
                    for (int n = 0; n < 2; ++n) acc[a][b][m][n] = (f32x4){0.f, 0.f, 0.f, 0.f};
        cur = nxt; cA = nA; cB = nB; ++ui;
        if (wr == 1) PG8_BAR;
    }
    PG8_WAIT_V(0);
    PG8_BAR;
#undef PG8_SA
#undef PG8_SB
#undef PG8_STAGE
#undef PG8_LDA
#undef PG8_LDB
#undef PG8_MMA
#undef PG8_WAIT_V
#undef PG8_WAIT_L
#undef PG8_BAR
#undef PG8_SCHED
#undef aoff
#undef boff
}
}

#define XB_TMO      128
#define XB_XCNT(j)  (256  + 64 * (j))
#define XB_XSUB(j)  (1280 + 64 * (j))
#define XB_XGEN(j)  (2304 + 64 * (j))
#define XB_TOP      3328
#define XB_TOPGEN   3392
#define XCD_BAR_WORDS 3456
#define XB_SPIN_CAP (1u << 22)
__device__ __forceinline__ unsigned xb_ld(unsigned* p)              { return __hip_atomic_load(p, __ATOMIC_RELAXED, __HIP_MEMORY_SCOPE_AGENT); }
__device__ __forceinline__ unsigned xb_add(unsigned* p, unsigned v) { return __hip_atomic_fetch_add(p, v, __ATOMIC_RELAXED, __HIP_MEMORY_SCOPE_AGENT); }
__device__ __forceinline__ unsigned xb_xcc_id() { return (unsigned)__builtin_amdgcn_s_getreg((3 << 11) | 20) & 0xFu; }
#define XB_SPIN(cond, bar) do { unsigned _sp = 0; while (cond) { __builtin_amdgcn_s_sleep(1); \
    if ((++_sp & 255u) == 0u) { if (xb_ld(&(bar)[XB_TMO])) break; if (_sp > XB_SPIN_CAP) { atomicAdd(&(bar)[XB_TMO], 1u); break; } } } } while (0)
struct XcdBarrier { unsigned* bar; unsigned x; volatile LAS unsigned* st; };
__device__ __forceinline__ XcdBarrier xcd_barrier_post(unsigned* bar, volatile LAS unsigned* st) {
    XcdBarrier b; b.bar = bar; b.x = xb_xcc_id(); b.st = st;
    if (threadIdx.x == 0) (void)xb_add(&bar[XB_XCNT(b.x)], 1u);
    return b;
}
__device__ __forceinline__ void xcd_barrier_complete(unsigned* bar, unsigned x, unsigned& nloc, unsigned& nx) {
    const unsigned G = gridDim.x * gridDim.y * gridDim.z;
    unsigned sum, cnt, mine, sp = 0u;
    for (;;) {
        sum = 0u; cnt = 0u; mine = 0u;
#pragma unroll
        for (unsigned j = 0; j < 16; ++j) { const unsigned c = xb_ld(&bar[XB_XCNT(j)]); sum += c; cnt += (c > 0u) ? 1u : 0u; mine = (j == x) ? c : mine; }
        if (sum == G) break;
        __builtin_amdgcn_s_sleep(1);
        if ((++sp & 255u) == 0u) { if (xb_ld(&bar[XB_TMO])) break; if (sp > XB_SPIN_CAP) { atomicAdd(&bar[XB_TMO], 1u); break; } }
    }
    nloc = mine > 0u ? mine : 1u; nx = cnt > 0u ? cnt : 1u;
}
__device__ __forceinline__ void xcd_barrier(const XcdBarrier& b) {
    asm volatile("s_waitcnt vmcnt(0)" ::: "memory");
    __syncthreads();
    if (threadIdx.x == 0) {
        unsigned* bar = b.bar;
        __builtin_amdgcn_s_waitcnt(0);
        unsigned nloc = b.st[0], nx = b.st[1];
        if (nloc == 0u) { xcd_barrier_complete(bar, b.x, nloc, nx); b.st[0] = nloc; b.st[1] = nx; }
        const unsigned old = xb_add(&bar[XB_XSUB(b.x)], 1u);
        const unsigned gen = old / nloc;
        if (old + 1u == (gen + 1u) * nloc) {
            __builtin_amdgcn_fence(__ATOMIC_RELEASE, "agent");
            asm volatile("s_waitcnt vmcnt(0)" ::: "memory");
            const unsigned og = xb_add(&bar[XB_TOP], 1u);
            const unsigned tg = og / nx;
            if (og + 1u == (tg + 1u) * nx) xb_add(&bar[XB_TOPGEN], 1u);
            else XB_SPIN(xb_ld(&bar[XB_TOPGEN]) == tg, bar);
            __builtin_amdgcn_fence(__ATOMIC_ACQUIRE, "agent");
            xb_add(&bar[XB_XGEN(b.x)], 1u);
            asm volatile("s_waitcnt vmcnt(0)" ::: "memory");
        } else {
            XB_SPIN((int)(xb_ld(&bar[XB_XGEN(b.x)]) - (gen + 1u)) < 0, bar);
            __builtin_amdgcn_fence(__ATOMIC_ACQUIRE, "agent");
            asm volatile("s_waitcnt vmcnt(0)" ::: "memory");
        }
    }
    __syncthreads();
}
__device__ __forceinline__ void xcd_arrive(const XcdBarrier& b) {
    asm volatile("s_waitcnt vmcnt(0)" ::: "memory");
    __syncthreads();
    if (threadIdx.x == 0) {
        unsigned* bar = b.bar;
        __builtin_amdgcn_s_waitcnt(0);
        unsigned nloc = b.st[0], nx = b.st[1];
        if (nloc == 0u) { xcd_barrier_complete(bar, b.x, nloc, nx); b.st[0] = nloc; b.st[1] = nx; }
        const unsigned old = xb_add(&bar[XB_XSUB(b.x)], 1u);
        const unsigned gen = old / nloc;
        unsigned leader = 0u;
        if (old + 1u == (gen + 1u) * nloc) {
            leader = 1u;
            __builtin_amdgcn_fence(__ATOMIC_RELEASE, "agent");
            asm volatile("s_waitcnt vmcnt(0)" ::: "memory");
            const unsigned og = xb_add(&bar[XB_TOP], 1u);
            const unsigned tg = og / nx;
            if (og + 1u == (tg + 1u) * nx) xb_add(&bar[XB_TOPGEN], 1u);
        }
        b.st[2] = gen; b.st[3] = leader;
    }
}
__device__ __forceinline__ void xcd_wait_arrived(const XcdBarrier& b) {
    if (threadIdx.x == 0) {
        unsigned* bar = b.bar; const unsigned gen = b.st[2], leader = b.st[3];
        XB_SPIN((int)(xb_ld(&bar[XB_TOPGEN]) - (gen + 1u)) < 0, bar);
        __builtin_amdgcn_fence(__ATOMIC_ACQUIRE, "agent");
        if (leader) xb_add(&bar[XB_XGEN(b.x)], 1u);
        asm volatile("s_waitcnt vmcnt(0)" ::: "memory");
    }
    __syncthreads();
}

constexpr size_t CTL_GRP = 32 * 1024, CTL_XMASK = 36 * 1024;
__device__ __forceinline__ void group_barrier(const XcdBarrier& b, int cid) {
    asm volatile("s_waitcnt vmcnt(0)" ::: "memory");
    __syncthreads();
    if (threadIdx.x == 0) {
        unsigned* bar = b.bar; const unsigned* xm = bar + CTL_XMASK / 4; unsigned ok = (gridDim.x == 256u) ? 1u : 0u;
#pragma unroll
        for (int j = 0; j < 8; ++j) { const unsigned mk = xb_ld((unsigned*)&xm[j]); ok &= (mk != 0u && (mk & (mk - 1u)) == 0u) ? 1u : 0u; }
        b.st[4] = ok;
        if (ok) {
            unsigned* cnt = bar + CTL_GRP / 4 + (cid & 7) * 64;
            __builtin_amdgcn_s_waitcnt(0);
            const unsigned old = xb_add(cnt, 1u), target = (old / 32u + 1u) * 32u;
            XB_SPIN((int)(xb_ld(cnt) - target) < 0, bar);
            __builtin_amdgcn_fence(__ATOMIC_ACQUIRE, "agent");
            asm volatile("s_waitcnt vmcnt(0)" ::: "memory");
        }
    }
    __syncthreads();
    if (!b.st[4]) xcd_barrier(b);
}
struct WaitHook { static constexpr bool ON = true; bool on; unsigned* bar; volatile LAS unsigned* st;
    __device__ __forceinline__ void operator()() const { if (on) { XcdBarrier bw; bw.bar = bar; bw.x = xb_xcc_id(); bw.st = st; xcd_wait_arrived(bw); } } };

constexpr int NWAVES = 8, NTHREADS = 512;
constexpr int RING_BYTES = 131072, MISC_OFF = RING_BYTES, LDS_BYTES = 163840;
constexpr int LX_P = 1024, LX_SQ = 5120, LX_GAIN = 13312, LX_POS = 16384;

struct Args { const float* in[22]; float* out; unsigned char* ws; int ph_lo, ph_hi; };
enum { I_X = 0, I_RELB, I_NMIX, I_NFFN, I_POOLW, I_POOLS, I_NKV, I_WKV, I_GK, I_CPOS, I_CW1, I_CW2, I_WQG, I_GQ, I_WO, I_FWG, I_FWU, I_FWD, I_ROUTER, I_MWG, I_MWU, I_MWD };

__device__ __forceinline__ void cvt_item(const float* src, int ld, int nvalid, const float* rowgain, const float* colscale, bf16_t* dst, int K, int k0, LAS float* scr, int lane, bool f8 = false) {
    { const int q = lane & 7, r = lane >> 3;
      f32x4 v[8];
#pragma unroll
      for (int i = 0; i < 8; ++i) { const int kk = 8 * i + r; v[i] = (f32x4){0.f, 0.f, 0.f, 0.f};
          if (4 * q < nvalid) { v[i] = *(const f32x4*)(src + (size_t)(k0 + kk) * ld + 4 * q); if (rowgain) v[i] *= rowgain[k0 + kk]; } }
#pragma unroll
      for (int i = 0; i < 8; ++i) { LAS float* d = scr + (8 * i + r) * 33 + 4 * q; d[0] = v[i].x; d[1] = v[i].y; d[2] = v[i].z; d[3] = v[i].w; } }
    asm volatile("s_waitcnt lgkmcnt(0)" ::: "memory");
    const int c = lane & 7;
#pragma unroll
    for (int j = 0; j < 4; ++j) { const int n = (lane >> 3) + 8 * j; const LAS float* s = scr + (8 * c) * 33 + n;
        const float cs = (colscale && n < nvalid) ? colscale[n] : 1.f;
        u32x4 o; o.x = pk2(s[0 * 33] * cs, s[1 * 33] * cs); o.y = pk2(s[2 * 33] * cs, s[3 * 33] * cs); o.z = pk2(s[4 * 33] * cs, s[5 * 33] * cs); o.w = pk2(s[6 * 33] * cs, s[7 * 33] * cs);
        const int np = 16 * ((n >> 2) & 1) + (((n >> 3) << 2) | (n & 3)), kc = k0 + 8 * c;
        if (!f8) *(u32x4*)((char*)dst + ((size_t)((np >> 4) * (K >> 5) + (kc >> 5)) << 10) + (np & 15) * 64 + (kc & 31) * 2) = o;
        else { const float ws = cs * pg8::F8_WS;
            int lo = __builtin_amdgcn_cvt_pk_fp8_f32(s[0 * 33] * ws, s[1 * 33] * ws, 0, false); lo = __builtin_amdgcn_cvt_pk_fp8_f32(s[2 * 33] * ws, s[3 * 33] * ws, lo, true);
            int hi = __builtin_amdgcn_cvt_pk_fp8_f32(s[4 * 33] * ws, s[5 * 33] * ws, 0, false); hi = __builtin_amdgcn_cvt_pk_fp8_f32(s[6 * 33] * ws, s[7 * 33] * ws, hi, true);
            *(u32x2*)((char*)dst + ((size_t)((np >> 4) * (K >> 6) + (kc >> 6)) << 10) + (np & 15) * 64 + (kc & 63)) = (u32x2){(unsigned)lo, (unsigned)hi}; } }
    asm volatile("s_waitcnt lgkmcnt(0)" ::: "memory");
}
__device__ __forceinline__ void cvt_plain(const float* src, int K, int N, const float* rowgain, const float* colscale, bf16_t* dst, int item, LAS float* scr, int lane, bool f8 = false) {
    const int nblk = N / 32, kb = item / nblk, nb = item % nblk;
    cvt_item(src + nb * 32, N, 32, rowgain, colscale ? colscale + nb * 32 : nullptr, f8 ? (bf16_t*)((char*)dst + (size_t)nb * 32 * K) : dst + (size_t)nb * 32 * K, K, kb * 64, scr, lane, f8);
}
__device__ __forceinline__ void cvt_gu(const float* wg, const float* wu, const float* rowgain, bf16_t* dst, int item, LAS float* scr, int lane, bool f8 = false) {
    constexpr int nblk = 7168 / 32; const int kb = item / nblk, nb = item % nblk, np = nb * 32, p = np >> 8, b = (np >> 7) & 1, j0 = np & 127;
    cvt_item((b ? wu : wg) + p * 128 + j0, FFD, 32, rowgain, nullptr, f8 ? (bf16_t*)((char*)dst + (size_t)np * DM) : dst + (size_t)np * DM, DM, kb * 64, scr, lane, f8);
}
__device__ __forceinline__ void cvt_qg(const float* w, const float* rowgain, bf16_t* dst, int item, LAS float* scr, int lane) {
    constexpr int nblk = 1280 / 32; const int kb = item / nblk, nb = item % nblk, np = nb * 32;
    int nvalid = 1072 - np; nvalid = nvalid < 0 ? 0 : (nvalid > 32 ? 32 : nvalid);
    cvt_item(w + np, 1072, nvalid, rowgain, nullptr, dst + (size_t)np * DM, DM, kb * 64, scr, lane);
}
__device__ __forceinline__ void cvt_headperm(const float* w, int ld, int ncols, const float* rowgain, bf16_t* dst, int K, int nblk, int item, LAS float* scr, int lane) {
    const int kb = item / nblk, nb = item % nblk, np = nb * 32, tile = np >> 8, bj = (np >> 7) & 1, wc = (np >> 5) & 3, o = tile * 256 + 64 * wc + 32 * bj;
    int nvalid = ncols - o; nvalid = nvalid < 0 ? 0 : (nvalid > 32 ? 32 : nvalid);
    cvt_item(w + o, ld, nvalid, rowgain, nullptr, dst + (size_t)np * K, K, kb * 64, scr, lane);
}
constexpr int IT_POOL = 8 * 32, IT_GU = 16 * 224, IT_D = 56 * 32, IT_KV = 16 * 48, IT_QG = 16 * 40, IT_O = 16 * 32, IT_C1 = 32 * 8;
constexpr int IT_C2 = 4 * 8;
constexpr int IT_STATIC = IT_POOL + 2 * IT_GU + 2 * IT_D + IT_KV + 2 * IT_QG + 2 * IT_O + 2 * IT_C1 + 2 * IT_C2;
__device__ __forceinline__ void p_convert_static(const Args& a, LAS unsigned char* lds) {
    const int tz = opaque_tid(), lane = tz & 63, wave = tz >> 6;
    LAS float* scr = (LAS float*)(lds + wave * 16384);
    unsigned char* ws = a.ws;
    for (int it = blockIdx.x * NWAVES + wave; it < IT_STATIC; it += gridDim.x * NWAVES) {
        int r = it;
        if (r < IT_POOL) { const int mg = r / 32, L = mg >> 2, g = mg & 3;
            cvt_plain(a.in[I_POOLW] + (size_t)mg * 65536, 256, 256, a.in[I_NMIX] + L * DM + g * 256, a.in[I_POOLS] + L * DM + g * 256, (bf16_t*)(ws + W_POOL) + (size_t)mg * 65536, r % 32, scr, lane); continue; } r -= IT_POOL;
        if (r < 2 * IT_GU) { const int i = r / IT_GU;
            cvt_gu(a.in[I_FWG] + (size_t)i * DM * FFD, a.in[I_FWU] + (size_t)i * DM * FFD, a.in[I_NFFN] + (2 * i) * DM, (bf16_t*)(ws + W_GU) + (size_t)i * 7168 * DM, r % IT_GU, scr, lane); continue; } r -= 2 * IT_GU;
        if (r < 2 * IT_D) { const int i = r / IT_D;
            cvt_plain(a.in[I_FWD] + (size_t)i * FFD * DM, FFD, DM, nullptr, nullptr, (bf16_t*)(ws + W_D + (size_t)i * DM * FFD), r % IT_D, scr, lane, true); continue; } r -= 2 * IT_D;
        if (r < IT_KV) { cvt_headperm(a.in[I_WKV], 1536, 1536, a.in[I_NKV], (bf16_t*)(ws + W_KV), DM, 48, r, scr, lane); continue; } r -= IT_KV;
        if (r < 2 * IT_QG) { const int j = r / IT_QG;
            cvt_headperm(a.in[I_WQG] + (size_t)j * DM * 1072, 1072, 1072, a.in[I_NMIX] + (2 + j) * DM, (bf16_t*)(ws + W_QG) + (size_t)j * 1280 * DM, DM, 40, r % IT_QG, scr, lane); continue; } r -= 2 * IT_QG;
        if (r < 2 * IT_O) { const int j = r / IT_O;
            cvt_plain(a.in[I_WO] + (size_t)j * DM * DM, DM, DM, nullptr, nullptr, (bf16_t*)(ws + W_O) + (size_t)j * DM * DM, r % IT_O, scr, lane); continue; } r -= 2 * IT_O;
        if (r < 2 * IT_C1) { const int w = r / IT_C1;
            cvt_plain(a.in[I_CW1] + (size_t)w * 2048 * 256, 2048, 256, nullptr, nullptr, (bf16_t*)(ws + W_C1) + (size_t)w * 256 * 2048, r % IT_C1, scr, lane); continue; } r -= 2 * IT_C1;
        { const int w = r / IT_C2;
            cvt_headperm(a.in[I_CW2] + (size_t)w * 256 * 64, 64, 64, nullptr, (bf16_t*)(ws + W_C2) + (size_t)w * 256 * 256, 256, 8, r % IT_C2, scr, lane); }
    }
}
__device__ __forceinline__ void p_convert_moe(const Args& a, LAS unsigned char* lds, int l) {
    const int tz = opaque_tid(), lane = tz & 63, wave = tz >> 6;
    LAS float* scr = (LAS float*)(lds + wave * 16384);
    unsigned char* ws = a.ws;
    const float* gain = a.in[I_NFFN] + (2 * l + 1) * DM;
    constexpr int NIT = 8 * (IT_GU + IT_D);
    for (int it = blockIdx.x * NWAVES + wave; it < NIT; it += gridDim.x * NWAVES) {
        if (it < 8 * IT_GU) { const int e = it / IT_GU; const size_t wo = ((size_t)l * 8 + e) * DM * FFD;
            cvt_gu(a.in[I_MWG] + wo, a.in[I_MWU] + wo, gain, (bf16_t*)(ws + WS_WMOE + (size_t)e * 7168 * DM), it % IT_GU, scr, lane, true); }
        else { const int r = it - 8 * IT_GU, e = r / IT_D; const size_t wo = ((size_t)l * 8 + e) * FFD * DM;
            cvt_plain(a.in[I_MWD] + wo, FFD, DM, nullptr, nullptr, (bf16_t*)(ws + WMOE_D + (size_t)e * DM * FFD), r % IT_D, scr, lane, true); }
    }
}

__device__ __forceinline__ float row_load_rstd(const float* xrow, int lane, f32x4 (&v)[4]) {
    const f32x4* xr = (const f32x4*)xrow + lane; float s = 0.f;
#pragma unroll
    for (int j = 0; j < 4; ++j) { v[j] = xr[64 * j]; s += (v[j].x * v[j].x + v[j].y * v[j].y) + (v[j].z * v[j].z + v[j].w * v[j].w); }
    return 1.0f / sqrtf(wave_sum(s) * (1.f / DM) + EPS);
}
__device__ __forceinline__ void row_store_bf16(bf16_t* orow, int lane, const f32x4 (&v)[4], float sc) {
    unsigned long long* o8 = (unsigned long long*)orow + lane;
#pragma unroll
    for (int j = 0; j < 4; ++j) o8[64 * j] = (unsigned long long)pk2(v[j].x * sc, v[j].y * sc) | ((unsigned long long)pk2(v[j].z * sc, v[j].w * sc) << 32);
}
__device__ __forceinline__ void row_load8(const bf16_t* xrow, int lane, f32x4 (&v)[4]) {
#pragma unroll
    for (int j = 0; j < 2; ++j) ld8(xrow + 8 * lane + 512 * j, v[2 * j], v[2 * j + 1]);
}
__device__ __forceinline__ void row_store8(bf16_t* orow, int lane, const f32x4 (&v)[4], float sc) {
#pragma unroll
    for (int j = 0; j < 2; ++j) { u32x4 o; o.x = pk2(v[2 * j].x * sc, v[2 * j].y * sc); o.y = pk2(v[2 * j].z * sc, v[2 * j].w * sc); o.z = pk2(v[2 * j + 1].x * sc, v[2 * j + 1].y * sc); o.w = pk2(v[2 * j + 1].z * sc, v[2 * j + 1].w * sc);
        *(u32x4*)(orow + 8 * lane + 512 * j) = o; }
}
__device__ __forceinline__ void row_store_f8(unsigned char* orow, int lane, const f32x4 (&v)[4], float sc) {
#pragma unroll
    for (int j = 0; j < 2; ++j) { int lo = __builtin_amdgcn_cvt_pk_fp8_f32(v[2 * j].x * sc, v[2 * j].y * sc, 0, false); lo = __builtin_amdgcn_cvt_pk_fp8_f32(v[2 * j].z * sc, v[2 * j].w * sc, lo, true);
        int hi = __builtin_amdgcn_cvt_pk_fp8_f32(v[2 * j + 1].x * sc, v[2 * j + 1].y * sc, 0, false); hi = __builtin_amdgcn_cvt_pk_fp8_f32(v[2 * j + 1].z * sc, v[2 * j + 1].w * sc, hi, true);
        *(u32x2*)(orow + 8 * lane + 512 * j) = (u32x2){(unsigned)lo, (unsigned)hi}; }
}
__device__ __forceinline__ void p_norm(const float* x, bf16_t* XN) {
    const int tz = opaque_tid(), lane = tz & 63, gw = blockIdx.x * NWAVES + (tz >> 6), NGW = gridDim.x * NWAVES;
    for (int m = gw; m < NTOK; m += NGW) { f32x4 v[4]; const float r = row_load_rstd(x + (size_t)m * DM, lane, v); row_store_bf16(XN + (size_t)m * DM, lane, v, r); }
}
template <typename TX> __device__ __forceinline__ void p_pool_diff(const TX* x, const float* SSQ  , bf16_t* DIFF, LAS unsigned char* lds) {
    LAS float* rs = (LAS float*)lds;
    const int tid = opaque_tid(), lane = tid & 63, wave = tid >> 6;
    for (int tile = blockIdx.x; tile < NTOK / 128; tile += gridDim.x) {
        const int b = tile >> 4, t0 = (tile & 15) * 128; const TX* xb = x + (size_t)b * SEQ * DM;
        if (SSQ) { if (tid < 143) { const int t = t0 - 15 + tid; if (t >= 0) { const f32x4 p = *(const f32x4*)(SSQ + ((size_t)b * SEQ + t) * 4); rs[tid] = 1.0f / sqrtf(((p.x + p.y) + (p.z + p.w)) * (1.f / DM) + EPS); } } }
        else for (int i = wave; i < 143; i += NWAVES) { const int t = t0 - 15 + i; if (t >= 0) { float sq = 0.f;
#pragma unroll
                for (int j = 0; j < 4; ++j) { const f32x4 v = ld4(xb + (size_t)t * DM + 4 * lane + 256 * j); sq += (v.x * v.x + v.y * v.y) + (v.z * v.z + v.w * v.w); }
                const float r = 1.0f / sqrtf(wave_sum(sq) * (1.f / DM) + EPS); if (lane == 0) rs[i] = r; } }
        __syncthreads();
        const int q = tid >> 7, cq = tid & 127, g = cq >> 5, w = 2 << g, ts = t0 + 32 * q;
        const TX* xc = xb + 8 * cq;
        f32x4 sa = (f32x4){0.f, 0.f, 0.f, 0.f}, sb = sa;
        { f32x4 wa[15], wb[15];
#pragma unroll
          for (int i = 1; i < 16; ++i) { const int ii = i < w ? i : w - 1; int t = ts - ii; t = t < 0 ? 0 : t; ld8(xc + (size_t)t * DM, wa[i - 1], wb[i - 1]); }
#pragma unroll
          for (int i = 1; i < 16; ++i) { const int t = ts - i; const float r = (i < w && t >= 0) ? rs[t - t0 + 15] : 0.f; sa += wa[i - 1] * r; sb += wb[i - 1] * r; } }
        for (int tt0 = 0; tt0 < 32; tt0 += 4) {
            f32x4 na[4], nb[4], oa[4], ob[4];
#pragma unroll
            for (int j = 0; j < 4; ++j) { const int t = ts + tt0 + j; ld8(xc + (size_t)t * DM, na[j], nb[j]); int told = t + 1 - w; told = told < 0 ? 0 : told; ld8(xc + (size_t)told * DM, oa[j], ob[j]); }
#pragma unroll
            for (int j = 0; j < 4; ++j) { const int t = ts + tt0 + j;
                f32x4 ha = na[j], hb = nb[j]; { const float r = rs[t - t0 + 15]; ha *= r; hb *= r; }
                sa += ha; sb += hb;
                const int cnt = (t + 1 < w) ? (t + 1) : w; const float ic = __builtin_amdgcn_rcpf((float)cnt);
                const f32x4 da = sa * ic - ha, db = sb * ic - hb;
                u32x4 o; o.x = pk2(da.x, da.y); o.y = pk2(da.z, da.w); o.z = pk2(db.x, db.y); o.w = pk2(db.z, db.w);
                *(u32x4*)(DIFF + ((size_t)b * SEQ + t) * DM + 8 * cq) = o;
                const int told = t + 1 - w; const float ro = (told >= 0) ? rs[told - t0 + 15] : 0.f; sa -= oa[j] * ro; sb -= ob[j] * ro; } }
        __syncthreads();
    }
}
__device__ __forceinline__ void p_router_a(const Args& a, const bf16_t* x, int l, LAS unsigned char* lds) {
    LAS float* grT = (LAS float*)lds;
    LAS int* cnt = (LAS int*)(lds + 32768);
    const int tid = opaque_tid(), lane = tid & 63, wave = tid >> 6;
    const float* gain = a.in[I_NFFN] + (2 * l + 1) * DM; const float* router = a.in[I_ROUTER] + (size_t)l * DM * NEXP;
    for (int i = tid; i < DM * NEXP; i += NTHREADS) { const int k = i >> 3, e = i & 7; grT[e * DM + k] = gain[k] * router[i]; }
    int* RE = (int*)(a.ws + MS_RE); f32x2* RG = (f32x2*)(a.ws + MS_RG); float* RSTD = (float*)(a.ws + MS_RSTD); int* CNT = (int*)(a.ws + CTL_CNT);
    for (int tb = blockIdx.x; tb < NTOK / 256; tb += gridDim.x) {
        if (tid < 8) cnt[tid] = 0;
        __syncthreads();
        for (int i0 = wave * 4; i0 < 256; i0 += NWAVES * 4) {
            f32x4 v4[4][4];
#pragma unroll
            for (int q = 0; q < 4; ++q) row_load8(x + (size_t)(tb * 256 + i0 + q) * DM, lane, v4[q]);
#pragma unroll
            for (int q = 0; q < 4; ++q) { const int tok = tb * 256 + i0 + q;
                float ssq = 0.f;
#pragma unroll
                for (int j = 0; j < 4; ++j) ssq += (v4[q][j].x * v4[q][j].x + v4[q][j].y * v4[q][j].y) + (v4[q][j].z * v4[q][j].z + v4[q][j].w * v4[q][j].w);
                const float r = 1.0f / sqrtf(wave_sum(ssq) * (1.f / DM) + EPS);
                float lg[8];
#pragma unroll
                for (int e = 0; e < 8; ++e) { float sd = 0.f;
#pragma unroll
                    for (int j = 0; j < 4; ++j) { const f32x4 w = *(const LAS f32x4*)(grT + e * DM + 512 * (j >> 1) + 8 * lane + 4 * (j & 1)); sd += (v4[q][j].x * w.x + v4[q][j].y * w.y) + (v4[q][j].z * w.z + v4[q][j].w * w.w); }
                    lg[e] = wave_sum(sd) * r; }
                int e0 = 0; float l0 = lg[0];
#pragma unroll
                for (int e = 1; e < 8; ++e) if (lg[e] > l0) { l0 = lg[e]; e0 = e; }
                int e1 = -1; float l1 = 0.f;
#pragma unroll
                for (int e = 0; e < 8; ++e) if (e != e0 && (e1 < 0 || lg[e] > l1)) { l1 = lg[e]; e1 = e; }
                if (lane == 0) { const float g1 = 1.f / (1.f + expf(l0 - l1)), g0 = 1.f - g1;
                    RE[tok] = e0 | (e1 << 8); RG[tok] = (f32x2){g0, g1}; RSTD[tok] = r; __hip_atomic_fetch_add(&cnt[e0], 1, __ATOMIC_RELAXED, __HIP_MEMORY_SCOPE_WORKGROUP); __hip_atomic_fetch_add(&cnt[e1], 1, __ATOMIC_RELAXED, __HIP_MEMORY_SCOPE_WORKGROUP); } } }
        __syncthreads();
        if (tid < 8) CNT[tb * 8 + tid] = cnt[tid];
        __syncthreads();
    }
}
__device__ __forceinline__ void p_router_b(const Args& a, const bf16_t* x, LAS unsigned char* lds) {
    LAS int* cn = (LAS int*)lds;
    LAS int* tot = cn + 2048; LAS int* bef = tot + 8; LAS int* seg = bef + 8; LAS int* wtot = seg + 16;
    LAS int* slot = wtot + 32;
    const int tid = opaque_tid(), lane = tid & 63, wave = tid >> 6;
    const int* RE = (const int*)(a.ws + MS_RE); const float* RSTD = (const float*)(a.ws + MS_RSTD); const int* CNT = (const int*)(a.ws + CTL_CNT);
    int* SLOT = (int*)(a.ws + MS_SLOT); int* TILE_E = (int*)(a.ws + CTL_TILEE); int* NT = (int*)(a.ws + CTL_NT);
    unsigned char* XS8 = a.ws + WS_A + 128 * MiB;
    for (int tb = blockIdx.x; tb < NTOK / 256; tb += gridDim.x) {
        { const int4 c4 = *(const int4*)(CNT + tid * 4); cn[tid * 4] = c4.x; cn[tid * 4 + 1] = c4.y; cn[tid * 4 + 2] = c4.z; cn[tid * 4 + 3] = c4.w; }
        __syncthreads();
        if (tid < 8) { int t = 0, bf = 0; for (int b = 0; b < 256; ++b) { const int c = cn[b * 8 + tid]; t += c; if (b < tb) bf += c; } tot[tid] = t; bef[tid] = bf; }
        __syncthreads();
        if (tid == 0) { int s = 0; for (int e = 0; e < 8; ++e) { seg[e] = s; s += ((tot[e] + 255) >> 8) << 8; } seg[8] = s; if (tb == 0) *NT = s >> 8; }
        int e0 = 0, e1 = 0, r0 = 0, r1 = 0;
        if (tid < 256) { const int re = RE[tb * 256 + tid]; e0 = re & 255; e1 = re >> 8;
#pragma unroll
            for (int e = 0; e < 8; ++e) { const bool f = (e0 == e) || (e1 == e); const unsigned long long mk = __ballot(f);
                const int r = __popcll(mk & ((1ull << lane) - 1ull)); if (lane == 0) wtot[wave * 8 + e] = __popcll(mk); if (e == e0) r0 = r; if (e == e1) r1 = r; } }
        __syncthreads();
        if (tb == 0) { const int ntl = seg[8] >> 8;
            for (int t = tid; t < ntl; t += NTHREADS) { int e = 0;
#pragma unroll
                for (int q = 1; q < 8; ++q) e = (seg[q] <= (t << 8)) ? q : e;
                TILE_E[t] = e; } }
        if (tid < 256) { int o0 = 0, o1 = 0; for (int w = 0; w < wave; ++w) { o0 += wtot[w * 8 + e0]; o1 += wtot[w * 8 + e1]; }
            const int p0 = seg[e0] + bef[e0] + o0 + r0, p1 = seg[e1] + bef[e1] + o1 + r1;
            slot[tid * 2] = p0; slot[tid * 2 + 1] = p1; *(int2*)(SLOT + (size_t)(tb * 256 + tid) * 2) = make_int2(p0, p1); }
        __syncthreads();
        for (int i0 = wave * 4; i0 < 256; i0 += NWAVES * 4) {
            f32x4 v4[4][4]; float r4[4];
#pragma unroll
            for (int q = 0; q < 4; ++q) { const int tok = tb * 256 + i0 + q; r4[q] = RSTD[tok]; row_load8(x + (size_t)tok * DM, lane, v4[q]); }
#pragma unroll
            for (int q = 0; q < 4; ++q) { row_store_f8(XS8 + (size_t)slot[(i0 + q) * 2] * DM, lane, v4[q], r4[q] * pg8::F8_XS); row_store_f8(XS8 + (size_t)slot[(i0 + q) * 2 + 1] * DM, lane, v4[q], r4[q] * pg8::F8_XS); } }
        __syncthreads();
    }
}
template <bool FINAL> __device__ __forceinline__ void p_moe_combine(const Args& a, bf16_t* XB, float* SSQ, float* out) {
    const int tz = opaque_tid(), lane = tz & 63, gw = blockIdx.x * NWAVES + (tz >> 6), NGW = gridDim.x * NWAVES;
    const f32x2* RG = (const f32x2*)(a.ws + MS_RG); const int* SLOT = (const int*)(a.ws + MS_SLOT); const bf16_t* YS = (const bf16_t*)(a.ws + WS_A);
    const bf16_t* YSP = (const bf16_t*)(a.ws + WS_QGRAW);
    constexpr int XROW0 = 1 << 30;
    for (int m0 = gw * 2; m0 < NTOK; m0 += NGW * 2) {
        f32x2 g2[2]; int2 sl2[2];
#pragma unroll
        for (int q = 0; q < 2; ++q) { g2[q] = RG[m0 + q]; sl2[q] = *(const int2*)(SLOT + (size_t)(m0 + q) * 2); }
        u32x4 xv[2][2], ya[2][2], yb[2][2];
#pragma unroll
        for (int q = 0; q < 2; ++q) { const u32x4* xr = (const u32x4*)(XB + (size_t)(m0 + q) * DM) + lane;
            const u32x4* y0 = (const u32x4*)(YS + (size_t)(sl2[q].x < XROW0 ? sl2[q].x : 0) * DM) + lane; const u32x4* y1 = (const u32x4*)(YS + (size_t)(sl2[q].y < XROW0 ? sl2[q].y : 0) * DM) + lane;
#pragma unroll
            for (int j = 0; j < 2; ++j) { xv[q][j] = xr[64 * j]; ya[q][j] = y0[64 * j]; yb[q][j] = y1[64 * j]; } }
#pragma unroll
        for (int q = 0; q < 2; ++q) { const int m = m0 + q; const f32x2 g = g2[q];
            u32x4* xb = (u32x4*)(XB + (size_t)m * DM) + lane; f32x4* orow = (f32x4*)(out + (size_t)m * DM) + 2 * lane; float ss = 0.f;
            const int s0 = __builtin_amdgcn_readfirstlane(sl2[q].x), s1 = __builtin_amdgcn_readfirstlane(sl2[q].y);
#pragma unroll
            for (int j = 0; j < 2; ++j) { const u32x4 x0 = xv[q][j];
                f32x4 a0l, a0h, a1l, a1h;
                { const u32x4 w = ya[q][j]; a0l = (f32x4){bflo(w.x), bfhi(w.x), bflo(w.y), bfhi(w.y)}; a0h = (f32x4){bflo(w.z), bfhi(w.z), bflo(w.w), bfhi(w.w)}; }
                { const u32x4 w = yb[q][j]; a1l = (f32x4){bflo(w.x), bfhi(w.x), bflo(w.y), bfhi(w.y)}; a1h = (f32x4){bflo(w.z), bfhi(w.z), bflo(w.w), bfhi(w.w)}; }
                if (s0 >= XROW0) { a0l = (f32x4){0.f, 0.f, 0.f, 0.f}; a0h = a0l;
                    for (int ks = 0; ks < pg8::XSPLIT; ++ks) { f32x4 pl, ph; ld8(YSP + ((size_t)ks * pg8::XROWS + (s0 - XROW0)) * DM + 8 * lane + 512 * j, pl, ph); a0l += pl; a0h += ph; } }
                if (s1 >= XROW0) { a1l = (f32x4){0.f, 0.f, 0.f, 0.f}; a1h = a1l;
                    for (int ks = 0; ks < pg8::XSPLIT; ++ks) { f32x4 pl, ph; ld8(YSP + ((size_t)ks * pg8::XROWS + (s1 - XROW0)) * DM + 8 * lane + 512 * j, pl, ph); a1l += pl; a1h += ph; } }
                const f32x4 xl = (f32x4){bflo(x0.x), bfhi(x0.x), bflo(x0.y), bfhi(x0.y)}, xh = (f32x4){bflo(x0.z), bfhi(x0.z), bflo(x0.w), bfhi(x0.w)};
                const f32x4 v = xl + g.x * a0l + g.y * a1l, u = xh + g.x * a0h + g.y * a1h;
                if (FINAL) { orow[128 * j] = v; orow[128 * j + 1] = u; }
                else { u32x4 w; w.x = pk2(v.x, v.y); w.y = pk2(v.z, v.w); w.z = pk2(u.x, u.y); w.w = pk2(u.z, u.w); xb[64 * j] = w;
                    ss += ((v.x * v.x + v.y * v.y) + (v.z * v.z + v.w * v.w)) + ((u.x * u.x + u.y * u.y) + (u.z * u.z + u.w * u.w)); } }
            if (!FINAL) { ss = wave_sum(ss); if (lane == 0) *(f32x4*)(SSQ + (size_t)m * 4) = (f32x4){ss, 0.f, 0.f, 0.f}; } } }
}

__device__ __forceinline__ void headnorm_inplace(bf16_t* buf, int ld, int col0, int nheads, const float* gain, float scale) {
    const int tz = opaque_tid(), gl = (blockIdx.x * NTHREADS + tz) >> 3, NG = (gridDim.x * NTHREADS) >> 3, sub = tz & 7;
    f32x4 ga = *(const f32x4*)(gain + sub * 8), gb = *(const f32x4*)(gain + sub * 8 + 4);
    const long total = (long)NTOK * nheads;
    for (long it = gl; it < total; it += NG) { const int tok = (int)(it / nheads), h = (int)(it % nheads);
        u32x4* p = (u32x4*)(buf + (size_t)tok * ld + col0 + h * 64 + sub * 8); const u32x4 w = *p;
        float v[8] = {bflo(w.x), bfhi(w.x), bflo(w.y), bfhi(w.y), bflo(w.z), bfhi(w.z), bflo(w.w), bfhi(w.w)};
        float s = 0.f;
#pragma unroll
        for (int j = 0; j < 8; ++j) s += v[j] * v[j];
        s += __shfl_xor(s, 1); s += __shfl_xor(s, 2); s += __shfl_xor(s, 4);
        const float r = scale / sqrtf(s * (1.f / 64.f) + EPS);
        u32x4 o; o.x = pk2(v[0] * r * ga.x, v[1] * r * ga.y); o.y = pk2(v[2] * r * ga.z, v[3] * r * ga.w); o.z = pk2(v[4] * r * gb.x, v[5] * r * gb.y); o.w = pk2(v[6] * r * gb.z, v[7] * r * gb.w);
        *p = o; }
}
__device__ __forceinline__ void p_cmp_gather(const Args& a) {
    const bf16_t* KV = (const bf16_t*)(a.ws + WS_KVRAW); bf16_t* BLK = (bf16_t*)(a.ws + WS_BLK); const float* pos = a.in[I_CPOS];
    const long total = (long)2 * 16256 * 256;
    const int tz = opaque_tid();
    for (long it = (long)blockIdx.x * NTHREADS + tz; it < total; it += (long)gridDim.x * NTHREADS) {
        const int piece = (int)(it & 255), row = (int)((it >> 8) % 16256), w = (int)((it >> 8) / 16256);
        const int l = piece >> 3, d0 = (piece & 7) * 8, g = row & 3, bc = row >> 2, b = bc / NCMP, c = bc % NCMP;
        const u32x4 kv = *(const u32x4*)(KV + ((size_t)b * SEQ + 16 * c + l) * 1536 + w * 256 + g * 64 + d0);
        const f32x4 pa = *(const f32x4*)(pos + (w * 32 + l) * 64 + d0), pb = *(const f32x4*)(pos + (w * 32 + l) * 64 + d0 + 4);
        u32x4 o; o.x = pk2(bflo(kv.x) + pa.x, bfhi(kv.x) + pa.y); o.y = pk2(bflo(kv.y) + pa.z, bfhi(kv.y) + pa.w); o.z = pk2(bflo(kv.z) + pb.x, bfhi(kv.z) + pb.y); o.w = pk2(bflo(kv.w) + pb.z, bfhi(kv.w) + pb.w);
        *(u32x4*)(BLK + ((size_t)w * 16384 + row) * 2048 + l * 64 + d0) = o; }
}
__device__ __forceinline__ int vt_pos(int k) { return (k & ~12) | ((k & 4) << 1) | ((k & 8) >> 1); }
__device__ __forceinline__ void p_cmp_finish(const Args& a) {
    const float* CMP = (const float*)(a.ws + MS_CMPRAW); const float* gk0 = a.in[I_GK];
    bf16_t* KCF = (bf16_t*)(a.ws + WS_KCF); bf16_t* VCF = (bf16_t*)(a.ws + WS_VCF);
    const int tz = opaque_tid(), lane = tz & 63, gw = blockIdx.x * NWAVES + (tz >> 6), NGW = gridDim.x * NWAVES;
    for (int it = gw; it < 2 * 16384; it += NGW) { const int w = it >> 14, idx = it & 16383, g = idx & 3, bc = idx >> 2, b = bc >> 7, c = bc & 127;
        float s = 0.f;
        if (c < NCMP) { s = CMP[((size_t)w * 16384 + (size_t)(b * NCMP + c) * 4 + g) * 64 + lane];
            if (w == 0) { const float ss = wave_sum(s * s); s = s * (1.0f / sqrtf(ss * (1.f / 64.f) + EPS)) * gk0[lane]; } }
        const int d = lane, t2 = c >> 6, kk = c & 63;
        if (w == 0) KCF[(((size_t)(b * 4 + g) * 2 + t2) * 8 + (kk >> 5) * 4 + (d >> 4)) * 512 + (((d >> 3) & 1) * 32 + (kk & 31)) * 8 + (d & 7)] = (bf16_t)f2bf(s);
        else { const int ps = vt_pos(kk); VCF[(((size_t)(b * 4 + g) * 2 + t2) * 8 + ((ps >> 4) * 2 + (d >> 5))) * 512 + (((ps >> 3) & 1) * 32 + (d & 31)) * 8 + (ps & 7)] = (bf16_t)f2bf(s); } }
}
__device__ __forceinline__ void p_kv_frag(const Args& a) {
    const bf16_t* KV = (const bf16_t*)(a.ws + WS_KVRAW); bf16_t* KF = (bf16_t*)(a.ws + WS_KF); bf16_t* VF = (bf16_t*)(a.ws + WS_VF);
    const int tz = opaque_tid();
    const long total = (long)2 * NBATCH * 4 * 8 * SEQ;
    const int sub = tz & 7;
    for (long it = (long)blockIdx.x * NTHREADS + tz; it < total; it += (long)gridDim.x * NTHREADS) {
        { const int t = (int)((it >> 3) & 2047), g = (int)((it >> 14) & 3), b = (int)((it >> 16) & 31), w = (int)(it >> 21);
          const float* gain = a.in[I_GK] + 64 * (1 + w);
          const u32x4 wv = *(const u32x4*)(KV + ((size_t)b * SEQ + t) * 1536 + 512 + w * 512 + g * 64 + sub * 8);
          float v[8] = {bflo(wv.x), bfhi(wv.x), bflo(wv.y), bfhi(wv.y), bflo(wv.z), bfhi(wv.z), bflo(wv.w), bfhi(wv.w)};
          float ss = 0.f;
#pragma unroll
          for (int j = 0; j < 8; ++j) ss += v[j] * v[j];
          ss += __shfl_xor(ss, 1); ss += __shfl_xor(ss, 2); ss += __shfl_xor(ss, 4);
          const float r = 1.0f / sqrtf(ss * (1.f / 64.f) + EPS);
          const f32x4 ga = *(const f32x4*)(gain + sub * 8), gb = *(const f32x4*)(gain + sub * 8 + 4);
          u32x4 o; o.x = pk2(v[0] * r * ga.x, v[1] * r * ga.y); o.y = pk2(v[2] * r * ga.z, v[3] * r * ga.w); o.z = pk2(v[4] * r * gb.x, v[5] * r * gb.y); o.w = pk2(v[6] * r * gb.z, v[7] * r * gb.w);
          const int kk = t & 63;
          *(u32x4*)(KF + ((((size_t)w * 128 + b * 4 + g) * 32 + (t >> 6)) * 8 + (kk >> 5) * 4 + (sub >> 1)) * 512 + ((sub & 1) * 32 + (kk & 31)) * 8) = o; }
        { const int t = (int)(it & 2047), piece = (int)((it >> 11) & 7), g = (int)((it >> 14) & 3), b = (int)((it >> 16) & 31), w = (int)(it >> 21);
          const u32x4 v = *(const u32x4*)(KV + ((size_t)b * SEQ + t) * 1536 + 768 + w * 512 + g * 64 + piece * 8);
          const int ps = vt_pos(t & 63), d0 = piece * 8;
          bf16_t* dst = VF + ((((size_t)w * 128 + b * 4 + g) * 32 + (t >> 6)) * 8 + ((ps >> 4) * 2 + (d0 >> 5))) * 512 + (((ps >> 3) & 1) * 32 + (d0 & 31)) * 8 + (ps & 7);
          dst[0] = (bf16_t)(v.x & 0xffff); dst[8] = (bf16_t)(v.x >> 16); dst[16] = (bf16_t)(v.y & 0xffff); dst[24] = (bf16_t)(v.y >> 16);
          dst[32] = (bf16_t)(v.z & 0xffff); dst[40] = (bf16_t)(v.z >> 16); dst[48] = (bf16_t)(v.w & 0xffff); dst[56] = (bf16_t)(v.w >> 16); } }
}

__device__ __forceinline__ int rel_bucket(int n) {
    if (n < 16) return n;
    int lg = 16 + (int)(logf((float)n * (1.f / 16.f)) / logf(8.f) * 16.f);
    return lg < 31 ? lg : 31;
}
typedef float f32x16 __attribute__((ext_vector_type(16)));
#define MFMA32(a, b, c) __builtin_amdgcn_mfma_f32_32x32x16_bf16((a), (b), (c), 0, 0, 0)
__device__ __forceinline__ float xhalf(float v, int h) { (void)h; return __shfl_xor(v, 32); }
__device__ __forceinline__ float dpp_xor1(float v) { return __shfl_xor(v, 1); }
__device__ __forceinline__ float dpp_xor2(float v) { return __shfl_xor(v, 2); }
__device__ __forceinline__ void pv_tile(const bf16_t* VTp, const f32x16& p0, const f32x16& p1, f32x16 (&O)[2], int lane) {
#pragma unroll
    for (int bb = 0; bb < 2; ++bb)
#pragma unroll
        for (int s2 = 0; s2 < 2; ++s2) {
            u32x4 w;
            if (bb == 0) { w.x = cvt_pk_bf16(p0[8 * s2 + 0], p0[8 * s2 + 1]); w.y = cvt_pk_bf16(p0[8 * s2 + 2], p0[8 * s2 + 3]); w.z = cvt_pk_bf16(p0[8 * s2 + 4], p0[8 * s2 + 5]); w.w = cvt_pk_bf16(p0[8 * s2 + 6], p0[8 * s2 + 7]); }
            else         { w.x = cvt_pk_bf16(p1[8 * s2 + 0], p1[8 * s2 + 1]); w.y = cvt_pk_bf16(p1[8 * s2 + 2], p1[8 * s2 + 3]); w.z = cvt_pk_bf16(p1[8 * s2 + 4], p1[8 * s2 + 5]); w.w = cvt_pk_bf16(p1[8 * s2 + 6], p1[8 * s2 + 7]); }
            const bf16x8 Pf = __builtin_bit_cast(bf16x8, w);
#pragma unroll
            for (int db = 0; db < 2; ++db) {
                const bf16x8 vf = *(const bf16x8*)(VTp + (size_t)((((bb * 2 + s2) * 2 + db) * 64 + lane) * 8));
                O[db] = MFMA32(vf, Pf, O[db]); } }
}
constexpr float MINIT = -1e20f;
constexpr float DEFER_THR = 11.5f;
constexpr int BT_C = 384, BT_N = 512;
__device__ __forceinline__ void online_tile(f32x16& s0, f32x16& s1, const LAS float* bl  , float& m, float& l, f32x16 (&O)[2]) {
    float mx = m;
    { float b0[16];
#pragma unroll
      for (int r = 0; r < 16; ++r) b0[r] = bl[(r & 3) + 8 * (r >> 2)];
#pragma unroll
      for (int r = 0; r < 16; ++r) { const float v = s0[r] + b0[r]; s0[r] = v; mx = fmaxf(mx, v); } }
    { float b1[16];
#pragma unroll
      for (int r = 0; r < 16; ++r) b1[r] = bl[32 + (r & 3) + 8 * (r >> 2)];
#pragma unroll
      for (int r = 0; r < 16; ++r) { const float v = s1[r] + b1[r]; s1[r] = v; mx = fmaxf(mx, v); } }
    mx = fmaxf(mx, __shfl_xor(mx, 32));
    if (!__all(mx - m <= DEFER_THR)) { const float al = __builtin_amdgcn_exp2f(m - mx); m = mx; l *= al; O[0] *= al; O[1] *= al; }
}
__device__ __forceinline__ void online_tile_wedge(f32x16& s0, f32x16& s1, int tedge  , float cb, float& m, float& l, f32x16 (&O)[2]) {
    float mx = m;
#pragma unroll
    for (int r = 0; r < 16; ++r) { const float v = ((r & 3) + 8 * (r >> 2) >= tedge) ? s0[r] + cb : NEGF; s0[r] = v; mx = fmaxf(mx, v); }
#pragma unroll
    for (int r = 0; r < 16; ++r) { const float v = (32 + (r & 3) + 8 * (r >> 2) >= tedge) ? s1[r] + cb : NEGF; s1[r] = v; mx = fmaxf(mx, v); }
    mx = fmaxf(mx, __shfl_xor(mx, 32));
    if (!__all(mx - m <= DEFER_THR)) { const float al = __builtin_amdgcn_exp2f(m - mx); m = mx; l *= al; O[0] *= al; O[1] *= al; }
}
__device__ __forceinline__ void online_tile_far(f32x16& s0, f32x16& s1, float cb, float& m, float& l, f32x16 (&O)[2]) {
    float mx = m;
#pragma unroll
    for (int r = 0; r < 16; ++r) { s0[r] += cb; mx = fmaxf(mx, s0[r]); }
#pragma unroll
    for (int r = 0; r < 16; ++r) { s1[r] += cb; mx = fmaxf(mx, s1[r]); }
    mx = fmaxf(mx, __shfl_xor(mx, 32));
    if (!__all(mx - m <= DEFER_THR)) { const float al = __builtin_amdgcn_exp2f(m - mx); m = mx; l *= al; O[0] *= al; O[1] *= al; }
}
template <int MODE> __device__ __forceinline__ void p_attn(const Args& a, LAS unsigned char* lds) {
    LAS float* biasd = (LAS float*)lds;
    const float* relb = a.in[I_RELB];
    if (opaque_tid() >= 256) __builtin_amdgcn_s_setprio(1);
    for (int i = opaque_tid(); i < 16 * BT_N; i += NTHREADS) { const int head = i / BT_N, dist = BT_C - (i % BT_N); biasd[i] = dist < 0 ? NEGF : relb[rel_bucket(dist < 128 ? dist : 128) * 16 + head] * 1.44269504f; }
    __syncthreads();
    const bf16_t* QG = (const bf16_t*)(a.ws + WS_QGRAW);
    const bf16_t* KF = (const bf16_t*)(a.ws + WS_KF); const bf16_t* VF = (const bf16_t*)(a.ws + WS_VF);
    const bf16_t* KCF = (const bf16_t*)(a.ws + WS_KCF); const bf16_t* VCF = (const bf16_t*)(a.ws + WS_VCF);
    bf16_t* OUT = (bf16_t*)(a.ws + (MODE == 0 ? WS_H : WS_BLK));
    for (int unit = blockIdx.x; unit < NBATCH * 32 * 4; unit += gridDim.x) {
        const int tid = opaque_tid(), lane = tid & 63, wave = tid >> 6, c = lane & 31, h = lane >> 5;
        const int k = unit >> 8, idx = unit & 255, xg = idx & 7;
        const int b = 2 * k + (xg >> 2), g = xg & 3, qx = ((idx >> 3) + 4 * (k >> 1)) & 31, qt = (k & 1) ? 31 - qx : qx;
        const int ql = 8 * wave + (c >> 2), r = c & 3, head = 4 * g + r; int tq = qt * 64 + ql; asm volatile("" : "+v"(tq));
        const size_t tok = (size_t)b * SEQ + tq;
        const LAS float* bd = biasd + head * BT_N + BT_C;
        bf16x8 Qf[4];
        LAS bf16x8* qlds = (LAS bf16x8*)(lds + 32768) + wave * 256 + lane;
#pragma unroll
        for (int s = 0; s < 4; ++s) { Qf[s] = *(const bf16x8*)(QG + tok * 1280 + head * 64 + 16 * s + 8 * h); qlds[64 * s] = Qf[s]; }
        const bf16_t* gp = QG + tok * 1280 + 1024 + head * 3;
        const float gt0 = __builtin_amdgcn_rcpf(1.f + __expf(-bf2f(gp[0]))), gt1 = __builtin_amdgcn_rcpf(1.f + __expf(-bf2f(gp[1]))), gt2 = __builtin_amdgcn_rcpf(1.f + __expf(-bf2f(gp[2])));
        f32x16 OT[2];
        int jsel = -1;
        bf16x8 Kn[8];
        {
            const bf16_t* KC = KCF + (size_t)(b * 4 + g) * 2 * 4096; const bf16_t* VC = VCF + (size_t)(b * 4 + g) * 2 * 4096;
            f32x16 sc[4];
#pragma unroll
            for (int i = 0; i < 4; ++i) sc[i] = (f32x16){0.f, 0.f, 0.f, 0.f, 0.f, 0.f, 0.f, 0.f, 0.f, 0.f, 0.f, 0.f, 0.f, 0.f, 0.f, 0.f};
            { bf16x8 kf[16];
#pragma unroll
              for (int t2 = 0; t2 < 2; ++t2)
#pragma unroll
                for (int s2 = 0; s2 < 4; ++s2) { kf[t2 * 8 + 2 * s2] = *(const bf16x8*)(KC + t2 * 4096 + (s2 * 64 + lane) * 8); kf[t2 * 8 + 2 * s2 + 1] = *(const bf16x8*)(KC + t2 * 4096 + ((4 + s2) * 64 + lane) * 8); }
              __builtin_amdgcn_sched_barrier(0);
#pragma unroll
              for (int t2 = 0; t2 < 2; ++t2)
#pragma unroll
                for (int s2 = 0; s2 < 4; ++s2) { sc[2 * t2] = MFMA32(kf[t2 * 8 + 2 * s2], Qf[s2], sc[2 * t2]); sc[2 * t2 + 1] = MFMA32(kf[t2 * 8 + 2 * s2 + 1], Qf[s2], sc[2 * t2 + 1]); } }
            bf16x8 vcf[8];
#pragma unroll
            for (int i = 0; i < 8; ++i) vcf[i] = *(const bf16x8*)(VC + (i * 64 + lane) * 8);
            __builtin_amdgcn_sched_barrier(0);
            float mx = NEGF;
            const int tq0 = qt * 64 + 8 * __builtin_amdgcn_readfirstlane(wave); const float cbf = bd[-128];
#pragma unroll
            for (int kb = 0; kb < 4; ++kb) {
                if ((tq0 - 31 - 64) - 16 * (32 * kb + 27) >= 128) {
#pragma unroll
                    for (int rr = 0; rr < 16; ++rr) { const float v = sc[kb][rr] + cbf; sc[kb][rr] = v; mx = fmaxf(mx, v); }
                } else if ((tq0 + 7 - 31) - 16 * (32 * kb) < 0) {
#pragma unroll
                    for (int rr = 0; rr < 16; ++rr) sc[kb][rr] = NEGF;
                } else {
                    float bb[16];
#pragma unroll
                    for (int rr = 0; rr < 16; ++rr) { const int dc = (tq - 31 - 64 * h) - 16 * (32 * kb + (rr & 3) + 8 * (rr >> 2)); bb[rr] = bd[-min(max(dc, 0), 128)]; }
#pragma unroll
                    for (int rr = 0; rr < 16; ++rr) { const int dc = (tq - 31 - 64 * h) - 16 * (32 * kb + (rr & 3) + 8 * (rr >> 2));
                        const float v = (dc >= 0) ? sc[kb][rr] + bb[rr] : NEGF; sc[kb][rr] = v; mx = fmaxf(mx, v); } } }
            mx = fmaxf(fmaxf(mx, __shfl_xor(mx, 32)), MINIT);
            float ps = 0.f;
#pragma unroll
            for (int kb = 0; kb < 4; ++kb)
#pragma unroll
                for (int rr = 0; rr < 16; ++rr) { const float p = __builtin_amdgcn_exp2f(sc[kb][rr] - mx); sc[kb][rr] = p; ps += p; }
            ps += __shfl_xor(ps, 32);
            const float inv = __builtin_amdgcn_rcpf(fmaxf(ps, TINYF));
#pragma unroll
            for (int kb = 0; kb < 4; ++kb) sc[kb] *= inv;
            OT[0] = (f32x16){0.f, 0.f, 0.f, 0.f, 0.f, 0.f, 0.f, 0.f, 0.f, 0.f, 0.f, 0.f, 0.f, 0.f, 0.f, 0.f}; OT[1] = OT[0];
#define CMP_PV(t2) do { _Pragma("unroll") for (int bb = 0; bb < 2; ++bb) _Pragma("unroll") for (int s2 = 0; s2 < 2; ++s2) { const f32x16& p = sc[2 * (t2) + bb]; \
                u32x4 w; w.x = cvt_pk_bf16(p[8 * s2 + 0], p[8 * s2 + 1]); w.y = cvt_pk_bf16(p[8 * s2 + 2], p[8 * s2 + 3]); w.z = cvt_pk_bf16(p[8 * s2 + 4], p[8 * s2 + 5]); w.w = cvt_pk_bf16(p[8 * s2 + 6], p[8 * s2 + 7]); \
                const bf16x8 Pf = __builtin_bit_cast(bf16x8, w); \
                _Pragma("unroll") for (int db = 0; db < 2; ++db) OT[db] = MFMA32(vcf[(bb * 2 + s2) * 2 + db], Pf, OT[db]); } } while (0)
            CMP_PV(0);
            { const bf16_t* Kp = KF + (size_t)(b * 4 + g) * 32 * 4096;
#pragma unroll
              for (int s2 = 0; s2 < 4; ++s2) { Kn[2 * s2] = *(const bf16x8*)(Kp + (s2 * 64 + lane) * 8); Kn[2 * s2 + 1] = *(const bf16x8*)(Kp + ((4 + s2) * 64 + lane) * 8); } }
#pragma unroll
            for (int i = 0; i < 8; ++i) vcf[i] = *(const bf16x8*)(VC + 4096 + (i * 64 + lane) * 8);
            __builtin_amdgcn_sched_barrier(0);
            float best = -1.f; int bj = -1; const int jmax = qt - 2;
            float prev_recv = 0.f;
#pragma unroll
            for (int v = 0; v < 16; ++v) if (2 * v <= jmax) { const int kb = v >> 2, aa = v & 3;
                const float p3 = sc[kb][4 * aa + 3];
                const float av = (sc[kb][4 * aa] + sc[kb][4 * aa + 1]) + (sc[kb][4 * aa + 2] + 0.5f * p3);
                const float recv = xhalf(0.5f * p3, h);
                float iv = av + (h ? recv : prev_recv);
                prev_recv = recv;
                iv += dpp_xor1(iv); iv += dpp_xor2(iv);
                const int jj = 2 * v + h;
                if (jj >= 1 && jj <= jmax && iv > best) { best = iv; bj = jj; } }
            { const float ob = xhalf(best, h); const int oj = __builtin_bit_cast(int, xhalf(__builtin_bit_cast(float, bj), h));
              if (oj >= 0 && (bj < 0 || ob > best || (ob == best && oj < bj))) { best = ob; bj = oj; } }
            jsel = bj;
            CMP_PV(1);
#undef CMP_PV
            LAS f32x4* otl0 = (LAS f32x4*)(lds + 65536) + wave * 512 + lane;
#pragma unroll
            for (int db = 0; db < 2; ++db)
#pragma unroll
                for (int r4 = 0; r4 < 4; ++r4) otl0[(db * 4 + r4) * 64] = (f32x4){OT[db][4 * r4], OT[db][4 * r4 + 1], OT[db][4 * r4 + 2], OT[db][4 * r4 + 3]} * gt0;
        }
        {
            float m = MINIT, l = 0.f; f32x16 O[2];
            LAS f32x4* otl = (LAS f32x4*)(lds + 65536) + wave * 512 + lane;
            O[0] = (f32x16){0.f, 0.f, 0.f, 0.f, 0.f, 0.f, 0.f, 0.f, 0.f, 0.f, 0.f, 0.f, 0.f, 0.f, 0.f, 0.f}; O[1] = O[0];
            const bf16_t* KbS = KF + (size_t)(b * 4 + g) * 32 * 4096; const bf16_t* VbS = VF + (size_t)(b * 4 + g) * 32 * 4096;
#define ATT_NEXT(nx, kt, pq, win, ok) do { pq = 0; win = 0; ok = false; \
                while ((nx) < 16) { \
                    if ((nx) < 3) { kt = ((nx) == 1) ? qt - 1 : qt; if (kt > 0) { ok = true; break; } ++(nx); } \
                    else if ((nx) == 3) { if (rem == 0ull) { (nx) = 11; continue; } \
                        kt = __builtin_amdgcn_readlane(jsel, (int)__builtin_ctzll(rem)); rem &= ~__ballot(jsel == kt); pq = 1; ok = true; break; } \
                    else { kt = qt - 15 + (nx); win = 1; if (kt >= 0) { ok = true; break; } ++(nx); } } } while (0)
#define ATT_KPTR(kt, win) (KbS + (size_t)(win) * ((size_t)128 * 32 * 4096) + (size_t)(kt) * 4096)
#define ATT_VPTR(kt, win) (VbS + (size_t)(win) * ((size_t)128 * 32 * 4096) + (size_t)(kt) * 4096)
            int st = 0, kt = 0, pq = 0, win = 0;
            unsigned long long rem = __ballot(jsel >= 1);
            int curwin = 0;
            for (;;) {
                int nx = (st == 3) ? 3 : st + 1, nkt = 0, npq = 0, nwin = 0; bool nok = false;
                ATT_NEXT(nx, nkt, npq, nwin, nok);
                bf16x8 Vc[8];
                { const bf16_t* Vp = ATT_VPTR(kt, win);
#pragma unroll
                  for (int bb = 0; bb < 2; ++bb)
#pragma unroll
                    for (int s2 = 0; s2 < 2; ++s2)
#pragma unroll
                        for (int db = 0; db < 2; ++db) Vc[(bb * 2 + s2) * 2 + db] = *(const bf16x8*)(Vp + ((((bb * 2 + s2) * 2 + db) * 64 + lane) * 8)); }
                if (win != curwin) {
                    const float scl = gt1 * __builtin_amdgcn_rcpf(fmaxf(l, TINYF));
#pragma unroll
                    for (int db = 0; db < 2; ++db)
#pragma unroll
                        for (int r4 = 0; r4 < 4; ++r4) otl[(db * 4 + r4) * 64] += (f32x4){O[db][4 * r4], O[db][4 * r4 + 1], O[db][4 * r4 + 2], O[db][4 * r4 + 3]} * scl;
                    m = MINIT; l = 0.f; O[0] = (f32x16){0.f, 0.f, 0.f, 0.f, 0.f, 0.f, 0.f, 0.f, 0.f, 0.f, 0.f, 0.f, 0.f, 0.f, 0.f, 0.f}; O[1] = O[0]; curwin = win; }
                f32x16 s0 = (f32x16){0.f, 0.f, 0.f, 0.f, 0.f, 0.f, 0.f, 0.f, 0.f, 0.f, 0.f, 0.f, 0.f, 0.f, 0.f, 0.f}, s1 = s0;
#pragma unroll
                for (int s2 = 0; s2 < 4; ++s2) { const bf16x8 qf = qlds[64 * s2]; s0 = MFMA32(Kn[2 * s2], qf, s0); s1 = MFMA32(Kn[2 * s2 + 1], qf, s1); }
                { const bf16_t* Kp = nok ? ATT_KPTR(nkt, nwin) : ATT_KPTR(kt, win);
#pragma unroll
                  for (int s2 = 0; s2 < 4; ++s2) { Kn[2 * s2] = *(const bf16x8*)(Kp + (s2 * 64 + lane) * 8); Kn[2 * s2 + 1] = *(const bf16x8*)(Kp + ((4 + s2) * 64 + lane) * 8); } }
                const bool colok = !pq || (jsel == kt);
                const int dq = qt - kt;
                if (win ? (dq == 3) : (dq >= 3)) online_tile_far(s0, s1, colok ? bd[-128] : NEGF, m, l, O);
                else if (win && dq == 4) online_tile_wedge(s0, s1, (tq - kt * 64 - 4 * h) - 255, bd[-128], m, l, O);
                else online_tile(s0, s1, bd - (colok ? (tq - kt * 64 - 4 * h) : -64), m, l, O);
                { float ps = 0.f;
#pragma unroll
                  for (int bb = 0; bb < 2; ++bb) {
                      f32x16& sb = bb ? s1 : s0;
#pragma unroll
                      for (int r = 0; r < 16; ++r) { const float p = __builtin_amdgcn_exp2f(sb[r] - m); sb[r] = p; ps += p; }
#pragma unroll
                      for (int s2 = 0; s2 < 2; ++s2) {
                          u32x4 w; w.x = cvt_pk_bf16(sb[8 * s2 + 0], sb[8 * s2 + 1]); w.y = cvt_pk_bf16(sb[8 * s2 + 2], sb[8 * s2 + 3]); w.z = cvt_pk_bf16(sb[8 * s2 + 4], sb[8 * s2 + 5]); w.w = cvt_pk_bf16(sb[8 * s2 + 6], sb[8 * s2 + 7]);
                          const bf16x8 Pf = __builtin_bit_cast(bf16x8, w);
#pragma unroll
                          for (int db = 0; db < 2; ++db) O[db] = MFMA32(Vc[(bb * 2 + s2) * 2 + db], Pf, O[db]); }
                      __builtin_amdgcn_sched_barrier(0); }
                  ps += __shfl_xor(ps, 32); l += ps; }
                if (!nok) break;
                st = nx; kt = nkt; pq = npq; win = nwin;
            }
#undef ATT_NEXT
#undef ATT_KPTR
#undef ATT_VPTR
            const float scl = gt2 * __builtin_amdgcn_rcpf(fmaxf(l, TINYF));
#pragma unroll
            for (int db = 0; db < 2; ++db)
#pragma unroll
                for (int r4 = 0; r4 < 4; ++r4) { const f32x4 p = otl[(db * 4 + r4) * 64];
#pragma unroll
                    for (int j = 0; j < 4; ++j) OT[db][4 * r4 + j] = p[j] + O[db][4 * r4 + j] * scl; }
        }
        bf16_t* op = OUT + tok * DM + head * 64;
#pragma unroll
        for (int db = 0; db < 2; ++db)
#pragma unroll
            for (int kk = 0; kk < 2; ++kk) {
                const unsigned ax = cvt_pk_bf16(OT[db][8 * kk], OT[db][8 * kk + 1]), ay = cvt_pk_bf16(OT[db][8 * kk + 2], OT[db][8 * kk + 3]);
                const unsigned bx = cvt_pk_bf16(OT[db][8 * kk + 4], OT[db][8 * kk + 5]), by = cvt_pk_bf16(OT[db][8 * kk + 6], OT[db][8 * kk + 7]);
                const auto r0 = __builtin_amdgcn_permlane32_swap(ax, bx, false, false);
                const auto r1 = __builtin_amdgcn_permlane32_swap(ay, by, false, false);
                u32x4 w; w.x = r0[0]; w.y = r1[0]; w.z = r0[1]; w.w = r1[1];
                *(u32x4*)(op + 32 * db + 16 * kk + 8 * h) = w; }
    }
    __builtin_amdgcn_s_setprio(0);
}

constexpr int MOE_CHUNK_TILES = 64, MOE_NCHUNK = 8, MOE_LAST_TILES = 72, DENSE_NCHUNK = 4, DENSE_CHUNK_ROWS = 16384;
__host__ __device__ constexpr int n_phases() {
    int pc = 0;
    for (int L = 0; L < 4; ++L) {
        if (L < 2) pc += 2; else { pc += (L == 2) ? 6 : 3; }
        if (L % 2 == 0) pc += 2 * DENSE_NCHUNK; else pc += 2 + 2 * MOE_NCHUNK + 1;
    }
    return pc;
}

typedef __attribute__((address_space(4))) const Args* KArgsPtr;
__device__ __forceinline__ Args load_args() {
    Args r{};
#if defined(__HIP_DEVICE_COMPILE__)
    KArgsPtr kp = (KArgsPtr)__builtin_amdgcn_kernarg_segment_ptr(); asm volatile("" : "+s"(kp));
#pragma unroll
    for (int i = 0; i < 22; ++i) r.in[i] = kp->in[i];
    r.out = kp->out; r.ws = kp->ws; r.ph_lo = kp->ph_lo; r.ph_hi = kp->ph_hi;
#endif
    return r;
}
__global__ void __launch_bounds__(NTHREADS, 2) yoco_fwd(Args kargs) {
    extern __shared__ __attribute__((aligned(16))) unsigned char lds_raw[];
    LAS unsigned char* lds = (LAS unsigned char*)lds_raw;
    volatile LAS unsigned* MISC = (volatile LAS unsigned*)(lds + MISC_OFF);
    const int tid = threadIdx.x, G = gridDim.x, cid = blockIdx.x;
    if (tid < 64) MISC[tid] = 0u;
    __syncthreads();
#if MK_SINGLE_LAUNCH
    constexpr int lo = 0, hi = n_phases();
#else
    const int lo = kargs.ph_lo, hi = kargs.ph_hi;
#endif
    unsigned char* ws = kargs.ws;
    const bool SPLIT_OK = (lo == 0 && hi == n_phases());
    if (hi - lo > 1) (void)xcd_barrier_post((unsigned*)(ws + WS_CTL), MISC + 8);
    if (tid == 0) atomicOr((unsigned*)(ws + WS_CTL + CTL_XMASK) + (cid & 7), 1u << xb_xcc_id());
    int pc = 0;
#define PH_BEGIN if (pc >= lo && pc < hi) { const Args args = load_args();
#define PH_JOIN }
#define PH_END_SPLIT(split) } if (pc >= lo && pc + 1 < hi) { XcdBarrier bb; bb.bar = (unsigned*)(load_args().ws + WS_CTL); bb.x = xb_xcc_id(); bb.st = (volatile LAS unsigned*)(lds + MISC_OFF) + 8; if (split) xcd_arrive(bb); else xcd_barrier(bb); } ++pc;
#define PH_END_GROUP(grp) } if (pc >= lo && pc + 1 < hi) { XcdBarrier bb; bb.bar = (unsigned*)(load_args().ws + WS_CTL); bb.x = xb_xcc_id(); bb.st = (volatile LAS unsigned*)(lds + MISC_OFF) + 8; if (grp) group_barrier(bb, cid); else xcd_barrier(bb); } ++pc;
#define PH_END } if (pc >= lo && pc + 1 < hi) { XcdBarrier bb; bb.bar = (unsigned*)(load_args().ws + WS_CTL); bb.x = xb_xcc_id(); bb.st = (volatile LAS unsigned*)(lds + MISC_OFF) + 8; xcd_barrier(bb); if (PROBE_BAR) xcd_barrier(bb); } ++pc;

    bf16_t* XB = (bf16_t*)(ws + WS_KVRAW);
    bf16_t* HID = (bf16_t*)(ws + WS_H);
    float* SSQ = (float*)(ws + MS_SSQ);
    LAS float* EPIP = (LAS float*)(lds + MISC_OFF + LX_P); LAS float* EPISQ = (LAS float*)(lds + MISC_OFF + LX_SQ);
    LAS float* LGAIN = (LAS float*)(lds + MISC_OFF + LX_GAIN); LAS float* LPOS = (LAS float*)(lds + MISC_OFF + LX_POS);


#pragma clang loop unroll(full)
    for (int L = 0; L < 4; ++L) {
        const bf16_t* XBin = XB;
        if (L < 2) {
            PH_BEGIN
                if (L == 0) { p_convert_static(args, lds); p_convert_moe(args, lds, 0); __syncthreads();
                              p_pool_diff(args.in[I_X], (const float*)nullptr, HID, lds); }
                else p_pool_diff((const bf16_t*)XB, (const float*)SSQ, HID, lds);
            PH_END
            PH_BEGIN
                pg8::Gemm g{256, DM, 256};
                pg8::GridSched S{NTOK / 256, 4, G, cid, (const char*)HID, (size_t)256 * DM * 2, (size_t)256 * 2, (const char*)(ws + W_POOL) + (size_t)L * 4 * 65536 * 2, (size_t)65536 * 2, 0, 1 << 30};
                if (L == 0) { pg8::EpiResid<float> E{args.in[I_X], XB, SSQ, DM, 0, EPIP, 1.f}; pg8::gemm_phase(lds, g, S, E); }
                else { pg8::EpiResid<bf16_t> E{XB, XB, SSQ, DM, 0, EPIP, 1.f}; pg8::gemm_phase(lds, g, S, E); }
            PH_END
        } else {
            const int j = L - 2;
            if (j == 0) {
                PH_BEGIN
                    { const int t = opaque_tid();
                      if (t < 192) LGAIN[t] = args.in[I_GK][t];
                      for (int i = t; i < 2 * 32 * 64; i += NTHREADS) LPOS[i] = args.in[I_CPOS][i];
                      __syncthreads(); }
                    pg8::Gemm g{DM, DM, DM};
                    pg8::GridSched S{NTOK / 256, 6, G, cid, (const char*)XBin, (size_t)256 * DM * 2, 0, (const char*)(ws + W_KV), (size_t)256 * DM * 2, 0, 1 << 30};
                    pg8::EpiKV E{pg8::RowScale{SSQ, 0, EPISQ}, (bf16_t*)(ws + WS_BLK), (bf16_t*)(ws + WS_KF), (bf16_t*)(ws + WS_VF), LGAIN, LPOS};
                    DUP(7) pg8::gemm_phase(lds, g, S, E);
                PH_JOIN
            }
            PH_BEGIN
                { const int t = opaque_tid(); if (t < 64) LGAIN[192 + t] = args.in[I_GQ][j * 64 + t]; __syncthreads(); }
                pg8::Gemm g{DM, DM, DM};
                pg8::GridSched S{NTOK / 256, 5, G, cid, (const char*)XBin, (size_t)256 * DM * 2, 0, (const char*)(ws + W_QG) + (size_t)j * 1280 * DM * 2, (size_t)256 * DM * 2, 0, 1 << 30};
                pg8::EpiQG E{pg8::RowScale{SSQ, 0, EPISQ}, (bf16_t*)(ws + WS_QGRAW), 1280, LGAIN + 192, 0.125f * 1.44269504f};
                DUP(7) pg8::gemm_phase(lds, g, S, E);
            PH_END
            if (j == 0) {
                PH_BEGIN
                    pg8::Gemm g{2048, 2048, 2048};
                    pg8::GridSched S{128, 1, G, cid, (const char*)(ws + WS_BLK), (size_t)256 * 2048 * 2, 0, (const char*)(ws + W_C1), 0, (size_t)256 * 2048 * 2, 64};
                    pg8::EpiBf16<1, false> E{HID, 256, pg8::RowScale{nullptr, 0, nullptr}, 1.f};
                    DUP(7) pg8::gemm_phase(lds, g, S, E);
                PH_END
                PH_BEGIN
                    pg8::Gemm g{256, 256, 256};
                    pg8::GridSched S{128, 1, G, cid, (const char*)HID, (size_t)256 * 256 * 2, 0, (const char*)(ws + W_C2), 0, (size_t)256 * 256 * 2, 64};
                    pg8::EpiCmp2 E{(float*)(ws + MS_CMPRAW)};
                    DUP(7) pg8::gemm_phase(lds, g, S, E);
                PH_END
                PH_BEGIN
                    DUP(6) p_cmp_finish(args);
                PH_END
            }
            PH_BEGIN
                p_attn<0>(args, lds);
#if PROBE_ATTN
                p_attn<PROBE_ATTN>(args, lds);
#endif
            PH_END
            PH_BEGIN
                pg8::Gemm g{DM, DM, DM};
                pg8::GridSched S{NTOK / 256, 4, G, cid, (const char*)HID, (size_t)256 * DM * 2, 0, (const char*)(ws + W_O) + (size_t)j * DM * DM * 2, (size_t)256 * DM * 2, 0, 1 << 30};
                pg8::EpiResid<bf16_t> E{XB, XB, SSQ, DM, 0, EPIP, 1.f};
                pg8::gemm_phase(lds, g, S, E);
            PH_END
        }
        if ((L & 1) == 0) {
            const int i = L >> 1;
            for (int ch = 0; ch < DENSE_NCHUNK; ++ch) {
                PH_BEGIN
                    pg8::Gemm g{DM, DM, DM};
                    pg8::GridSched S{DENSE_CHUNK_ROWS / 256, 28, G, cid, (const char*)(XB + (size_t)ch * DENSE_CHUNK_ROWS * DM), (size_t)256 * DM * 2, 0, (const char*)(ws + W_GU) + (size_t)i * 7168 * DM * 2, (size_t)256 * DM * 2, 0, 1 << 30};
                    pg8::EpiSwiGLU<true> E{HID, FFD, pg8::RowScale{SSQ, ch * DENSE_CHUNK_ROWS, EPISQ}, (unsigned*)(ws + MS_CMPRAW)};
                    pg8::gemm_phase(lds, g, S, E, WaitHook{SPLIT_OK && ch > 0, (unsigned*)(args.ws + WS_CTL), (volatile LAS unsigned*)(lds + MISC_OFF) + 8});
                PH_END_GROUP(SPLIT_OK)
                PH_BEGIN
                    pg8::Gemm g{FFD / 2, FFD / 2, FFD / 2};
                    pg8::GridSched S{DENSE_CHUNK_ROWS / 256, 4, G, cid, (const char*)HID, (size_t)256 * FFD, 0, (const char*)(ws + W_D) + (size_t)i * DM * FFD, (size_t)256 * FFD, 0, 1 << 30};
                    pg8::EpiResid<bf16_t> E{XB, XB, SSQ, DM, ch * DENSE_CHUNK_ROWS, EPIP, pg8::F8_OSC};
                    pg8::gemm_phase<pg8::EpiResid<bf16_t>, pg8::GridSched, pg8::NoHook, true, true>(lds, g, S, E);
                PH_END_SPLIT(SPLIT_OK && ch + 1 < DENSE_NCHUNK)
            }
        } else {
            const int l = L >> 1;
            PH_BEGIN
                if (l == 1) { p_convert_moe(args, lds, 1); __syncthreads(); }
                p_router_a(args, XB, l, lds);
            PH_END
            PH_BEGIN
                DUP(5) p_router_b(args, XB, lds);
            PH_END
            for (int ch = 0; ch < MOE_NCHUNK; ++ch) {
                PH_BEGIN
                    const int NT = *(const int*)(ws + CTL_NT), capT = (ch == MOE_NCHUNK - 1) ? MOE_LAST_TILES : MOE_CHUNK_TILES; int nT = NT - ch * MOE_CHUNK_TILES; nT = nT < 0 ? 0 : (nT > capT ? capT : nT);
                    LAS int* LTE = (LAS int*)(lds + MISC_OFF + 14336);
                    { const int t = opaque_tid(); if (t < nT) LTE[t] = ((const int*)(ws + CTL_TILEE))[ch * MOE_CHUNK_TILES + t]; __syncthreads(); }
                    pg8::Gemm g{DM / 2, DM / 2, DM / 2};
                    pg8::MoeSched S{nT, 28, G, cid, LTE, (const char*)(ws + WS_A + 128 * MiB) + (size_t)ch * MOE_CHUNK_TILES * 256 * DM, (size_t)256 * DM, (const char*)(ws + WS_WMOE), (size_t)256 * DM, 28};
                    pg8::EpiSwiGLU<false> E{HID, FFD, pg8::RowScale{nullptr, 0, nullptr}, (unsigned*)(ws + MS_CMPRAW)};
                    pg8::gemm_phase<pg8::EpiSwiGLU<false>, pg8::MoeSched, WaitHook, false, true>(lds, g, S, E, WaitHook{SPLIT_OK && ch > 0, (unsigned*)(args.ws + WS_CTL), (volatile LAS unsigned*)(lds + MISC_OFF) + 8});
                PH_END_GROUP(SPLIT_OK && ch + 1 < MOE_NCHUNK)
                PH_BEGIN
                    const int NT = *(const int*)(ws + CTL_NT), capT = (ch == MOE_NCHUNK - 1) ? MOE_LAST_TILES : MOE_CHUNK_TILES; int nT = NT - ch * MOE_CHUNK_TILES; nT = nT < 0 ? 0 : (nT > capT ? capT : nT);
                    LAS int* LTE = (LAS int*)(lds + MISC_OFF + 14336);
                    { const int t = opaque_tid(); if (t < nT) LTE[t] = ((const int*)(ws + CTL_TILEE))[ch * MOE_CHUNK_TILES + t]; __syncthreads(); }
                    { pg8::Gemm g{FFD / 2, FFD / 2, FFD / 2};
                      pg8::MoeSched S{nT, 4, G, cid, LTE, (const char*)HID, (size_t)256 * FFD, (const char*)(ws + WMOE_D), (size_t)256 * FFD, 4};
                      pg8::EpiBf16<0, false> E{(bf16_t*)(ws + WS_A) + (size_t)ch * MOE_CHUNK_TILES * 256 * DM, DM, pg8::RowScale{nullptr, 0, nullptr}, pg8::F8_OSC};
                      pg8::gemm_phase<pg8::EpiBf16<0, false>, pg8::MoeSched, pg8::NoHook, true, true>(lds, g, S, E); }
                PH_END_SPLIT(SPLIT_OK && ch + 1 < MOE_NCHUNK)
            }
            PH_BEGIN
                if (L == 3) p_moe_combine<true>(args, XB, SSQ, kargs.out); else p_moe_combine<false>(args, XB, SSQ, nullptr);
            PH_END
        }
    }
#undef PH_BEGIN
#undef PH_END
}

extern "C" void kernel_launch(void* const* d_in, const int* in_sizes, int n_in, void* d_out, int out_size, void* d_ws, size_t ws_size, hipStream_t stream) {
    static int grid = 0;
    if (grid == 0) {
        if (n_in != 22 || in_sizes[0] != NTOK * DM || out_size != NTOK * DM || ws_size < WS_END) {
            fprintf(stderr, "kernel_launch: unexpected problem: n_in %d in0 %d out %d ws %zu (need %zu)\n", n_in, n_in > 0 ? in_sizes[0] : -1, out_size, ws_size, (size_t)WS_END); grid = -1; return; }
        int dev = 0, cus = 0;
        if (hipGetDevice(&dev) != hipSuccess || hipDeviceGetAttribute(&cus, hipDeviceAttributeMultiprocessorCount, dev) != hipSuccess) { grid = -1; return; }
        if (hipFuncSetAttribute((const void*)yoco_fwd, hipFuncAttributeMaxDynamicSharedMemorySize, LDS_BYTES) != hipSuccess) { fprintf(stderr, "kernel_launch: hipFuncSetAttribute failed\n"); grid = -1; return; }
        int per_cu = 0;
        if (hipOccupancyMaxActiveBlocksPerMultiprocessor(&per_cu, (const void*)yoco_fwd, NTHREADS, LDS_BYTES) != hipSuccess || per_cu < 1)
            fprintf(stderr, "kernel_launch: note: occupancy query says %d\n", per_cu);
        (void)hipGetLastError();
        grid = cus;
    }
    if (grid < 0) return;
    (void)hipMemsetAsync((char*)d_ws + WS_CTL, 0, CTL_ZERO_BYTES, stream);
    Args a{};
    for (int i = 0; i < 22; ++i) a.in[i] = (const float*)d_in[i];
    a.out = (float*)d_out; a.ws = (unsigned char*)d_ws;
    constexpr int NPH = n_phases();
#if MK_SINGLE_LAUNCH
    a.ph_lo = 0; a.ph_hi = NPH;
    hipLaunchKernelGGL(yoco_fwd, dim3(grid), dim3(NTHREADS), LDS_BYTES, stream, a);
#else
    for (int p = 0; p < NPH; ++p) { a.ph_lo = p; a.ph_hi = p + 1; hipLaunchKernelGGL(yoco_fwd, dim3(grid), dim3(NTHREADS), LDS_BYTES, stream, a); }
#endif
}
```

```cpp
#include <hip/hip_runtime.h>
#include <cstdio>
#include <cstdint>

#ifndef MK_SINGLE_LAUNCH
#define MK_SINGLE_LAUNCH 1
#endif

#ifndef PROBE_BAR
#define PROBE_BAR 0
#endif
#ifndef PROBE_ATTN
#define PROBE_ATTN 0
#endif
#ifndef PROBE_DUP
#define PROBE_DUP 0
#endif
#define DUP(bit) for (int _rep = 0; _rep < (((PROBE_DUP) >> (bit)) & 1) + 1; ++_rep)
#define LAS __attribute__((address_space(3)))
typedef unsigned short bf16_t;
typedef short bf16x8 __attribute__((ext_vector_type(8)));
typedef float f32x4 __attribute__((ext_vector_type(4)));
typedef float f32x2 __attribute__((ext_vector_type(2)));
typedef unsigned u32x4 __attribute__((ext_vector_type(4)));
typedef int v8i32 __attribute__((ext_vector_type(8)));
typedef int v4i32 __attribute__((ext_vector_type(4)));
typedef unsigned u32x2 __attribute__((ext_vector_type(2)));

constexpr int NTOK = 65536, DM = 1024, FFD = 3584, NEXP = 8, SEQ = 2048, NBATCH = 32;
constexpr int NCMP = 127, NSLC = 32;
constexpr float EPS = 1e-6f;
constexpr float NEGF = -1e30f, TINYF = 1e-30f;

constexpr size_t MiB = (size_t)1 << 20;
constexpr size_t WS_CTL = 0;
constexpr size_t CTL_ZERO_BYTES = 64 * 1024;
constexpr size_t CTL_CNT = 64 * 1024;
constexpr size_t CTL_TILEE = 80 * 1024;
constexpr size_t CTL_NT = 88 * 1024;
constexpr size_t WS_W = 1 * MiB;
constexpr size_t W_POOL = WS_W;
constexpr size_t W_GU = W_POOL + (size_t)2 * 4 * 256 * 256 * 2;
constexpr size_t W_D = W_GU + (size_t)2 * 7168 * 1024 * 2;
constexpr size_t W_KV = W_D + (size_t)2 * 1024 * 3584 * 2;
constexpr size_t W_QG = W_KV + (size_t)1536 * 1024 * 2;
constexpr size_t W_O = W_QG + (size_t)2 * 1280 * 1024 * 2;
constexpr size_t W_C1 = W_O + (size_t)2 * 1024 * 1024 * 2;
constexpr size_t W_C2 = W_C1 + (size_t)2 * 256 * 2048 * 2;
constexpr size_t W_END = W_C2 + (size_t)2 * 256 * 256 * 2;
constexpr size_t WS_WMOE = 60 * MiB;
constexpr size_t WMOE_D = WS_WMOE + (size_t)8 * 7168 * 1024 * 2;
constexpr size_t WS_A = 228 * MiB;
constexpr size_t WS_BLK = WS_A + 128 * MiB;
constexpr size_t WS_KF = WS_WMOE;
constexpr size_t WS_VF = WS_WMOE + 64 * MiB;
constexpr size_t WS_KCF = WS_WMOE + 128 * MiB;
constexpr size_t WS_VCF = WS_KCF + 2 * MiB;
constexpr size_t WS_H = 488 * MiB;
constexpr size_t WS_KVRAW = 616 * MiB;
constexpr size_t WS_QGRAW = 808 * MiB;
constexpr size_t WS_MISC = 968 * MiB;
constexpr size_t MS_CMPRAW = WS_MISC;
constexpr size_t MS_RE = WS_MISC + 8 * MiB;
constexpr size_t MS_RG = MS_RE + 256 * 1024;
constexpr size_t MS_RSTD = MS_RG + 512 * 1024;
constexpr size_t MS_SLOT = MS_RSTD + 256 * 1024;
constexpr size_t MS_SSQ = MS_SLOT + 512 * 1024;
constexpr size_t WS_END = WS_MISC + 12 * MiB;
static_assert(W_END <= WS_WMOE, "weights region");

__device__ __forceinline__ unsigned f2bf(float f) { unsigned u = __builtin_bit_cast(unsigned, f); return (u + 0x7fffu + ((u >> 16) & 1u)) >> 16; }
__device__ __forceinline__ unsigned pk2(float lo, float hi) { return f2bf(lo) | (f2bf(hi) << 16); }
__device__ __forceinline__ float bf2f(unsigned short b) { return __builtin_bit_cast(float, (unsigned)b << 16); }
__device__ __forceinline__ float bflo(unsigned w) { return __builtin_bit_cast(float, w << 16); }
__device__ __forceinline__ float bfhi(unsigned w) { return __builtin_bit_cast(float, w & 0xffff0000u); }
__device__ __forceinline__ unsigned cvt_pk_bf16(float lo, float hi) { unsigned r; asm volatile("v_cvt_pk_bf16_f32 %0, %1, %2" : "=v"(r) : "v"(lo), "v"(hi)); return r; }
__device__ __forceinline__ f32x4 ld4(const float* p) { return *(const f32x4*)p; }
__device__ __forceinline__ f32x4 ld4(const bf16_t* p) { const u32x2 w = *(const u32x2*)p; return (f32x4){bflo(w.x), bfhi(w.x), bflo(w.y), bfhi(w.y)}; }
__device__ __forceinline__ void ld8(const float* p, f32x4& a, f32x4& b) { a = *(const f32x4*)p; b = *(const f32x4*)(p + 4); }
__device__ __forceinline__ void ld8(const bf16_t* p, f32x4& a, f32x4& b) { const u32x4 w = *(const u32x4*)p; a = (f32x4){bflo(w.x), bfhi(w.x), bflo(w.y), bfhi(w.y)}; b = (f32x4){bflo(w.z), bfhi(w.z), bflo(w.w), bfhi(w.w)}; }
__device__ __forceinline__ float wave_sum(float v) {
#pragma unroll
    for (int o = 1; o < 64; o <<= 1) v += __shfl_xor(v, o);
    return v;
}
__device__ __forceinline__ int opaque_tid() { int t = threadIdx.x; asm volatile("" : "+v"(t)); return t; }
__device__ __forceinline__ float silu_f(float g) { return g * __builtin_amdgcn_rcpf(1.f + __expf(-g)); }

namespace pg8 {
constexpr int BM = 256, BK = 64, HALF = 128, HTB = HALF * BK * 2, STAGE_BYTES = 8 * HTB, NXCD = 8, WGM = 8;
__host__ __device__ __forceinline__ int lds_byte(int r, int c) { const int st = (r >> 4) * 2 + (c >> 5), rr = r & 15, cc = c & 31, ob = rr * 64 + cc * 2; return st * 1024 + (ob ^ (((ob >> 9) & 1) << 5)); }
__host__ __device__ __forceinline__ void stage_rc(int b, int& R, int& C) { const int st = b / 1024, sb = b % 1024, swz = sb ^ (((sb >> 9) & 1) << 5); R = (st >> 1) * 16 + swz / 64; C = (st & 1) * 32 + (swz % 64) / 2; }
__host__ __device__ __forceinline__ int perm32(int rho) { const int n = rho >> 4, i = rho & 15; return 8 * (i >> 2) + 4 * n + (i & 3); }

struct Unit { int pm, pn; };
struct Gemm { int K, lda, ldb; };

__device__ __forceinline__ bool grid_order(int nM, int nN, int G, int c, int i, Unit& u) {
    const int nwg = nM * nN; const long L = (long)i * G + c; if (L >= nwg) return false;
    int wgid = (int)L; { const int q = nwg / NXCD, r = nwg % NXCD, xcd = wgid % NXCD, off = wgid / NXCD; wgid = (xcd < r ? xcd * (q + 1) : r * (q + 1) + (xcd - r) * q) + off; }
    const int nig = WGM * nN, gid = wgid / nig, fm = gid * WGM, gsz = (nM - fm) < WGM ? (nM - fm) : WGM;
    u.pm = fm + ((wgid % nig) % gsz); u.pn = (wgid % nig) / gsz; return true;
}
struct GridSched {
    int nM, nN, G, c; const char* A; size_t a_sm, a_sn; const char* B; size_t b_sn, b_sm; int b_div;
    __device__ __forceinline__ bool next(int i, Unit& u) const { return grid_order(nM, nN, G, c, i, u); }
    __device__ __forceinline__ const char* a_tile(const Unit& u) const { return A + (size_t)u.pm * a_sm + (size_t)u.pn * a_sn; }
    __device__ __forceinline__ const char* b_tile(const Unit& u) const { return B + (size_t)u.pn * b_sn + (size_t)(u.pm / b_div) * b_sm; }
};
struct MoeSched {
    int nM, nN, G, c; const LAS int* tile_e; const char* A; size_t a_sm; const char* B; size_t b_tile_bytes; int tiles_per_e;
    __device__ __forceinline__ bool next(int i, Unit& u) const { return grid_order(nM, nN, G, c, i, u); }
    __device__ __forceinline__ const char* a_tile(const Unit& u) const { return A + (size_t)u.pm * a_sm; }
    __device__ __forceinline__ const char* b_tile(const Unit& u) const { const int e = __builtin_amdgcn_readfirstlane(tile_e[u.pm]); return B + ((size_t)e * tiles_per_e + u.pn) * b_tile_bytes; }
};

constexpr int XSPLIT = 7, XK = 512, XROWS = 8 * 256;
constexpr float F8_HS = 8.f, F8_WS = 64.f, F8_OSC = 1.f / (F8_HS * F8_WS);
constexpr float F8_XS = 8.f, F8_GUS = 1.f / (F8_XS * F8_WS);
constexpr int XKE = XK / 2;
struct MoeSplitSched {
    int nX, G, c; const LAS int* tile_e; const char* A; size_t a_sm; const char* B; size_t b_tile_bytes;
    __device__ __forceinline__ bool next(int i, Unit& u) const { return grid_order(nX, 4 * XSPLIT, G, c, i, u); }
    __device__ __forceinline__ const char* a_tile(const Unit& u) const { return A + (size_t)u.pm * a_sm + (size_t)(u.pn >> 2) * (XK / 64) * 1024; }
    __device__ __forceinline__ const char* b_tile(const Unit& u) const { const int e = __builtin_amdgcn_readfirstlane(tile_e[u.pm]); return B + ((size_t)e * 4 + (u.pn & 3)) * b_tile_bytes + (size_t)(u.pn >> 2) * (XK / 64) * 1024; }
};
struct RowScale {
    const float* SSQ; int row_off; LAS float* SQ;
    __device__ __forceinline__ void pre_dma(const Unit& u, int slot, int wid, int lane) const {
        const float* g = SSQ + (size_t)(row_off + u.pm * BM) * 4 + wid * 64 + lane;
#pragma unroll
        for (int i = 0; i < 2; ++i) __builtin_amdgcn_global_load_lds((const unsigned*)(g + i * 512), (LAS unsigned*)(SQ + slot * 1024 + i * 512 + wid * 64), 4, 0, 0);
    }
    __device__ __forceinline__ float msq(int slot, int lrow) const { const f32x4 p = *(const LAS f32x4*)(SQ + slot * 1024 + lrow * 4); return ((p.x + p.y) + (p.z + p.w)) * (1.f / DM) + EPS; }
    __device__ __forceinline__ float get(int slot, int lrow) const { const f32x4 p = *(const LAS f32x4*)(SQ + slot * 1024 + lrow * 4); return __builtin_amdgcn_rsqf(((p.x + p.y) + (p.z + p.w)) * (1.f / DM) + EPS); }
};
template <typename TS> struct EpiResid {
    static constexpr bool PERM = true, PRE = false; static constexpr int NSTORE = 0;
    __device__ __forceinline__ void pre_dma(const Unit&, int, int, int) const {}
    const TS* src; bf16_t* XB; float* SSQ; int ld; int row_off; LAS float* P; float osc;
    __device__ __forceinline__ void operator()(const f32x4 (&acc)[2][2][4][2], const Unit& u, int wr, int wc, int fr, int fq, int) const {
        const int row0 = row_off + u.pm * BM + wr * 64 + fr, col0 = u.pn * BM + wc * 32 + 8 * fq;
#pragma unroll
        for (int ai = 0; ai < 2; ++ai)
#pragma unroll
            for (int m = 0; m < 4; ++m) { const size_t ro = (size_t)(row0 + ai * HALF + m * 16) * ld + col0; float ss = 0.f;
#pragma unroll
                for (int bj = 0; bj < 2; ++bj) { f32x4 v0, v1; ld8(src + ro + bj * HALF, v0, v1); v0 += acc[ai][bj][m][0] * osc; v1 += acc[ai][bj][m][1] * osc;
                        u32x4 w; w.x = cvt_pk_bf16(v0.x, v0.y); w.y = cvt_pk_bf16(v0.z, v0.w); w.z = cvt_pk_bf16(v1.x, v1.y); w.w = cvt_pk_bf16(v1.z, v1.w); *(u32x4*)(XB + ro + bj * HALF) = w;
                        ss += ((v0.x * v0.x + v0.y * v0.y) + (v0.z * v0.z + v0.w * v0.w)) + ((v1.x * v1.x + v1.y * v1.y) + (v1.z * v1.z + v1.w * v1.w)); }
                ss += __shfl_xor(ss, 16); ss += __shfl_xor(ss, 32);
                if (fq == 0) P[(ai * HALF + wr * 64 + m * 16 + fr) * 4 + wc] = ss; }
        asm volatile("s_waitcnt lgkmcnt(0)" ::: "memory"); __builtin_amdgcn_s_barrier(); asm volatile("" ::: "memory");
        const int t = opaque_tid();
        if (t < 256) { const f32x4 p = *(const LAS f32x4*)(P + t * 4); SSQ[(size_t)(row_off + u.pm * BM + t) * 4 + u.pn] = (p.x + p.y) + (p.z + p.w); }
    }
};
template <bool SCALE> struct EpiSwiGLU {
    static constexpr bool PERM = true, PRE = SCALE; static constexpr int NSTORE = 0;
    bf16_t* O; int ldc; RowScale R; unsigned* sink;
    __device__ __forceinline__ unsigned* dummy() const { return sink + (size_t)blockIdx.x * 4096; }
    __device__ __forceinline__ void pre_dma(const Unit& u, int slot, int wid, int lane) const { if (SCALE) R.pre_dma(u, slot, wid, lane); }
    __device__ __forceinline__ void operator()(const f32x4 (&acc)[2][2][4][2], const Unit& u, int wr, int wc, int fr, int fq, int slot) const {
        const int rb0 = u.pm * 16 + wr * 4, cb = u.pn * 2 + (wc >> 1), ncb = ldc >> 6;
#pragma unroll
        for (int ai = 0; ai < 2; ++ai)
#pragma unroll
            for (int m = 0; m < 4; ++m) { bf16_t* rowp = (bf16_t*)((char*)O + ((size_t)(rb0 + ai * 8 + m) * ncb + cb) * 1024 + fr * 64 + (wc & 1) * 32 + fq * 8);
                float nr = SCALE ? -1.44269504f : -1.44269504f * F8_GUS, ir2 = 1.f;
                if (SCALE) { ir2 = R.msq(slot, ai * HALF + wr * 64 + m * 16 + fr); nr = -1.44269504f * __builtin_amdgcn_rsqf(ir2); }
                u32x4 w = (u32x4){0u, 0u, 0u, 0u};
#pragma unroll
                for (int n = 0; n < 2; ++n) {
#pragma unroll
                    for (int hh = 0; hh < 2; ++hh) { const f32x2 g = (f32x2){acc[ai][0][m][n][2 * hh], acc[ai][0][m][n][2 * hh + 1]}, u = (f32x2){acc[ai][1][m][n][2 * hh], acc[ai][1][m][n][2 * hh + 1]};
                        const f32x2 t = g * nr; f32x2 e; e.x = __builtin_amdgcn_exp2f(t.x); e.y = __builtin_amdgcn_exp2f(t.y);
                        f32x2 d; if (SCALE) d = e * ir2 + ir2; else d = e + 1.0f;
                        f32x2 q; q.x = __builtin_amdgcn_rcpf(d.x); q.y = __builtin_amdgcn_rcpf(d.y);
                        const f32x2 hv = (g * u) * q;
                        { const f32x2 h8 = hv * (SCALE ? F8_HS : F8_HS * F8_GUS * F8_GUS);
                            if (n == 0 && hh == 0) w.x = (unsigned)__builtin_amdgcn_cvt_pk_fp8_f32(h8.x, h8.y, (int)w.x, false); else if (n == 0) w.x = (unsigned)__builtin_amdgcn_cvt_pk_fp8_f32(h8.x, h8.y, (int)w.x, true);
                            else if (hh == 0) w.y = (unsigned)__builtin_amdgcn_cvt_pk_fp8_f32(h8.x, h8.y, (int)w.y, false); else w.y = (unsigned)__builtin_amdgcn_cvt_pk_fp8_f32(h8.x, h8.y, (int)w.y, true); } } }
                *(u32x2*)rowp = (u32x2){w.x, w.y}; }
    }
};
template <int ACT  , bool SCALE> struct EpiBf16 {
    static constexpr bool PERM = true, PRE = SCALE; static constexpr int NSTORE = 0;
    bf16_t* O; int ldc; RowScale R; float osc;
    __device__ __forceinline__ void pre_dma(const Unit& u, int slot, int wid, int lane) const { if (SCALE) R.pre_dma(u, slot, wid, lane); }
    __device__ __forceinline__ void operator()(const f32x4 (&acc)[2][2][4][2], const Unit& u, int wr, int wc, int fr, int fq, int slot) const {
        const int row0 = u.pm * BM + wr * 64 + fr, col0 = u.pn * BM + wc * 32 + 8 * fq;
#pragma unroll
        for (int ai = 0; ai < 2; ++ai)
#pragma unroll
            for (int m = 0; m < 4; ++m) { bf16_t* rowp = O + (size_t)(row0 + ai * HALF + m * 16) * ldc + col0;
                const float r = (SCALE ? R.get(slot, ai * HALF + wr * 64 + m * 16 + fr) : 1.f) * osc;
#pragma unroll
                for (int bj = 0; bj < 2; ++bj) { f32x4 v0 = acc[ai][bj][m][0] * r, v1 = acc[ai][bj][m][1] * r;
                    if (ACT == 1) {
#pragma unroll
                        for (int j = 0; j < 4; ++j) { v0[j] = silu_f(v0[j]); v1[j] = silu_f(v1[j]); } }
                    u32x4 w; w.x = cvt_pk_bf16(v0[0], v0[1]); w.y = cvt_pk_bf16(v0[2], v0[3]); w.z = cvt_pk_bf16(v1[0], v1[1]); w.w = cvt_pk_bf16(v1[2], v1[3]);
                    *(u32x4*)(rowp + bj * HALF) = w; } }
    }
};

struct EpiPart {
    static constexpr bool PERM = true, PRE = false; static constexpr int NSTORE = 0;
    bf16_t* P;
    __device__ __forceinline__ void pre_dma(const Unit&, int, int, int) const {}
    __device__ __forceinline__ void operator()(const f32x4 (&acc)[2][2][4][2], const Unit& u, int wr, int wc, int fr, int fq, int) const {
        const int row0 = u.pm * BM + wr * 64 + fr, col0 = (u.pn & 3) * BM + wc * 32 + 8 * fq; bf16_t* O = P + (size_t)(u.pn >> 2) * XROWS * DM;
#pragma unroll
        for (int ai = 0; ai < 2; ++ai)
#pragma unroll
            for (int m = 0; m < 4; ++m) { bf16_t* rowp = O + (size_t)(row0 + ai * HALF + m * 16) * DM + col0;
#pragma unroll
                for (int bj = 0; bj < 2; ++bj) { const f32x4 v0 = acc[ai][bj][m][0] * F8_OSC, v1 = acc[ai][bj][m][1] * F8_OSC;
                    u32x4 w; w.x = cvt_pk_bf16(v0[0], v0[1]); w.y = cvt_pk_bf16(v0[2], v0[3]); w.z = cvt_pk_bf16(v1[0], v1[1]); w.w = cvt_pk_bf16(v1[2], v1[3]);
                    *(u32x4*)(rowp + bj * HALF) = w; } }
    }
};

__device__ __forceinline__ int vt_pos_(int k) { return (k & ~12) | ((k & 4) << 1) | ((k & 8) >> 1); }
struct EpiKV {
    static constexpr bool PERM = true, PRE = true; static constexpr int NSTORE = 0;
    RowScale R; bf16_t* BLK; bf16_t* KF; bf16_t* VF; const LAS float* gain; const LAS float* pos;
    __device__ __forceinline__ void pre_dma(const Unit& u, int slot, int wid, int lane) const { R.pre_dma(u, slot, wid, lane); }
    __device__ __forceinline__ void operator()(const f32x4 (&acc)[2][2][4][2], const Unit& u, int wr, int wc, int fr, int fq, int slot) const {
        const int kind = u.pn, w = kind >> 1, g = wc;
#pragma unroll
        for (int ai = 0; ai < 2; ++ai)
#pragma unroll
            for (int m = 0; m < 4; ++m) {
                const int lrow = ai * HALF + wr * 64 + m * 16 + fr, row = u.pm * BM + lrow, b = row >> 11, t = row & 2047;
                const float rs = R.get(slot, lrow);
                f32x4 v[2][2];
#pragma unroll
                for (int bj = 0; bj < 2; ++bj)
#pragma unroll
                    for (int n = 0; n < 2; ++n) v[bj][n] = acc[ai][bj][m][n] * rs;
                if (kind < 2) {
#pragma unroll
                    for (int which = 0; which < 2; ++which) { const int c = (t >> 4) - which, l = (t & 15) + 16 * which;
                        if (c >= 0 && c < NCMP) { bf16_t* dst = BLK + ((size_t)kind * 16384 + (size_t)(b * NCMP + c) * 4 + g) * 2048 + l * 64;
#pragma unroll
                            for (int bj = 0; bj < 2; ++bj) { const int d0 = 32 * bj + 8 * fq; const LAS float* pp = pos + (kind * 32 + l) * 64 + d0;
                                const f32x4 p0 = *(const LAS f32x4*)pp, p1 = *(const LAS f32x4*)(pp + 4); const f32x4 x0 = v[bj][0] + p0, x1 = v[bj][1] + p1;
                                u32x4 o; o.x = cvt_pk_bf16(x0[0], x0[1]); o.y = cvt_pk_bf16(x0[2], x0[3]); o.z = cvt_pk_bf16(x1[0], x1[1]); o.w = cvt_pk_bf16(x1[2], x1[3]);
                                *(u32x4*)(dst + d0) = o; } } }
                } else if ((kind & 1) == 0) {
                    float ss = 0.f;
#pragma unroll
                    for (int bj = 0; bj < 2; ++bj)
#pragma unroll
                        for (int n = 0; n < 2; ++n) ss += (v[bj][n][0] * v[bj][n][0] + v[bj][n][1] * v[bj][n][1]) + (v[bj][n][2] * v[bj][n][2] + v[bj][n][3] * v[bj][n][3]);
                    ss += __shfl_xor(ss, 16); ss += __shfl_xor(ss, 32);
                    const float rn = __builtin_amdgcn_rsqf(ss * (1.f / 64.f) + EPS);
                    const int kk = t & 63; bf16_t* tile = KF + (((size_t)(w - 1) * 128 + b * 4 + g) * 32 + (t >> 6)) * 4096;
#pragma unroll
                    for (int bj = 0; bj < 2; ++bj) { const int d0 = 32 * bj + 8 * fq; const LAS float* gp = gain + w * 64 + d0;
                        const f32x4 g0 = *(const LAS f32x4*)gp, g1 = *(const LAS f32x4*)(gp + 4); const f32x4 x0 = v[bj][0] * rn * g0, x1 = v[bj][1] * rn * g1;
                        u32x4 o; o.x = cvt_pk_bf16(x0[0], x0[1]); o.y = cvt_pk_bf16(x0[2], x0[3]); o.z = cvt_pk_bf16(x1[0], x1[1]); o.w = cvt_pk_bf16(x1[2], x1[3]);
                        *(u32x4*)(tile + (((kk >> 5) * 4 + (d0 >> 4)) * 64 + ((d0 >> 3) & 1) * 32 + (kk & 31)) * 8) = o; }
                } else {
                    const int kk = t & 63, ps = vt_pos_(kk); bf16_t* tile = VF + (((size_t)(w - 1) * 128 + b * 4 + g) * 32 + (t >> 6)) * 4096 + (((ps >> 4) * 2) * 64 + ((ps >> 3) & 1) * 32) * 8 + (ps & 7);
#pragma unroll
                    for (int bj = 0; bj < 2; ++bj)
#pragma unroll
                        for (int n = 0; n < 2; ++n)
#pragma unroll
                            for (int jj = 0; jj < 4; ++jj) { const int cc = 8 * fq + 4 * n + jj;
                                tile[(bj * 64 + cc) * 8] = (bf16_t)(cvt_pk_bf16(v[bj][n][jj], 0.f) & 0xffffu); }
                } }
    }
};
struct EpiQG {
    static constexpr bool PERM = true, PRE = true; static constexpr int NSTORE = 0;
    RowScale R; bf16_t* Q; int ldq; const LAS float* gain; float qscale;
    __device__ __forceinline__ void pre_dma(const Unit& u, int slot, int wid, int lane) const { R.pre_dma(u, slot, wid, lane); }
    __device__ __forceinline__ void operator()(const f32x4 (&acc)[2][2][4][2], const Unit& u, int wr, int wc, int fr, int fq, int slot) const {
#pragma unroll
        for (int ai = 0; ai < 2; ++ai)
#pragma unroll
            for (int m = 0; m < 4; ++m) {
                const int lrow = ai * HALF + wr * 64 + m * 16 + fr, row = u.pm * BM + lrow;
                const float rs = R.get(slot, lrow);
                f32x4 v[2][2];
#pragma unroll
                for (int bj = 0; bj < 2; ++bj)
#pragma unroll
                    for (int n = 0; n < 2; ++n) v[bj][n] = acc[ai][bj][m][n] * rs;
                if (u.pn < 4) {
                    float ss = 0.f;
#pragma unroll
                    for (int bj = 0; bj < 2; ++bj)
#pragma unroll
                        for (int n = 0; n < 2; ++n) ss += (v[bj][n][0] * v[bj][n][0] + v[bj][n][1] * v[bj][n][1]) + (v[bj][n][2] * v[bj][n][2] + v[bj][n][3] * v[bj][n][3]);
                    ss += __shfl_xor(ss, 16); ss += __shfl_xor(ss, 32);
                    const float rn = qscale * __builtin_amdgcn_rsqf(ss * (1.f / 64.f) + EPS);
                    bf16_t* dst = Q + (size_t)row * ldq + (4 * u.pn + wc) * 64;
#pragma unroll
                    for (int bj = 0; bj < 2; ++bj) { const int d0 = 32 * bj + 8 * fq; const LAS float* gp = gain + d0;
                        const f32x4 g0 = *(const LAS f32x4*)gp, g1 = *(const LAS f32x4*)(gp + 4); const f32x4 x0 = v[bj][0] * rn * g0, x1 = v[bj][1] * rn * g1;
                        u32x4 o; o.x = cvt_pk_bf16(x0[0], x0[1]); o.y = cvt_pk_bf16(x0[2], x0[3]); o.z = cvt_pk_bf16(x1[0], x1[1]); o.w = cvt_pk_bf16(x1[2], x1[3]);
                        *(u32x4*)(dst + d0) = o; }
                } else {
#pragma unroll
                    for (int bj = 0; bj < 2; ++bj) { const int o0 = 64 * wc + 32 * bj + 8 * fq;
                        if (o0 < 48) { u32x4 o; o.x = cvt_pk_bf16(v[bj][0][0], v[bj][0][1]); o.y = cvt_pk_bf16(v[bj][0][2], v[bj][0][3]); o.z = cvt_pk_bf16(v[bj][1][0], v[bj][1][1]); o.w = cvt_pk_bf16(v[bj][1][2], v[bj][1][3]);
                            *(u32x4*)(Q + (size_t)row * ldq + 1024 + o0) = o; } }
                } }
    }
};

struct EpiCmp2 {
    static constexpr bool PERM = true, PRE = false; static constexpr int NSTORE = 0;
    float* CMP;
    __device__ __forceinline__ void pre_dma(const Unit&, int, int, int) const {}
    __device__ __forceinline__ void operator()(const f32x4 (&acc)[2][2][4][2], const Unit& u, int wr, int wc, int fr, int fq, int) const {
        if (wc != 0) return;
#pragma unroll
        for (int ai = 0; ai < 2; ++ai)
#pragma unroll
            for (int m = 0; m < 4; ++m) { float* rowp = CMP + (size_t)(u.pm * BM + ai * HALF + wr * 64 + m * 16 + fr) * 64 + 8 * fq;
#pragma unroll
                for (int bj = 0; bj < 2; ++bj) { *(f32x4*)(rowp + 32 * bj) = acc[ai][bj][m][0]; *(f32x4*)(rowp + 32 * bj + 4) = acc[ai][bj][m][1]; } }
    }
};

struct NoHook { static constexpr bool ON = false; __device__ __forceinline__ void operator()() const {} };
template <class Epi, class Sched, class Hook = NoHook, bool ATILED = false, bool FP8 = false>
__device__ __forceinline__ void gemm_phase(LAS unsigned char* lds, const Gemm g, const Sched& S, const Epi& E, const Hook hook = Hook()) {
    const int tid = opaque_tid(), wid = __builtin_amdgcn_readfirstlane(tid >> 6), lane = tid & 63, wr = wid >> 2, wc = wid & 3, fr = lane & 15, fq = lane >> 4;
    int nt = g.K / BK; asm volatile("" : "+s"(nt));
    unsigned voffA[2], voffB[2];
#pragma unroll
    for (int i = 0; i < 2; ++i) { int R, C; stage_rc(tid * 16 + i * 8192, R, C); const int Rb = Epi::PERM ? ((R & ~31) + perm32(R & 31)) : R;
        voffA[i] = ATILED ? (unsigned)((((R >> 4) * (g.lda >> 5) + (C >> 5)) << 10) + (R & 15) * 64 + (C & 31) * 2) : (unsigned)(R * g.lda + C) * 2u;
        static_assert(Epi::PERM, "the converted weights are stored in the PERM row order"); (void)Rb;
        voffB[i] = (unsigned)((((R >> 4) * (g.ldb >> 5) + (C >> 5)) << 10) + (R & 15) * 64 + (C & 31) * 2); }
    const size_t voffA_step = ATILED ? (size_t)4 * (g.lda >> 5) * 1024 : (size_t)64 * g.lda * 2, voffB_step = (size_t)4 * (g.ldb >> 5) * 1024;
    const size_t kstep = (size_t)2048, kstepA = ATILED ? (size_t)2048 : (size_t)(BK * 2);
    const size_t hstepA = ATILED ? (size_t)(HALF / 16) * (g.lda >> 5) * 1024 : (size_t)HALF * g.lda * 2, hstepB = (size_t)(HALF / 16) * (g.ldb >> 5) * 1024;
    const unsigned ldsw = (unsigned)wid * 1024u;
    const int lanep = lds_byte(fr, fq * 8), aoffs = wr * 8192, boffs = wc * 4096;
#define aoff (__extension__({ int o_ = lanep; asm volatile("" : "+v"(o_)); o_ + aoffs; }))
#define boff (__extension__({ int o_ = lanep; asm volatile("" : "+v"(o_)); o_ + boffs; }))
#define PG8_SA(b, h) (((b) * 2 + (h)) * HTB)
#define PG8_SB(b, h) ((4 + (b) * 2 + (h)) * HTB)
#define PG8_STAGE(bufoff, gbase, voff) do { _Pragma("unroll") for (int _i = 0; _i < 2; ++_i) \
        { unsigned vo_ = (voff)[0]; asm volatile("" : "+v"(vo_)); __builtin_amdgcn_global_load_lds((const unsigned*)((const char*)(gbase) + _i * voff##_step + vo_), (LAS unsigned*)(lds + (bufoff) + ldsw + _i * 8192), 16, 0, 0); } } while (0)
#define PG8_LDA(dst, b, h) do { const int aoff_ = aoff; _Pragma("unroll") for (int m = 0; m < 4; ++m) { \
        if constexpr (FP8) { const v4i32 l_ = *(const LAS v4i32*)(lds + PG8_SA(b, h) + aoff_ + m * 2048), h_ = *(const LAS v4i32*)(lds + PG8_SA(b, h) + aoff_ + m * 2048 + 1024); dst##8[m] = __builtin_shufflevector(l_, h_, 0, 1, 2, 3, 4, 5, 6, 7); } \
        else { _Pragma("unroll") for (int k = 0; k < 2; ++k) dst[m][k] = *(const LAS bf16x8*)(lds + PG8_SA(b, h) + aoff_ + m * 2048 + k * 1024); } } } while (0)
#define PG8_LDB(dst, b, h) do { const int boff_ = boff; _Pragma("unroll") for (int n = 0; n < 2; ++n) { \
        if constexpr (FP8) { const v4i32 l_ = *(const LAS v4i32*)(lds + PG8_SB(b, h) + boff_ + n * 2048), h_ = *(const LAS v4i32*)(lds + PG8_SB(b, h) + boff_ + n * 2048 + 1024); dst##8[n] = __builtin_shufflevector(l_, h_, 0, 1, 2, 3, 4, 5, 6, 7); } \
        else { _Pragma("unroll") for (int k = 0; k < 2; ++k) dst[n][k] = *(const LAS bf16x8*)(lds + PG8_SB(b, h) + boff_ + n * 2048 + k * 1024); } } } while (0)
#define PG8_MMA(ai, bj, At, Bt) do { __builtin_amdgcn_s_setprio(1); _Pragma("unroll") for (int m = 0; m < 4; ++m) _Pragma("unroll") for (int n = 0; n < 2; ++n) { \
        if constexpr (FP8) { acc[ai][bj][m][n] = __builtin_amdgcn_mfma_scale_f32_16x16x128_f8f6f4(Bt##8[n], At##8[m], acc[ai][bj][m][n], 0, 0, 0, 0x7f7f7f7f, 0, 0x7f7f7f7f); } \
        else { _Pragma("unroll") for (int k = 0; k < 2; ++k) acc[ai][bj][m][n] = __builtin_amdgcn_mfma_f32_16x16x32_bf16(Bt[n][k], At[m][k], acc[ai][bj][m][n], 0, 0, 0); } } \
        __builtin_amdgcn_s_setprio(0); } while (0)
#define PG8_WAIT_V(n) asm volatile("s_waitcnt vmcnt(" #n ")" ::: "memory")
#define PG8_WAIT_L(n) asm volatile("s_waitcnt lgkmcnt(" #n ")" ::: "memory")
#define PG8_BAR __builtin_amdgcn_s_barrier()
#define PG8_SCHED __builtin_amdgcn_sched_barrier(0)
    Unit cur, nxt; int ui = 0;
    static_assert(Epi::NSTORE == 0 || Epi::NSTORE == 8, "the relaxed waits are written for 8 epilogue stores");
    if (!S.next(0, cur)) { if constexpr (Hook::ON) hook(); return; }
    f32x4 acc[2][2][4][2];
#pragma unroll
    for (int a = 0; a < 2; ++a)
#pragma unroll
        for (int b = 0; b < 2; ++b)
#pragma unroll
            for (int m = 0; m < 4; ++m)
#pragma unroll
                for (int n = 0; n < 2; ++n) acc[a][b][m][n] = (f32x4){0.f, 0.f, 0.f, 0.f};
    bf16x8 At[4][2], B0[2][2], B1[2][2]; v8i32 At8[4], B08[2], B18[2];
    const char* cA = S.a_tile(cur); const char* cB = S.b_tile(cur);
    if constexpr (Epi::PRE) E.pre_dma(cur, 0, wid, lane);
    PG8_STAGE(PG8_SB(0, 0), cB, voffB); PG8_STAGE(PG8_SB(0, 1), cB + hstepB, voffB); PG8_STAGE(PG8_SA(0, 0), cA, voffA); PG8_STAGE(PG8_SA(0, 1), cA + hstepA, voffA);
    if (wr == 1) PG8_BAR;
    PG8_WAIT_V(2); PG8_BAR;
    PG8_STAGE(PG8_SB(1, 0), cB + kstep, voffB); PG8_STAGE(PG8_SA(1, 0), cA + kstepA, voffA); PG8_STAGE(PG8_SB(1, 1), cB + hstepB + kstep, voffB);
    PG8_WAIT_V(6); PG8_BAR;
    if constexpr (Epi::NSTORE == 8) {
        PG8_STAGE(PG8_SA(1, 1), cA + kstepA + hstepA, voffA);
        unsigned* dz = E.dummy() + tid;
#pragma unroll
        for (int i = 0; i < 8; ++i) __builtin_nontemporal_store(0u, dz + i * 512); }
    for (;;) {
        const bool has_next = S.next(ui + 1, nxt);
        const char* nA = has_next ? S.a_tile(nxt) : cA; const char* nB = has_next ? S.b_tile(nxt) : cB;
        int t = 0;
        if constexpr (Epi::NSTORE == 8) {
            const bool last = (t == nt - 2);
            const char* a2 = last ? nA : cA + (size_t)(t + 2) * kstepA; const char* b2 = last ? nB : cB + (size_t)(t + 2) * kstep;
            const char* a3 = a2 + kstepA; const char* b3 = b2 + kstep;
            if constexpr (Epi::PRE) { if (last && has_next) E.pre_dma(nxt, (ui + 1) & 1, wid, lane); }
            PG8_LDB(B0, 0, 0); PG8_LDB(B1, 0, 1); PG8_SCHED; PG8_LDA(At, 0, 0);
            PG8_WAIT_V(16); PG8_WAIT_L(0); PG8_BAR; PG8_MMA(0, 0, At, B0); PG8_MMA(0, 1, At, B1); PG8_BAR; PG8_SCHED;
            PG8_LDA(At, 0, 1); PG8_STAGE(PG8_SB(0, 0), b2, voffB); PG8_STAGE(PG8_SB(0, 1), b2 + hstepB, voffB); PG8_STAGE(PG8_SA(0, 0), a2, voffA);
            PG8_WAIT_V(16); PG8_WAIT_L(0); PG8_BAR; PG8_MMA(1, 0, At, B0); PG8_MMA(1, 1, At, B1); PG8_BAR; PG8_SCHED;
            PG8_LDB(B0, 1, 0); PG8_LDB(B1, 1, 1); PG8_SCHED; PG8_LDA(At, 1, 0); PG8_STAGE(PG8_SA(0, 1), a2 + hstepA, voffA);
            PG8_WAIT_V(16); PG8_WAIT_L(0); PG8_BAR; PG8_MMA(0, 0, At, B0); PG8_MMA(0, 1, At, B1); PG8_BAR; PG8_SCHED;
            PG8_LDA(At, 1, 1); PG8_STAGE(PG8_SB(1, 0), b3, voffB); PG8_STAGE(PG8_SB(1, 1), b3 + hstepB, voffB); PG8_STAGE(PG8_SA(1, 0), a3, voffA);
            PG8_WAIT_V(8); PG8_WAIT_L(0); PG8_BAR; PG8_MMA(1, 0, At, B0); PG8_MMA(1, 1, At, B1); PG8_BAR; PG8_SCHED;
            t = 2; }
        for (; t < nt; t += 2) {
            const bool last = (t == nt - 2);
            const char* a1 = cA + (size_t)(t + 1) * kstepA;
            const char* a2 = last ? nA : cA + (size_t)(t + 2) * kstepA; const char* b2 = last ? nB : cB + (size_t)(t + 2) * kstep;
            const char* a3 = a2 + kstepA; const char* b3 = b2 + kstep;
            if constexpr (Epi::PRE) { if (last && has_next) E.pre_dma(nxt, (ui + 1) & 1, wid, lane); }
            PG8_LDB(B0, 0, 0); PG8_LDB(B1, 0, 1); PG8_SCHED; PG8_LDA(At, 0, 0); PG8_STAGE(PG8_SA(1, 1), a1 + hstepA, voffA);
            PG8_WAIT_V(8); PG8_WAIT_L(0); PG8_BAR; PG8_MMA(0, 0, At, B0); PG8_MMA(0, 1, At, B1); PG8_BAR; PG8_SCHED;
            PG8_LDA(At, 0, 1); PG8_STAGE(PG8_SB(0, 0), b2, voffB); PG8_STAGE(PG8_SB(0, 1), b2 + hstepB, voffB); PG8_STAGE(PG8_SA(0, 0), a2, voffA);
            PG8_WAIT_V(8); PG8_WAIT_L(0); PG8_BAR; PG8_MMA(1, 0, At, B0); PG8_MMA(1, 1, At, B1); PG8_BAR; PG8_SCHED;
            PG8_LDB(B0, 1, 0); PG8_LDB(B1, 1, 1); PG8_SCHED; PG8_LDA(At, 1, 0); PG8_STAGE(PG8_SA(0, 1), a2 + hstepA, voffA);
            PG8_WAIT_V(8); PG8_WAIT_L(0); PG8_BAR; PG8_MMA(0, 0, At, B0); PG8_MMA(0, 1, At, B1); PG8_BAR; PG8_SCHED;
            PG8_LDA(At, 1, 1); PG8_STAGE(PG8_SB(1, 0), b3, voffB); PG8_STAGE(PG8_SB(1, 1), b3 + hstepB, voffB); PG8_STAGE(PG8_SA(1, 0), a3, voffA);
            PG8_WAIT_V(8); PG8_WAIT_L(0); PG8_BAR; PG8_MMA(1, 0, At, B0); PG8_MMA(1, 1, At, B1); PG8_BAR; PG8_SCHED;
        }
        if (wr == 0) PG8_BAR;
        if constexpr (Hook::ON) { if (ui == 0) hook(); }
        if constexpr (Epi::NSTORE == 8) {
            if (has_next) PG8_STAGE(PG8_SA(1, 1), nA + kstepA + hstepA, voffA); }
        { const int tz = opaque_tid(), lz = tz & 63;
          E(acc, cur, wr, wc, lz & 15, lz >> 4, ui & 1); }
        if (!has_next) break;
#pragma unroll
        for (int a = 0; a < 2; ++a)
#pragma unroll
            for (int b = 0; b < 2; ++b)
#pragma unroll
                for (int m = 0; m < 4; ++m)
#pragma unroll
                    for (int n = 0; n < 2; ++n) acc[a][b][m][n] = (f32x4){0.f, 0.f, 0.f, 0.f};
        cur = nxt; cA = nA; cB = nB; ++ui;
        if (wr == 1) PG8_BAR;
    }
    PG8_WAIT_V(0);
    PG8_BAR;
#undef PG8_SA
#undef PG8_SB
#undef PG8_STAGE
#undef PG8_LDA
#undef PG8_LDB
#undef PG8_MMA
#undef PG8_WAIT_V
#undef PG8_WAIT_L
#undef PG8_BAR
#undef PG8_SCHED
#undef aoff
#undef boff
}
}

#define XB_TMO      128
#define XB_XCNT(j)  (256  + 64 * (j))
#define XB_XSUB(j)  (1280 + 64 * (j))
#define XB_XGEN(j)  (2304 + 64 * (j))
#define XB_TOP      3328
#define XB_TOPGEN   3392
#define XCD_BAR_WORDS 3456
#define XB_SPIN_CAP (1u << 22)
__device__ __forceinline__ unsigned xb_ld(unsigned* p)              { return __hip_atomic_load(p, __ATOMIC_RELAXED, __HIP_MEMORY_SCOPE_AGENT); }
__device__ __forceinline__ unsigned xb_add(unsigned* p, unsigned v) { return __hip_atomic_fetch_add(p, v, __ATOMIC_RELAXED, __HIP_MEMORY_SCOPE_AGENT); }
__device__ __forceinline__ unsigned xb_xcc_id() { return (unsigned)__builtin_amdgcn_s_getreg((3 << 11) | 20) & 0xFu; }
#define XB_SPIN(cond, bar) do { unsigned _sp = 0; while (cond) { __builtin_amdgcn_s_sleep(1); \
    if ((++_sp & 255u) == 0u) { if (xb_ld(&(bar)[XB_TMO])) break; if (_sp > XB_SPIN_CAP) { atomicAdd(&(bar)[XB_TMO], 1u); break; } } } } while (0)
struct XcdBarrier { unsigned* bar; unsigned x; volatile LAS unsigned* st; };
__device__ __forceinline__ XcdBarrier xcd_barrier_post(unsigned* bar, volatile LAS unsigned* st) {
    XcdBarrier b; b.bar = bar; b.x = xb_xcc_id(); b.st = st;
    if (threadIdx.x == 0) (void)xb_add(&bar[XB_XCNT(b.x)], 1u);
    return b;
}
__device__ __forceinline__ void xcd_barrier_complete(unsigned* bar, unsigned x, unsigned& nloc, unsigned& nx) {
    const unsigned G = gridDim.x * gridDim.y * gridDim.z;
    unsigned sum, cnt, mine, sp = 0u;
    for (;;) {
        sum = 0u; cnt = 0u; mine = 0u;
#pragma unroll
        for (unsigned j = 0; j < 16; ++j) { const unsigned c = xb_ld(&bar[XB_XCNT(j)]); sum += c; cnt += (c > 0u) ? 1u : 0u; mine = (j == x) ? c : mine; }
        if (sum == G) break;
        __builtin_amdgcn_s_sleep(1);
        if ((++sp & 255u) == 0u) { if (xb_ld(&bar[XB_TMO])) break; if (sp > XB_SPIN_CAP) { atomicAdd(&bar[XB_TMO], 1u); break; } }
    }
    nloc = mine > 0u ? mine : 1u; nx = cnt > 0u ? cnt : 1u;
}
__device__ __forceinline__ void xcd_barrier(const XcdBarrier& b) {
    asm volatile("s_waitcnt vmcnt(0)" ::: "memory");
    __syncthreads();
    if (threadIdx.x == 0) {
        unsigned* bar = b.bar;
        __builtin_amdgcn_s_waitcnt(0);
        unsigned nloc = b.st[0], nx = b.st[1];
        if (nloc == 0u) { xcd_barrier_complete(bar, b.x, nloc, nx); b.st[0] = nloc; b.st[1] = nx; }
        const unsigned old = xb_add(&bar[XB_XSUB(b.x)], 1u);
        const unsigned gen = old / nloc;
        if (old + 1u == (gen + 1u) * nloc) {
            __builtin_amdgcn_fence(__ATOMIC_RELEASE, "agent");
            asm volatile("s_waitcnt vmcnt(0)" ::: "memory");
            const unsigned og = xb_add(&bar[XB_TOP], 1u);
            const unsigned tg = og / nx;
            if (og + 1u == (tg + 1u) * nx) xb_add(&bar[XB_TOPGEN], 1u);
            else XB_SPIN(xb_ld(&bar[XB_TOPGEN]) == tg, bar);
            __builtin_amdgcn_fence(__ATOMIC_ACQUIRE, "agent");
            xb_add(&bar[XB_XGEN(b.x)], 1u);
            asm volatile("s_waitcnt vmcnt(0)" ::: "memory");
        } else {
            XB_SPIN((int)(xb_ld(&bar[XB_XGEN(b.x)]) - (gen + 1u)) < 0, bar);
            __builtin_amdgcn_fence(__ATOMIC_ACQUIRE, "agent");
            asm volatile("s_waitcnt vmcnt(0)" ::: "memory");
        }
    }
    __syncthreads();
}
__device__ __forceinline__ void xcd_arrive(const XcdBarrier& b) {
    asm volatile("s_waitcnt vmcnt(0)" ::: "memory");
    __syncthreads();
    if (threadIdx.x == 0) {
        unsigned* bar = b.bar;
        __builtin_amdgcn_s_waitcnt(0);
        unsigned nloc = b.st[0], nx = b.st[1];
        if (nloc == 0u) { xcd_barrier_complete(bar, b.x, nloc, nx); b.st[0] = nloc; b.st[1] = nx; }
        const unsigned old = xb_add(&bar[XB_XSUB(b.x)], 1u);
        const unsigned gen = old / nloc;
        unsigned leader = 0u;
        if (old + 1u == (gen + 1u) * nloc) {
            leader = 1u;
            __builtin_amdgcn_fence(__ATOMIC_RELEASE, "agent");
            asm volatile("s_waitcnt vmcnt(0)" ::: "memory");
            const unsigned og = xb_add(&bar[XB_TOP], 1u);
            const unsigned tg = og / nx;
            if (og + 1u == (tg + 1u) * nx) xb_add(&bar[XB_TOPGEN], 1u);
        }
        b.st[2] = gen; b.st[3] = leader;
    }
}
__device__ __forceinline__ void xcd_wait_arrived(const XcdBarrier& b) {
    if (threadIdx.x == 0) {
        unsigned* bar = b.bar; const unsigned gen = b.st[2], leader = b.st[3];
        XB_SPIN((int)(xb_ld(&bar[XB_TOPGEN]) - (gen + 1u)) < 0, bar);
        __builtin_amdgcn_fence(__ATOMIC_ACQUIRE, "agent");
        if (leader) xb_add(&bar[XB_XGEN(b.x)], 1u);
        asm volatile("s_waitcnt vmcnt(0)" ::: "memory");
    }
    __syncthreads();
}

constexpr size_t CTL_GRP = 32 * 1024, CTL_XMASK = 36 * 1024;
__device__ __forceinline__ void group_barrier(const XcdBarrier& b, int cid) {
    asm volatile("s_waitcnt vmcnt(0)" ::: "memory");
    __syncthreads();
    if (threadIdx.x == 0) {
        unsigned* bar = b.bar; const unsigned* xm = bar + CTL_XMASK / 4; unsigned ok = (gridDim.x == 256u) ? 1u : 0u;
#pragma unroll
        for (int j = 0; j < 8; ++j) { const unsigned mk = xb_ld((unsigned*)&xm[j]); ok &= (mk != 0u && (mk & (mk - 1u)) == 0u) ? 1u : 0u; }
        b.st[4] = ok;
        if (ok) {
            unsigned* cnt = bar + CTL_GRP / 4 + (cid & 7) * 64;
            __builtin_amdgcn_s_waitcnt(0);
            const unsigned old = xb_add(cnt, 1u), target = (old / 32u + 1u) * 32u;
            XB_SPIN((int)(xb_ld(cnt) - target) < 0, bar);
            __builtin_amdgcn_fence(__ATOMIC_ACQUIRE, "agent");
            asm volatile("s_waitcnt vmcnt(0)" ::: "memory");
        }
    }
    __syncthreads();
    if (!b.st[4]) xcd_barrier(b);
}
struct WaitHook { static constexpr bool ON = true; bool on; unsigned* bar; volatile LAS unsigned* st;
    __device__ __forceinline__ void operator()() const { if (on) { XcdBarrier bw; bw.bar = bar; bw.x = xb_xcc_id(); bw.st = st; xcd_wait_arrived(bw); } } };

constexpr int NWAVES = 8, NTHREADS = 512;
constexpr int RING_BYTES = 131072, MISC_OFF = RING_BYTES, LDS_BYTES = 163840;
constexpr int LX_P = 1024, LX_SQ = 5120, LX_GAIN = 13312, LX_POS = 16384;

struct Args { const float* in[22]; float* out; unsigned char* ws; int ph_lo, ph_hi; };
enum { I_X = 0, I_RELB, I_NMIX, I_NFFN, I_POOLW, I_POOLS, I_NKV, I_WKV, I_GK, I_CPOS, I_CW1, I_CW2, I_WQG, I_GQ, I_WO, I_FWG, I_FWU, I_FWD, I_ROUTER, I_MWG, I_MWU, I_MWD };

__device__ __forceinline__ void cvt_item(const float* src, int ld, int nvalid, const float* rowgain, const float* colscale, bf16_t* dst, int K, int k0, LAS float* scr, int lane, bool f8 = false) {
    { const int q = lane & 7, r = lane >> 3;
      f32x4 v[8];
#pragma unroll
      for (int i = 0; i < 8; ++i) { const int kk = 8 * i + r; v[i] = (f32x4){0.f, 0.f, 0.f, 0.f};
          if (4 * q < nvalid) { v[i] = *(const f32x4*)(src + (size_t)(k0 + kk) * ld + 4 * q); if (rowgain) v[i] *= rowgain[k0 + kk]; } }
#pragma unroll
      for (int i = 0; i < 8; ++i) { LAS float* d = scr + (8 * i + r) * 33 + 4 * q; d[0] = v[i].x; d[1] = v[i].y; d[2] = v[i].z; d[3] = v[i].w; } }
    asm volatile("s_waitcnt lgkmcnt(0)" ::: "memory");
    const int c = lane & 7;
#pragma unroll
    for (int j = 0; j < 4; ++j) { const int n = (lane >> 3) + 8 * j; const LAS float* s = scr + (8 * c) * 33 + n;
        const float cs = (colscale && n < nvalid) ? colscale[n] : 1.f;
        u32x4 o; o.x = pk2(s[0 * 33] * cs, s[1 * 33] * cs); o.y = pk2(s[2 * 33] * cs, s[3 * 33] * cs); o.z = pk2(s[4 * 33] * cs, s[5 * 33] * cs); o.w = pk2(s[6 * 33] * cs, s[7 * 33] * cs);
        const int np = 16 * ((n >> 2) & 1) + (((n >> 3) << 2) | (n & 3)), kc = k0 + 8 * c;
        if (!f8) *(u32x4*)((char*)dst + ((size_t)((np >> 4) * (K >> 5) + (kc >> 5)) << 10) + (np & 15) * 64 + (kc & 31) * 2) = o;
        else { const float ws = cs * pg8::F8_WS;
            int lo = __builtin_amdgcn_cvt_pk_fp8_f32(s[0 * 33] * ws, s[1 * 33] * ws, 0, false); lo = __builtin_amdgcn_cvt_pk_fp8_f32(s[2 * 33] * ws, s[3 * 33] * ws, lo, true);
            int hi = __builtin_amdgcn_cvt_pk_fp8_f32(s[4 * 33] * ws, s[5 * 33] * ws, 0, false); hi = __builtin_amdgcn_cvt_pk_fp8_f32(s[6 * 33] * ws, s[7 * 33] * ws, hi, true);
            *(u32x2*)((char*)dst + ((size_t)((np >> 4) * (K >> 6) + (kc >> 6)) << 10) + (np & 15) * 64 + (kc & 63)) = (u32x2){(unsigned)lo, (unsigned)hi}; } }
    asm volatile("s_waitcnt lgkmcnt(0)" ::: "memory");
}
__device__ __forceinline__ void cvt_plain(const float* src, int K, int N, const float* rowgain, const float* colscale, bf16_t* dst, int item, LAS float* scr, int lane, bool f8 = false) {
    const int nblk = N / 32, kb = item / nblk, nb = item % nblk;
    cvt_item(src + nb * 32, N, 32, rowgain, colscale ? colscale + nb * 32 : nullptr, f8 ? (bf16_t*)((char*)dst + (size_t)nb * 32 * K) : dst + (size_t)nb * 32 * K, K, kb * 64, scr, lane, f8);
}
__device__ __forceinline__ void cvt_gu(const float* wg, const float* wu, const float* rowgain, bf16_t* dst, int item, LAS float* scr, int lane, bool f8 = false) {
    constexpr int nblk = 7168 / 32; const int kb = item / nblk, nb = item % nblk, np = nb * 32, p = np >> 8, b = (np >> 7) & 1, j0 = np & 127;
    cvt_item((b ? wu : wg) + p * 128 + j0, FFD, 32, rowgain, nullptr, f8 ? (bf16_t*)((char*)dst + (size_t)np * DM) : dst + (size_t)np * DM, DM, kb * 64, scr, lane, f8);
}
__device__ __forceinline__ void cvt_qg(const float* w, const float* rowgain, bf16_t* dst, int item, LAS float* scr, int lane) {
    constexpr int nblk = 1280 / 32; const int kb = item / nblk, nb = item % nblk, np = nb * 32;
    int nvalid = 1072 - np; nvalid = nvalid < 0 ? 0 : (nvalid > 32 ? 32 : nvalid);
    cvt_item(w + np, 1072, nvalid, rowgain, nullptr, dst + (size_t)np * DM, DM, kb * 64, scr, lane);
}
__device__ __forceinline__ void cvt_headperm(const float* w, int ld, int ncols, const float* rowgain, bf16_t* dst, int K, int nblk, int item, LAS float* scr, int lane) {
    const int kb = item / nblk, nb = item % nblk, np = nb * 32, tile = np >> 8, bj = (np >> 7) & 1, wc = (np >> 5) & 3, o = tile * 256 + 64 * wc + 32 * bj;
    int nvalid = ncols - o; nvalid = nvalid < 0 ? 0 : (nvalid > 32 ? 32 : nvalid);
    cvt_item(w + o, ld, nvalid, rowgain, nullptr, dst + (size_t)np * K, K, kb * 64, scr, lane);
}
constexpr int IT_POOL = 8 * 32, IT_GU = 16 * 224, IT_D = 56 * 32, IT_KV = 16 * 48, IT_QG = 16 * 40, IT_O = 16 * 32, IT_C1 = 32 * 8;
constexpr int IT_C2 = 4 * 8;
constexpr int IT_STATIC = IT_POOL + 2 * IT_GU + 2 * IT_D + IT_KV + 2 * IT_QG + 2 * IT_O + 2 * IT_C1 + 2 * IT_C2;
__device__ __forceinline__ void p_convert_static(const Args& a, LAS unsigned char* lds) {
    const int tz = opaque_tid(), lane = tz & 63, wave = tz >> 6;
    LAS float* scr = (LAS float*)(lds + wave * 16384);
    unsigned char* ws = a.ws;
    for (int it = blockIdx.x * NWAVES + wave; it < IT_STATIC; it += gridDim.x * NWAVES) {
        int r = it;
        if (r < IT_POOL) { const int mg = r / 32, L = mg >> 2, g = mg & 3;
            cvt_plain(a.in[I_POOLW] + (size_t)mg * 65536, 256, 256, a.in[I_NMIX] + L * DM + g * 256, a.in[I_POOLS] + L * DM + g * 256, (bf16_t*)(ws + W_POOL) + (size_t)mg * 65536, r % 32, scr, lane); continue; } r -= IT_POOL;
        if (r < 2 * IT_GU) { const int i = r / IT_GU;
            cvt_gu(a.in[I_FWG] + (size_t)i * DM * FFD, a.in[I_FWU] + (size_t)i * DM * FFD, a.in[I_NFFN] + (2 * i) * DM, (bf16_t*)(ws + W_GU) + (size_t)i * 7168 * DM, r % IT_GU, scr, lane); continue; } r -= 2 * IT_GU;
        if (r < 2 * IT_D) { const int i = r / IT_D;
            cvt_plain(a.in[I_FWD] + (size_t)i * FFD * DM, FFD, DM, nullptr, nullptr, (bf16_t*)(ws + W_D + (size_t)i * DM * FFD), r % IT_D, scr, lane, true); continue; } r -= 2 * IT_D;
        if (r < IT_KV) { cvt_headperm(a.in[I_WKV], 1536, 1536, a.in[I_NKV], (bf16_t*)(ws + W_KV), DM, 48, r, scr, lane); continue; } r -= IT_KV;
        if (r < 2 * IT_QG) { const int j = r / IT_QG;
            cvt_headperm(a.in[I_WQG] + (size_t)j * DM * 1072, 1072, 1072, a.in[I_NMIX] + (2 + j) * DM, (bf16_t*)(ws + W_QG) + (size_t)j * 1280 * DM, DM, 40, r % IT_QG, scr, lane); continue; } r -= 2 * IT_QG;
        if (r < 2 * IT_O) { const int j = r / IT_O;
            cvt_plain(a.in[I_WO] + (size_t)j * DM * DM, DM, DM, nullptr, nullptr, (bf16_t*)(ws + W_O) + (size_t)j * DM * DM, r % IT_O, scr, lane); continue; } r -= 2 * IT_O;
        if (r < 2 * IT_C1) { const int w = r / IT_C1;
            cvt_plain(a.in[I_CW1] + (size_t)w * 2048 * 256, 2048, 256, nullptr, nullptr, (bf16_t*)(ws + W_C1) + (size_t)w * 256 * 2048, r % IT_C1, scr, lane); continue; } r -= 2 * IT_C1;
        { const int w = r / IT_C2;
            cvt_headperm(a.in[I_CW2] + (size_t)w * 256 * 64, 64, 64, nullptr, (bf16_t*)(ws + W_C2) + (size_t)w * 256 * 256, 256, 8, r % IT_C2, scr, lane); }
    }
}
__device__ __forceinline__ void p_convert_moe(const Args& a, LAS unsigned char* lds, int l) {
    const int tz = opaque_tid(), lane = tz & 63, wave = tz >> 6;
    LAS float* scr = (LAS float*)(lds + wave * 16384);
    unsigned char* ws = a.ws;
    const float* gain = a.in[I_NFFN] + (2 * l + 1) * DM;
    constexpr int NIT = 8 * (IT_GU + IT_D);
    for (int it = blockIdx.x * NWAVES + wave; it < NIT; it += gridDim.x * NWAVES) {
        if (it < 8 * IT_GU) { const int e = it / IT_GU; const size_t wo = ((size_t)l * 8 + e) * DM * FFD;
            cvt_gu(a.in[I_MWG] + wo, a.in[I_MWU] + wo, gain, (bf16_t*)(ws + WS_WMOE + (size_t)e * 7168 * DM), it % IT_GU, scr, lane, true); }
        else { const int r = it - 8 * IT_GU, e = r / IT_D; const size_t wo = ((size_t)l * 8 + e) * FFD * DM;
            cvt_plain(a.in[I_MWD] + wo, FFD, DM, nullptr, nullptr, (bf16_t*)(ws + WMOE_D + (size_t)e * DM * FFD), r % IT_D, scr, lane, true); }
    }
}

__device__ __forceinline__ float row_load_rstd(const float* xrow, int lane, f32x4 (&v)[4]) {
    const f32x4* xr = (const f32x4*)xrow + lane; float s = 0.f;
#pragma unroll
    for (int j = 0; j < 4; ++j) { v[j] = xr[64 * j]; s += (v[j].x * v[j].x + v[j].y * v[j].y) + (v[j].z * v[j].z + v[j].w * v[j].w); }
    return 1.0f / sqrtf(wave_sum(s) * (1.f / DM) + EPS);
}
__device__ __forceinline__ void row_store_bf16(bf16_t* orow, int lane, const f32x4 (&v)[4], float sc) {
    unsigned long long* o8 = (unsigned long long*)orow + lane;
#pragma unroll
    for (int j = 0; j < 4; ++j) o8[64 * j] = (unsigned long long)pk2(v[j].x * sc, v[j].y * sc) | ((unsigned long long)pk2(v[j].z * sc, v[j].w * sc) << 32);
}
__device__ __forceinline__ void row_load8(const bf16_t* xrow, int lane, f32x4 (&v)[4]) {
#pragma unroll
    for (int j = 0; j < 2; ++j) ld8(xrow + 8 * lane + 512 * j, v[2 * j], v[2 * j + 1]);
}
__device__ __forceinline__ void row_store8(bf16_t* orow, int lane, const f32x4 (&v)[4], float sc) {
#pragma unroll
    for (int j = 0; j < 2; ++j) { u32x4 o; o.x = pk2(v[2 * j].x * sc, v[2 * j].y * sc); o.y = pk2(v[2 * j].z * sc, v[2 * j].w * sc); o.z = pk2(v[2 * j + 1].x * sc, v[2 * j + 1].y * sc); o.w = pk2(v[2 * j + 1].z * sc, v[2 * j + 1].w * sc);
        *(u32x4*)(orow + 8 * lane + 512 * j) = o; }
}
__device__ __forceinline__ void row_store_f8(unsigned char* orow, int lane, const f32x4 (&v)[4], float sc) {
#pragma unroll
    for (int j = 0; j < 2; ++j) { int lo = __builtin_amdgcn_cvt_pk_fp8_f32(v[2 * j].x * sc, v[2 * j].y * sc, 0, false); lo = __builtin_amdgcn_cvt_pk_fp8_f32(v[2 * j].z * sc, v[2 * j].w * sc, lo, true);
        int hi = __builtin_amdgcn_cvt_pk_fp8_f32(v[2 * j + 1].x * sc, v[2 * j + 1].y * sc, 0, false); hi = __builtin_amdgcn_cvt_pk_fp8_f32(v[2 * j + 1].z * sc, v[2 * j + 1].w * sc, hi, true);
        *(u32x2*)(orow + 8 * lane + 512 * j) = (u32x2){(unsigned)lo, (unsigned)hi}; }
}
__device__ __forceinline__ void p_norm(const float* x, bf16_t* XN) {
    const int tz = opaque_tid(), lane = tz & 63, gw = blockIdx.x * NWAVES + (tz >> 6), NGW = gridDim.x * NWAVES;
    for (int m = gw; m < NTOK; m += NGW) { f32x4 v[4]; const float r = row_load_rstd(x + (size_t)m * DM, lane, v); row_store_bf16(XN + (size_t)m * DM, lane, v, r); }
}
template <typename TX> __device__ __forceinline__ void p_pool_diff(const TX* x, const float* SSQ  , bf16_t* DIFF, LAS unsigned char* lds) {
    LAS float* rs = (LAS float*)lds;
    const int tid = opaque_tid(), lane = tid & 63, wave = tid >> 6;
    for (int tile = blockIdx.x; tile < NTOK / 128; tile += gridDim.x) {
        const int b = tile >> 4, t0 = (tile & 15) * 128; const TX* xb = x + (size_t)b * SEQ * DM;
        if (SSQ) { if (tid < 143) { const int t = t0 - 15 + tid; if (t >= 0) { const f32x4 p = *(const f32x4*)(SSQ + ((size_t)b * SEQ + t) * 4); rs[tid] = 1.0f / sqrtf(((p.x + p.y) + (p.z + p.w)) * (1.f / DM) + EPS); } } }
        else for (int i = wave; i < 143; i += NWAVES) { const int t = t0 - 15 + i; if (t >= 0) { float sq = 0.f;
#pragma unroll
                for (int j = 0; j < 4; ++j) { const f32x4 v = ld4(xb + (size_t)t * DM + 4 * lane + 256 * j); sq += (v.x * v.x + v.y * v.y) + (v.z * v.z + v.w * v.w); }
                const float r = 1.0f / sqrtf(wave_sum(sq) * (1.f / DM) + EPS); if (lane == 0) rs[i] = r; } }
        __syncthreads();
        const int q = tid >> 7, cq = tid & 127, g = cq >> 5, w = 2 << g, ts = t0 + 32 * q;
        const TX* xc = xb + 8 * cq;
        f32x4 sa = (f32x4){0.f, 0.f, 0.f, 0.f}, sb = sa;
        { f32x4 wa[15], wb[15];
#pragma unroll
          for (int i = 1; i < 16; ++i) { const int ii = i < w ? i : w - 1; int t = ts - ii; t = t < 0 ? 0 : t; ld8(xc + (size_t)t * DM, wa[i - 1], wb[i - 1]); }
#pragma unroll
          for (int i = 1; i < 16; ++i) { const int t = ts - i; const float r = (i < w && t >= 0) ? rs[t - t0 + 15] : 0.f; sa += wa[i - 1] * r; sb += wb[i - 1] * r; } }
        for (int tt0 = 0; tt0 < 32; tt0 += 4) {
            f32x4 na[4], nb[4], oa[4], ob[4];
#pragma unroll
            for (int j = 0; j < 4; ++j) { const int t = ts + tt0 + j; ld8(xc + (size_t)t * DM, na[j], nb[j]); int told = t + 1 - w; told = told < 0 ? 0 : told; ld8(xc + (size_t)told * DM, oa[j], ob[j]); }
#pragma unroll
            for (int j = 0; j < 4; ++j) { const int t = ts + tt0 + j;
                f32x4 ha = na[j], hb = nb[j]; { const float r = rs[t - t0 + 15]; ha *= r; hb *= r; }
                sa += ha; sb += hb;
                const int cnt = (t + 1 < w) ? (t + 1) : w; const float ic = __builtin_amdgcn_rcpf((float)cnt);
                const f32x4 da = sa * ic - ha, db = sb * ic - hb;
                u32x4 o; o.x = pk2(da.x, da.y); o.y = pk2(da.z, da.w); o.z = pk2(db.x, db.y); o.w = pk2(db.z, db.w);
                *(u32x4*)(DIFF + ((size_t)b * SEQ + t) * DM + 8 * cq) = o;
                const int told = t + 1 - w; const float ro = (told >= 0) ? rs[told - t0 + 15] : 0.f; sa -= oa[j] * ro; sb -= ob[j] * ro; } }
        __syncthreads();
    }
}
__device__ __forceinline__ void p_router_a(const Args& a, const bf16_t* x, int l, LAS unsigned char* lds) {
    LAS float* grT = (LAS float*)lds;
    LAS int* cnt = (LAS int*)(lds + 32768);
    const int tid = opaque_tid(), lane = tid & 63, wave = tid >> 6;
    const float* gain = a.in[I_NFFN] + (2 * l + 1) * DM; const float* router = a.in[I_ROUTER] + (size_t)l * DM * NEXP;
    for (int i = tid; i < DM * NEXP; i += NTHREADS) { const int k = i >> 3, e = i & 7; grT[e * DM + k] = gain[k] * router[i]; }
    int* RE = (int*)(a.ws + MS_RE); f32x2* RG = (f32x2*)(a.ws + MS_RG); float* RSTD = (float*)(a.ws + MS_RSTD); int* CNT = (int*)(a.ws + CTL_CNT);
    for (int tb = blockIdx.x; tb < NTOK / 256; tb += gridDim.x) {
        if (tid < 8) cnt[tid] = 0;
        __syncthreads();
        for (int i0 = wave * 4; i0 < 256; i0 += NWAVES * 4) {
            f32x4 v4[4][4];
#pragma unroll
            for (int q = 0; q < 4; ++q) row_load8(x + (size_t)(tb * 256 + i0 + q) * DM, lane, v4[q]);
#pragma unroll
            for (int q = 0; q < 4; ++q) { const int tok = tb * 256 + i0 + q;
                float ssq = 0.f;
#pragma unroll
                for (int j = 0; j < 4; ++j) ssq += (v4[q][j].x * v4[q][j].x + v4[q][j].y * v4[q][j].y) + (v4[q][j].z * v4[q][j].z + v4[q][j].w * v4[q][j].w);
                const float r = 1.0f / sqrtf(wave_sum(ssq) * (1.f / DM) + EPS);
                float lg[8];
#pragma unroll
                for (int e = 0; e < 8; ++e) { float sd = 0.f;
#pragma unroll
                    for (int j = 0; j < 4; ++j) { const f32x4 w = *(const LAS f32x4*)(grT + e * DM + 512 * (j >> 1) + 8 * lane + 4 * (j & 1)); sd += (v4[q][j].x * w.x + v4[q][j].y * w.y) + (v4[q][j].z * w.z + v4[q][j].w * w.w); }
                    lg[e] = wave_sum(sd) * r; }
                int e0 = 0; float l0 = lg[0];
#pragma unroll
                for (int e = 1; e < 8; ++e) if (lg[e] > l0) { l0 = lg[e]; e0 = e; }
                int e1 = -1; float l1 = 0.f;
#pragma unroll
                for (int e = 0; e < 8; ++e) if (e != e0 && (e1 < 0 || lg[e] > l1)) { l1 = lg[e]; e1 = e; }
                if (lane == 0) { const float g1 = 1.f / (1.f + expf(l0 - l1)), g0 = 1.f - g1;
                    RE[tok] = e0 | (e1 << 8); RG[tok] = (f32x2){g0, g1}; RSTD[tok] = r; __hip_atomic_fetch_add(&cnt[e0], 1, __ATOMIC_RELAXED, __HIP_MEMORY_SCOPE_WORKGROUP); __hip_atomic_fetch_add(&cnt[e1], 1, __ATOMIC_RELAXED, __HIP_MEMORY_SCOPE_WORKGROUP); } } }
        __syncthreads();
        if (tid < 8) CNT[tb * 8 + tid] = cnt[tid];
        __syncthreads();
    }
}
__device__ __forceinline__ void p_router_b(const Args& a, const bf16_t* x, LAS unsigned char* lds) {
    LAS int* cn = (LAS int*)lds;
    LAS int* tot = cn + 2048; LAS int* bef = tot + 8; LAS int* seg = bef + 8; LAS int* wtot = seg + 16;
    LAS int* slot = wtot + 32;
    const int tid = opaque_tid(), lane = tid & 63, wave = tid >> 6;
    const int* RE = (const int*)(a.ws + MS_RE); const float* RSTD = (const float*)(a.ws + MS_RSTD); const int* CNT = (const int*)(a.ws + CTL_CNT);
    int* SLOT = (int*)(a.ws + MS_SLOT); int* TILE_E = (int*)(a.ws + CTL_TILEE); int* NT = (int*)(a.ws + CTL_NT);
    unsigned char* XS8 = a.ws + WS_A + 128 * MiB;
    for (int tb = blockIdx.x; tb < NTOK / 256; tb += gridDim.x) {
        { const int4 c4 = *(const int4*)(CNT + tid * 4); cn[tid * 4] = c4.x; cn[tid * 4 + 1] = c4.y; cn[tid * 4 + 2] = c4.z; cn[tid * 4 + 3] = c4.w; }
        __syncthreads();
        if (tid < 8) { int t = 0, bf = 0; for (int b = 0; b < 256; ++b) { const int c = cn[b * 8 + tid]; t += c; if (b < tb) bf += c; } tot[tid] = t; bef[tid] = bf; }
        __syncthreads();
        if (tid == 0) { int s = 0; for (int e = 0; e < 8; ++e) { seg[e] = s; s += ((tot[e] + 255) >> 8) << 8; } seg[8] = s; if (tb == 0) *NT = s >> 8; }
        int e0 = 0, e1 = 0, r0 = 0, r1 = 0;
        if (tid < 256) { const int re = RE[tb * 256 + tid]; e0 = re & 255; e1 = re >> 8;
#pragma unroll
            for (int e = 0; e < 8; ++e) { const bool f = (e0 == e) || (e1 == e); const unsigned long long mk = __ballot(f);
                const int r = __popcll(mk & ((1ull << lane) - 1ull)); if (lane == 0) wtot[wave * 8 + e] = __popcll(mk); if (e == e0) r0 = r; if (e == e1) r1 = r; } }
        __syncthreads();
        if (tb == 0) { const int ntl = seg[8] >> 8;
            for (int t = tid; t < ntl; t += NTHREADS) { int e = 0;
#pragma unroll
                for (int q = 1; q < 8; ++q) e = (seg[q] <= (t << 8)) ? q : e;
                TILE_E[t] = e; } }
        if (tid < 256) { int o0 = 0, o1 = 0; for (int w = 0; w < wave; ++w) { o0 += wtot[w * 8 + e0]; o1 += wtot[w * 8 + e1]; }
            const int p0 = seg[e0] + bef[e0] + o0 + r0, p1 = seg[e1] + bef[e1] + o1 + r1;
            slot[tid * 2] = p0; slot[tid * 2 + 1] = p1; *(int2*)(SLOT + (size_t)(tb * 256 + tid) * 2) = make_int2(p0, p1); }
        __syncthreads();
        for (int i0 = wave * 4; i0 < 256; i0 += NWAVES * 4) {
            f32x4 v4[4][4]; float r4[4];
#pragma unroll
            for (int q = 0; q < 4; ++q) { const int tok = tb * 256 + i0 + q; r4[q] = RSTD[tok]; row_load8(x + (size_t)tok * DM, lane, v4[q]); }
#pragma unroll
            for (int q = 0; q < 4; ++q) { row_store_f8(XS8 + (size_t)slot[(i0 + q) * 2] * DM, lane, v4[q], r4[q] * pg8::F8_XS); row_store_f8(XS8 + (size_t)slot[(i0 + q) * 2 + 1] * DM, lane, v4[q], r4[q] * pg8::F8_XS); } }
        __syncthreads();
    }
}
template <bool FINAL> __device__ __forceinline__ void p_moe_combine(const Args& a, bf16_t* XB, float* SSQ, float* out) {
    const int tz = opaque_tid(), lane = tz & 63, gw = blockIdx.x * NWAVES + (tz >> 6), NGW = gridDim.x * NWAVES;
    const f32x2* RG = (const f32x2*)(a.ws + MS_RG); const int* SLOT = (const int*)(a.ws + MS_SLOT); const bf16_t* YS = (const bf16_t*)(a.ws + WS_A);
    const bf16_t* YSP = (const bf16_t*)(a.ws + WS_QGRAW);
    constexpr int XROW0 = 1 << 30;
    for (int m0 = gw * 2; m0 < NTOK; m0 += NGW * 2) {
        f32x2 g2[2]; int2 sl2[2];
#pragma unroll
        for (int q = 0; q < 2; ++q) { g2[q] = RG[m0 + q]; sl2[q] = *(const int2*)(SLOT + (size_t)(m0 + q) * 2); }
        u32x4 xv[2][2], ya[2][2], yb[2][2];
#pragma unroll
        for (int q = 0; q < 2; ++q) { const u32x4* xr = (const u32x4*)(XB + (size_t)(m0 + q) * DM) + lane;
            const u32x4* y0 = (const u32x4*)(YS + (size_t)(sl2[q].x < XROW0 ? sl2[q].x : 0) * DM) + lane; const u32x4* y1 = (const u32x4*)(YS + (size_t)(sl2[q].y < XROW0 ? sl2[q].y : 0) * DM) + lane;
#pragma unroll
            for (int j = 0; j < 2; ++j) { xv[q][j] = xr[64 * j]; ya[q][j] = y0[64 * j]; yb[q][j] = y1[64 * j]; } }
#pragma unroll
        for (int q = 0; q < 2; ++q) { const int m = m0 + q; const f32x2 g = g2[q];
            u32x4* xb = (u32x4*)(XB + (size_t)m * DM) + lane; f32x4* orow = (f32x4*)(out + (size_t)m * DM) + 2 * lane; float ss = 0.f;
            const int s0 = __builtin_amdgcn_readfirstlane(sl2[q].x), s1 = __builtin_amdgcn_readfirstlane(sl2[q].y);
#pragma unroll
            for (int j = 0; j < 2; ++j) { const u32x4 x0 = xv[q][j];
                f32x4 a0l, a0h, a1l, a1h;
                { const u32x4 w = ya[q][j]; a0l = (f32x4){bflo(w.x), bfhi(w.x), bflo(w.y), bfhi(w.y)}; a0h = (f32x4){bflo(w.z), bfhi(w.z), bflo(w.w), bfhi(w.w)}; }
                { const u32x4 w = yb[q][j]; a1l = (f32x4){bflo(w.x), bfhi(w.x), bflo(w.y), bfhi(w.y)}; a1h = (f32x4){bflo(w.z), bfhi(w.z), bflo(w.w), bfhi(w.w)}; }
                if (s0 >= XROW0) { a0l = (f32x4){0.f, 0.f, 0.f, 0.f}; a0h = a0l;
                    for (int ks = 0; ks < pg8::XSPLIT; ++ks) { f32x4 pl, ph; ld8(YSP + ((size_t)ks * pg8::XROWS + (s0 - XROW0)) * DM + 8 * lane + 512 * j, pl, ph); a0l += pl; a0h += ph; } }
                if (s1 >= XROW0) { a1l = (f32x4){0.f, 0.f, 0.f, 0.f}; a1h = a1l;
                    for (int ks = 0; ks < pg8::XSPLIT; ++ks) { f32x4 pl, ph; ld8(YSP + ((size_t)ks * pg8::XROWS + (s1 - XROW0)) * DM + 8 * lane + 512 * j, pl, ph); a1l += pl; a1h += ph; } }
                const f32x4 xl = (f32x4){bflo(x0.x), bfhi(x0.x), bflo(x0.y), bfhi(x0.y)}, xh = (f32x4){bflo(x0.z), bfhi(x0.z), bflo(x0.w), bfhi(x0.w)};
                const f32x4 v = xl + g.x * a0l + g.y * a1l, u = xh + g.x * a0h + g.y * a1h;
                if (FINAL) { orow[128 * j] = v; orow[128 * j + 1] = u; }
                else { u32x4 w; w.x = pk2(v.x, v.y); w.y = pk2(v.z, v.w); w.z = pk2(u.x, u.y); w.w = pk2(u.z, u.w); xb[64 * j] = w;
                    ss += ((v.x * v.x + v.y * v.y) + (v.z * v.z + v.w * v.w)) + ((u.x * u.x + u.y * u.y) + (u.z * u.z + u.w * u.w)); } }
            if (!FINAL) { ss = wave_sum(ss); if (lane == 0) *(f32x4*)(SSQ + (size_t)m * 4) = (f32x4){ss, 0.f, 0.f, 0.f}; } } }
}

__device__ __forceinline__ void headnorm_inplace(bf16_t* buf, int ld, int col0, int nheads, const float* gain, float scale) {
    const int tz = opaque_tid(), gl = (blockIdx.x * NTHREADS + tz) >> 3, NG = (gridDim.x * NTHREADS) >> 3, sub = tz & 7;
    f32x4 ga = *(const f32x4*)(gain + sub * 8), gb = *(const f32x4*)(gain + sub * 8 + 4);
    const long total = (long)NTOK * nheads;
    for (long it = gl; it < total; it += NG) { const int tok = (int)(it / nheads), h = (int)(it % nheads);
        u32x4* p = (u32x4*)(buf + (size_t)tok * ld + col0 + h * 64 + sub * 8); const u32x4 w = *p;
        float v[8] = {bflo(w.x), bfhi(w.x), bflo(w.y), bfhi(w.y), bflo(w.z), bfhi(w.z), bflo(w.w), bfhi(w.w)};
        float s = 0.f;
#pragma unroll
        for (int j = 0; j < 8; ++j) s += v[j] * v[j];
        s += __shfl_xor(s, 1); s += __shfl_xor(s, 2); s += __shfl_xor(s, 4);
        const float r = scale / sqrtf(s * (1.f / 64.f) + EPS);
        u32x4 o; o.x = pk2(v[0] * r * ga.x, v[1] * r * ga.y); o.y = pk2(v[2] * r * ga.z, v[3] * r * ga.w); o.z = pk2(v[4] * r * gb.x, v[5] * r * gb.y); o.w = pk2(v[6] * r * gb.z, v[7] * r * gb.w);
        *p = o; }
}
__device__ __forceinline__ void p_cmp_gather(const Args& a) {
    const bf16_t* KV = (const bf16_t*)(a.ws + WS_KVRAW); bf16_t* BLK = (bf16_t*)(a.ws + WS_BLK); const float* pos = a.in[I_CPOS];
    const long total = (long)2 * 16256 * 256;
    const int tz = opaque_tid();
    for (long it = (long)blockIdx.x * NTHREADS + tz; it < total; it += (long)gridDim.x * NTHREADS) {
        const int piece = (int)(it & 255), row = (int)((it >> 8) % 16256), w = (int)((it >> 8) / 16256);
        const int l = piece >> 3, d0 = (piece & 7) * 8, g = row & 3, bc = row >> 2, b = bc / NCMP, c = bc % NCMP;
        const u32x4 kv = *(const u32x4*)(KV + ((size_t)b * SEQ + 16 * c + l) * 1536 + w * 256 + g * 64 + d0);
        const f32x4 pa = *(const f32x4*)(pos + (w * 32 + l) * 64 + d0), pb = *(const f32x4*)(pos + (w * 32 + l) * 64 + d0 + 4);
        u32x4 o; o.x = pk2(bflo(kv.x) + pa.x, bfhi(kv.x) + pa.y); o.y = pk2(bflo(kv.y) + pa.z, bfhi(kv.y) + pa.w); o.z = pk2(bflo(kv.z) + pb.x, bfhi(kv.z) + pb.y); o.w = pk2(bflo(kv.w) + pb.z, bfhi(kv.w) + pb.w);
        *(u32x4*)(BLK + ((size_t)w * 16384 + row) * 2048 + l * 64 + d0) = o; }
}
__device__ __forceinline__ int vt_pos(int k) { return (k & ~12) | ((k & 4) << 1) | ((k & 8) >> 1); }
__device__ __forceinline__ void p_cmp_finish(const Args& a) {
    const float* CMP = (const float*)(a.ws + MS_CMPRAW); const float* gk0 = a.in[I_GK];
    bf16_t* KCF = (bf16_t*)(a.ws + WS_KCF); bf16_t* VCF = (bf16_t*)(a.ws + WS_VCF);
    const int tz = opaque_tid(), lane = tz & 63, gw = blockIdx.x * NWAVES + (tz >> 6), NGW = gridDim.x * NWAVES;
    for (int it = gw; it < 2 * 16384; it += NGW) { const int w = it >> 14, idx = it & 16383, g = idx & 3, bc = idx >> 2, b = bc >> 7, c = bc & 127;
        float s = 0.f;
        if (c < NCMP) { s = CMP[((size_t)w * 16384 + (size_t)(b * NCMP + c) * 4 + g) * 64 + lane];
            if (w == 0) { const float ss = wave_sum(s * s); s = s * (1.0f / sqrtf(ss * (1.f / 64.f) + EPS)) * gk0[lane]; } }
        const int d = lane, t2 = c >> 6, kk = c & 63;
        if (w == 0) KCF[(((size_t)(b * 4 + g) * 2 + t2) * 8 + (kk >> 5) * 4 + (d >> 4)) * 512 + (((d >> 3) & 1) * 32 + (kk & 31)) * 8 + (d & 7)] = (bf16_t)f2bf(s);
        else { const int ps = vt_pos(kk); VCF[(((size_t)(b * 4 + g) * 2 + t2) * 8 + ((ps >> 4) * 2 + (d >> 5))) * 512 + (((ps >> 3) & 1) * 32 + (d & 31)) * 8 + (ps & 7)] = (bf16_t)f2bf(s); } }
}
__device__ __forceinline__ void p_kv_frag(const Args& a) {
    const bf16_t* KV = (const bf16_t*)(a.ws + WS_KVRAW); bf16_t* KF = (bf16_t*)(a.ws + WS_KF); bf16_t* VF = (bf16_t*)(a.ws + WS_VF);
    const int tz = opaque_tid();
    const long total = (long)2 * NBATCH * 4 * 8 * SEQ;
    const int sub = tz & 7;
    for (long it = (long)blockIdx.x * NTHREADS + tz; it < total; it += (long)gridDim.x * NTHREADS) {
        { const int t = (int)((it >> 3) & 2047), g = (int)((it >> 14) & 3), b = (int)((it >> 16) & 31), w = (int)(it >> 21);
          const float* gain = a.in[I_GK] + 64 * (1 + w);
          const u32x4 wv = *(const u32x4*)(KV + ((size_t)b * SEQ + t) * 1536 + 512 + w * 512 + g * 64 + sub * 8);
          float v[8] = {bflo(wv.x), bfhi(wv.x), bflo(wv.y), bfhi(wv.y), bflo(wv.z), bfhi(wv.z), bflo(wv.w), bfhi(wv.w)};
          float ss = 0.f;
#pragma unroll
          for (int j = 0; j < 8; ++j) ss += v[j] * v[j];
          ss += __shfl_xor(ss, 1); ss += __shfl_xor(ss, 2); ss += __shfl_xor(ss, 4);
          const float r = 1.0f / sqrtf(ss * (1.f / 64.f) + EPS);
          const f32x4 ga = *(const f32x4*)(gain + sub * 8), gb = *(const f32x4*)(gain + sub * 8 + 4);
          u32x4 o; o.x = pk2(v[0] * r * ga.x, v[1] * r * ga.y); o.y = pk2(v[2] * r * ga.z, v[3] * r * ga.w); o.z = pk2(v[4] * r * gb.x, v[5] * r * gb.y); o.w = pk2(v[6] * r * gb.z, v[7] * r * gb.w);
          const int kk = t & 63;
          *(u32x4*)(KF + ((((size_t)w * 128 + b * 4 + g) * 32 + (t >> 6)) * 8 + (kk >> 5) * 4 + (sub >> 1)) * 512 + ((sub & 1) * 32 + (kk & 31)) * 8) = o; }
        { const int t = (int)(it & 2047), piece = (int)((it >> 11) & 7), g = (int)((it >> 14) & 3), b = (int)((it >> 16) & 31), w = (int)(it >> 21);
          const u32x4 v = *(const u32x4*)(KV + ((size_t)b * SEQ + t) * 1536 + 768 + w * 512 + g * 64 + piece * 8);
          const int ps = vt_pos(t & 63), d0 = piece * 8;
          bf16_t* dst = VF + ((((size_t)w * 128 + b * 4 + g) * 32 + (t >> 6)) * 8 + ((ps >> 4) * 2 + (d0 >> 5))) * 512 + (((ps >> 3) & 1) * 32 + (d0 & 31)) * 8 + (ps & 7);
          dst[0] = (bf16_t)(v.x & 0xffff); dst[8] = (bf16_t)(v.x >> 16); dst[16] = (bf16_t)(v.y & 0xffff); dst[24] = (bf16_t)(v.y >> 16);
          dst[32] = (bf16_t)(v.z & 0xffff); dst[40] = (bf16_t)(v.z >> 16); dst[48] = (bf16_t)(v.w & 0xffff); dst[56] = (bf16_t)(v.w >> 16); } }
}

__device__ __forceinline__ int rel_bucket(int n) {
    if (n < 16) return n;
    int lg = 16 + (int)(logf((float)n * (1.f / 16.f)) / logf(8.f) * 16.f);
    return lg < 31 ? lg : 31;
}
typedef float f32x16 __attribute__((ext_vector_type(16)));
#define MFMA32(a, b, c) __builtin_amdgcn_mfma_f32_32x32x16_bf16((a), (b), (c), 0, 0, 0)
__device__ __forceinline__ float xhalf(float v, int h) { (void)h; return __shfl_xor(v, 32); }
__device__ __forceinline__ float dpp_xor1(float v) { return __shfl_xor(v, 1); }
__device__ __forceinline__ float dpp_xor2(float v) { return __shfl_xor(v, 2); }
__device__ __forceinline__ void pv_tile(const bf16_t* VTp, const f32x16& p0, const f32x16& p1, f32x16 (&O)[2], int lane) {
#pragma unroll
    for (int bb = 0; bb < 2; ++bb)
#pragma unroll
        for (int s2 = 0; s2 < 2; ++s2) {
            u32x4 w;
            if (bb == 0) { w.x = cvt_pk_bf16(p0[8 * s2 + 0], p0[8 * s2 + 1]); w.y = cvt_pk_bf16(p0[8 * s2 + 2], p0[8 * s2 + 3]); w.z = cvt_pk_bf16(p0[8 * s2 + 4], p0[8 * s2 + 5]); w.w = cvt_pk_bf16(p0[8 * s2 + 6], p0[8 * s2 + 7]); }
            else         { w.x = cvt_pk_bf16(p1[8 * s2 + 0], p1[8 * s2 + 1]); w.y = cvt_pk_bf16(p1[8 * s2 + 2], p1[8 * s2 + 3]); w.z = cvt_pk_bf16(p1[8 * s2 + 4], p1[8 * s2 + 5]); w.w = cvt_pk_bf16(p1[8 * s2 + 6], p1[8 * s2 + 7]); }
            const bf16x8 Pf = __builtin_bit_cast(bf16x8, w);
#pragma unroll
            for (int db = 0; db < 2; ++db) {
                const bf16x8 vf = *(const bf16x8*)(VTp + (size_t)((((bb * 2 + s2) * 2 + db) * 64 + lane) * 8));
                O[db] = MFMA32(vf, Pf, O[db]); } }
}
constexpr float MINIT = -1e20f;
constexpr float DEFER_THR = 11.5f;
constexpr int BT_C = 384, BT_N = 512;
__device__ __forceinline__ void online_tile(f32x16& s0, f32x16& s1, const LAS float* bl  , float& m, float& l, f32x16 (&O)[2]) {
    float mx = m;
    { float b0[16];
#pragma unroll
      for (int r = 0; r < 16; ++r) b0[r] = bl[(r & 3) + 8 * (r >> 2)];
#pragma unroll
      for (int r = 0; r < 16; ++r) { const float v = s0[r] + b0[r]; s0[r] = v; mx = fmaxf(mx, v); } }
    { float b1[16];
#pragma unroll
      for (int r = 0; r < 16; ++r) b1[r] = bl[32 + (r & 3) + 8 * (r >> 2)];
#pragma unroll
      for (int r = 0; r < 16; ++r) { const float v = s1[r] + b1[r]; s1[r] = v; mx = fmaxf(mx, v); } }
    mx = fmaxf(mx, __shfl_xor(mx, 32));
    if (!__all(mx - m <= DEFER_THR)) { const float al = __builtin_amdgcn_exp2f(m - mx); m = mx; l *= al; O[0] *= al; O[1] *= al; }
}
__device__ __forceinline__ void online_tile_wedge(f32x16& s0, f32x16& s1, int tedge  , float cb, float& m, float& l, f32x16 (&O)[2]) {
    float mx = m;
#pragma unroll
    for (int r = 0; r < 16; ++r) { const float v = ((r & 3) + 8 * (r >> 2) >= tedge) ? s0[r] + cb : NEGF; s0[r] = v; mx = fmaxf(mx, v); }
#pragma unroll
    for (int r = 0; r < 16; ++r) { const float v = (32 + (r & 3) + 8 * (r >> 2) >= tedge) ? s1[r] + cb : NEGF; s1[r] = v; mx = fmaxf(mx, v); }
    mx = fmaxf(mx, __shfl_xor(mx, 32));
    if (!__all(mx - m <= DEFER_THR)) { const float al = __builtin_amdgcn_exp2f(m - mx); m = mx; l *= al; O[0] *= al; O[1] *= al; }
}
__device__ __forceinline__ void online_tile_far(f32x16& s0, f32x16& s1, float cb, float& m, float& l, f32x16 (&O)[2]) {
    float mx = m;
#pragma unroll
    for (int r = 0; r < 16; ++r) { s0[r] += cb; mx = fmaxf(mx, s0[r]); }
#pragma unroll
    for (int r = 0; r < 16; ++r) { s1[r] += cb; mx = fmaxf(mx, s1[r]); }
    mx = fmaxf(mx, __shfl_xor(mx, 32));
    if (!__all(mx - m <= DEFER_THR)) { const float al = __builtin_amdgcn_exp2f(m - mx); m = mx; l *= al; O[0] *= al; O[1] *= al; }
}
template <int MODE> __device__ __forceinline__ void p_attn(const Args& a, LAS unsigned char* lds) {
    LAS float* biasd = (LAS float*)lds;
    const float* relb = a.in[I_RELB];
    if (opaque_tid() >= 256) __builtin_amdgcn_s_setprio(1);
    for (int i = opaque_tid(); i < 16 * BT_N; i += NTHREADS) { const int head = i / BT_N, dist = BT_C - (i % BT_N); biasd[i] = dist < 0 ? NEGF : relb[rel_bucket(dist < 128 ? dist : 128) * 16 + head] * 1.44269504f; }
    __syncthreads();
    const bf16_t* QG = (const bf16_t*)(a.ws + WS_QGRAW);
    const bf16_t* KF = (const bf16_t*)(a.ws + WS_KF); const bf16_t* VF = (const bf16_t*)(a.ws + WS_VF);
    const bf16_t* KCF = (const bf16_t*)(a.ws + WS_KCF); const bf16_t* VCF = (const bf16_t*)(a.ws + WS_VCF);
    bf16_t* OUT = (bf16_t*)(a.ws + (MODE == 0 ? WS_H : WS_BLK));
    for (int unit = blockIdx.x; unit < NBATCH * 32 * 4; unit += gridDim.x) {
        const int tid = opaque_tid(), lane = tid & 63, wave = tid >> 6, c = lane & 31, h = lane >> 5;
        const int k = unit >> 8, idx = unit & 255, xg = idx & 7;
        const int b = 2 * k + (xg >> 2), g = xg & 3, qx = ((idx >> 3) + 4 * (k >> 1)) & 31, qt = (k & 1) ? 31 - qx : qx;
        const int ql = 8 * wave + (c >> 2), r = c & 3, head = 4 * g + r; int tq = qt * 64 + ql; asm volatile("" : "+v"(tq));
        const size_t tok = (size_t)b * SEQ + tq;
        const LAS float* bd = biasd + head * BT_N + BT_C;
        bf16x8 Qf[4];
        LAS bf16x8* qlds = (LAS bf16x8*)(lds + 32768) + wave * 256 + lane;
#pragma unroll
        for (int s = 0; s < 4; ++s) { Qf[s] = *(const bf16x8*)(QG + tok * 1280 + head * 64 + 16 * s + 8 * h); qlds[64 * s] = Qf[s]; }
        const bf16_t* gp = QG + tok * 1280 + 1024 + head * 3;
        const float gt0 = __builtin_amdgcn_rcpf(1.f + __expf(-bf2f(gp[0]))), gt1 = __builtin_amdgcn_rcpf(1.f + __expf(-bf2f(gp[1]))), gt2 = __builtin_amdgcn_rcpf(1.f + __expf(-bf2f(gp[2])));
        f32x16 OT[2];
        int jsel = -1;
        bf16x8 Kn[8];
        {
            const bf16_t* KC = KCF + (size_t)(b * 4 + g) * 2 * 4096; const bf16_t* VC = VCF + (size_t)(b * 4 + g) * 2 * 4096;
            f32x16 sc[4];
#pragma unroll
            for (int i = 0; i < 4; ++i) sc[i] = (f32x16){0.f, 0.f, 0.f, 0.f, 0.f, 0.f, 0.f, 0.f, 0.f, 0.f, 0.f, 0.f, 0.f, 0.f, 0.f, 0.f};
            { bf16x8 kf[16];
#pragma unroll
              for (int t2 = 0; t2 < 2; ++t2)
#pragma unroll
                for (int s2 = 0; s2 < 4; ++s2) { kf[t2 * 8 + 2 * s2] = *(const bf16x8*)(KC + t2 * 4096 + (s2 * 64 + lane) * 8); kf[t2 * 8 + 2 * s2 + 1] = *(const bf16x8*)(KC + t2 * 4096 + ((4 + s2) * 64 + lane) * 8); }
              __builtin_amdgcn_sched_barrier(0);
#pragma unroll
              for (int t2 = 0; t2 < 2; ++t2)
#pragma unroll
                for (int s2 = 0; s2 < 4; ++s2) { sc[2 * t2] = MFMA32(kf[t2 * 8 + 2 * s2], Qf[s2], sc[2 * t2]); sc[2 * t2 + 1] = MFMA32(kf[t2 * 8 + 2 * s2 + 1], Qf[s2], sc[2 * t2 + 1]); } }
            bf16x8 vcf[8];
#pragma unroll
            for (int i = 0; i < 8; ++i) vcf[i] = *(const bf16x8*)(VC + (i * 64 + lane) * 8);
            __builtin_amdgcn_sched_barrier(0);
            float mx = NEGF;
            const int tq0 = qt * 64 + 8 * __builtin_amdgcn_readfirstlane(wave); const float cbf = bd[-128];
#pragma unroll
            for (int kb = 0; kb < 4; ++kb) {
                if ((tq0 - 31 - 64) - 16 * (32 * kb + 27) >= 128) {
#pragma unroll
                    for (int rr = 0; rr < 16; ++rr) { const float v = sc[kb][rr] + cbf; sc[kb][rr] = v; mx = fmaxf(mx, v); }
                } else if ((tq0 + 7 - 31) - 16 * (32 * kb) < 0) {
#pragma unroll
                    for (int rr = 0; rr < 16; ++rr) sc[kb][rr] = NEGF;
                } else {
                    float bb[16];
#pragma unroll
                    for (int rr = 0; rr < 16; ++rr) { const int dc = (tq - 31 - 64 * h) - 16 * (32 * kb + (rr & 3) + 8 * (rr >> 2)); bb[rr] = bd[-min(max(dc, 0), 128)]; }
#pragma unroll
                    for (int rr = 0; rr < 16; ++rr) { const int dc = (tq - 31 - 64 * h) - 16 * (32 * kb + (rr & 3) + 8 * (rr >> 2));
                        const float v = (dc >= 0) ? sc[kb][rr] + bb[rr] : NEGF; sc[kb][rr] = v; mx = fmaxf(mx, v); } } }
            mx = fmaxf(fmaxf(mx, __shfl_xor(mx, 32)), MINIT);
            float ps = 0.f;
#pragma unroll
            for (int kb = 0; kb < 4; ++kb)
#pragma unroll
                for (int rr = 0; rr < 16; ++rr) { const float p = __builtin_amdgcn_exp2f(sc[kb][rr] - mx); sc[kb][rr] = p; ps += p; }
            ps += __shfl_xor(ps, 32);
            const float inv = __builtin_amdgcn_rcpf(fmaxf(ps, TINYF));
#pragma unroll
            for (int kb = 0; kb < 4; ++kb) sc[kb] *= inv;
            OT[0] = (f32x16){0.f, 0.f, 0.f, 0.f, 0.f, 0.f, 0.f, 0.f, 0.f, 0.f, 0.f, 0.f, 0.f, 0.f, 0.f, 0.f}; OT[1] = OT[0];
#define CMP_PV(t2) do { _Pragma("unroll") for (int bb = 0; bb < 2; ++bb) _Pragma("unroll") for (int s2 = 0; s2 < 2; ++s2) { const f32x16& p = sc[2 * (t2) + bb]; \
                u32x4 w; w.x = cvt_pk_bf16(p[8 * s2 + 0], p[8 * s2 + 1]); w.y = cvt_pk_bf16(p[8 * s2 + 2], p[8 * s2 + 3]); w.z = cvt_pk_bf16(p[8 * s2 + 4], p[8 * s2 + 5]); w.w = cvt_pk_bf16(p[8 * s2 + 6], p[8 * s2 + 7]); \
                const bf16x8 Pf = __builtin_bit_cast(bf16x8, w); \
                _Pragma("unroll") for (int db = 0; db < 2; ++db) OT[db] = MFMA32(vcf[(bb * 2 + s2) * 2 + db], Pf, OT[db]); } } while (0)
            CMP_PV(0);
            { const bf16_t* Kp = KF + (size_t)(b * 4 + g) * 32 * 4096;
#pragma unroll
              for (int s2 = 0; s2 < 4; ++s2) { Kn[2 * s2] = *(const bf16x8*)(Kp + (s2 * 64 + lane) * 8); Kn[2 * s2 + 1] = *(const bf16x8*)(Kp + ((4 + s2) * 64 + lane) * 8); } }
#pragma unroll
            for (int i = 0; i < 8; ++i) vcf[i] = *(const bf16x8*)(VC + 4096 + (i * 64 + lane) * 8);
            __builtin_amdgcn_sched_barrier(0);
            float best = -1.f; int bj = -1; const int jmax = qt - 2;
            float prev_recv = 0.f;
#pragma unroll
            for (int v = 0; v < 16; ++v) if (2 * v <= jmax) { const int kb = v >> 2, aa = v & 3;
                const float p3 = sc[kb][4 * aa + 3];
                const float av = (sc[kb][4 * aa] + sc[kb][4 * aa + 1]) + (sc[kb][4 * aa + 2] + 0.5f * p3);
                const float recv = xhalf(0.5f * p3, h);
                float iv = av + (h ? recv : prev_recv);
                prev_recv = recv;
                iv += dpp_xor1(iv); iv += dpp_xor2(iv);
                const int jj = 2 * v + h;
                if (jj >= 1 && jj <= jmax && iv > best) { best = iv; bj = jj; } }
            { const float ob = xhalf(best, h); const int oj = __builtin_bit_cast(int, xhalf(__builtin_bit_cast(float, bj), h));
              if (oj >= 0 && (bj < 0 || ob > best || (ob == best && oj < bj))) { best = ob; bj = oj; } }
            jsel = bj;
            CMP_PV(1);
#undef CMP_PV
            LAS f32x4* otl0 = (LAS f32x4*)(lds + 65536) + wave * 512 + lane;
#pragma unroll
            for (int db = 0; db < 2; ++db)
#pragma unroll
                for (int r4 = 0; r4 < 4; ++r4) otl0[(db * 4 + r4) * 64] = (f32x4){OT[db][4 * r4], OT[db][4 * r4 + 1], OT[db][4 * r4 + 2], OT[db][4 * r4 + 3]} * gt0;
        }
        {
            float m = MINIT, l = 0.f; f32x16 O[2];
            LAS f32x4* otl = (LAS f32x4*)(lds + 65536) + wave * 512 + lane;
            O[0] = (f32x16){0.f, 0.f, 0.f, 0.f, 0.f, 0.f, 0.f, 0.f, 0.f, 0.f, 0.f, 0.f, 0.f, 0.f, 0.f, 0.f}; O[1] = O[0];
            const bf16_t* KbS = KF + (size_t)(b * 4 + g) * 32 * 4096; const bf16_t* VbS = VF + (size_t)(b * 4 + g) * 32 * 4096;
#define ATT_NEXT(nx, kt, pq, win, ok) do { pq = 0; win = 0; ok = false; \
                while ((nx) < 16) { \
                    if ((nx) < 3) { kt = ((nx) == 1) ? qt - 1 : qt; if (kt > 0) { ok = true; break; } ++(nx); } \
                    else if ((nx) == 3) { if (rem == 0ull) { (nx) = 11; continue; } \
                        kt = __builtin_amdgcn_readlane(jsel, (int)__builtin_ctzll(rem)); rem &= ~__ballot(jsel == kt); pq = 1; ok = true; break; } \
                    else { kt = qt - 15 + (nx); win = 1; if (kt >= 0) { ok = true; break; } ++(nx); } } } while (0)
#define ATT_KPTR(kt, win) (KbS + (size_t)(win) * ((size_t)128 * 32 * 4096) + (size_t)(kt) * 4096)
#define ATT_VPTR(kt, win) (VbS + (size_t)(win) * ((size_t)128 * 32 * 4096) + (size_t)(kt) * 4096)
            int st = 0, kt = 0, pq = 0, win = 0;
            unsigned long long rem = __ballot(jsel >= 1);
            int curwin = 0;
            for (;;) {
                int nx = (st == 3) ? 3 : st + 1, nkt = 0, npq = 0, nwin = 0; bool nok = false;
                ATT_NEXT(nx, nkt, npq, nwin, nok);
                bf16x8 Vc[8];
                { const bf16_t* Vp = ATT_VPTR(kt, win);
#pragma unroll
                  for (int bb = 0; bb < 2; ++bb)
#pragma unroll
                    for (int s2 = 0; s2 < 2; ++s2)
#pragma unroll
                        for (int db = 0; db < 2; ++db) Vc[(bb * 2 + s2) * 2 + db] = *(const bf16x8*)(Vp + ((((bb * 2 + s2) * 2 + db) * 64 + lane) * 8)); }
                if (win != curwin) {
                    const float scl = gt1 * __builtin_amdgcn_rcpf(fmaxf(l, TINYF));
#pragma unroll
                    for (int db = 0; db < 2; ++db)
#pragma unroll
                        for (int r4 = 0; r4 < 4; ++r4) otl[(db * 4 + r4) * 64] += (f32x4){O[db][4 * r4], O[db][4 * r4 + 1], O[db][4 * r4 + 2], O[db][4 * r4 + 3]} * scl;
                    m = MINIT; l = 0.f; O[0] = (f32x16){0.f, 0.f, 0.f, 0.f, 0.f, 0.f, 0.f, 0.f, 0.f, 0.f, 0.f, 0.f, 0.f, 0.f, 0.f, 0.f}; O[1] = O[0]; curwin = win; }
                f32x16 s0 = (f32x16){0.f, 0.f, 0.f, 0.f, 0.f, 0.f, 0.f, 0.f, 0.f, 0.f, 0.f, 0.f, 0.f, 0.f, 0.f, 0.f}, s1 = s0;
#pragma unroll
                for (int s2 = 0; s2 < 4; ++s2) { const bf16x8 qf = qlds[64 * s2]; s0 = MFMA32(Kn[2 * s2], qf, s0); s1 = MFMA32(Kn[2 * s2 + 1], qf, s1); }
                { const bf16_t* Kp = nok ? ATT_KPTR(nkt, nwin) : ATT_KPTR(kt, win);
#pragma unroll
                  for (int s2 = 0; s2 < 4; ++s2) { Kn[2 * s2] = *(const bf16x8*)(Kp + (s2 * 64 + lane) * 8); Kn[2 * s2 + 1] = *(const bf16x8*)(Kp + ((4 + s2) * 64 + lane) * 8); } }
                const bool colok = !pq || (jsel == kt);
                const int dq = qt - kt;
                if (win ? (dq == 3) : (dq >= 3)) online_tile_far(s0, s1, colok ? bd[-128] : NEGF, m, l, O);
                else if (win && dq == 4) online_tile_wedge(s0, s1, (tq - kt * 64 - 4 * h) - 255, bd[-128], m, l, O);
                else online_tile(s0, s1, bd - (colok ? (tq - kt * 64 - 4 * h) : -64), m, l, O);
                { float ps = 0.f;
#pragma unroll
                  for (int bb = 0; bb < 2; ++bb) {
                      f32x16& sb = bb ? s1 : s0;
#pragma unroll
                      for (int r = 0; r < 16; ++r) { const float p = __builtin_amdgcn_exp2f(sb[r] - m); sb[r] = p; ps += p; }
#pragma unroll
                      for (int s2 = 0; s2 < 2; ++s2) {
                          u32x4 w; w.x = cvt_pk_bf16(sb[8 * s2 + 0], sb[8 * s2 + 1]); w.y = cvt_pk_bf16(sb[8 * s2 + 2], sb[8 * s2 + 3]); w.z = cvt_pk_bf16(sb[8 * s2 + 4], sb[8 * s2 + 5]); w.w = cvt_pk_bf16(sb[8 * s2 + 6], sb[8 * s2 + 7]);
                          const bf16x8 Pf = __builtin_bit_cast(bf16x8, w);
#pragma unroll
                          for (int db = 0; db < 2; ++db) O[db] = MFMA32(Vc[(bb * 2 + s2) * 2 + db], Pf, O[db]); }
                      __builtin_amdgcn_sched_barrier(0); }
                  ps += __shfl_xor(ps, 32); l += ps; }
                if (!nok) break;
                st = nx; kt = nkt; pq = npq; win = nwin;
            }
#undef ATT_NEXT
#undef ATT_KPTR
#undef ATT_VPTR
            const float scl = gt2 * __builtin_amdgcn_rcpf(fmaxf(l, TINYF));
#pragma unroll
            for (int db = 0; db < 2; ++db)
#pragma unroll
                for (int r4 = 0; r4 < 4; ++r4) { const f32x4 p = otl[(db * 4 + r4) * 64];
#pragma unroll
                    for (int j = 0; j < 4; ++j) OT[db][4 * r4 + j] = p[j] + O[db][4 * r4 + j] * scl; }
        }
        bf16_t* op = OUT + tok * DM + head * 64;
#pragma unroll
        for (int db = 0; db < 2; ++db)
#pragma unroll
            for (int kk = 0; kk < 2; ++kk) {
                const unsigned ax = cvt_pk_bf16(OT[db][8 * kk], OT[db][8 * kk + 1]), ay = cvt_pk_bf16(OT[db][8 * kk + 2], OT[db][8 * kk + 3]);
                const unsigned bx = cvt_pk_bf16(OT[db][8 * kk + 4], OT[db][8 * kk + 5]), by = cvt_pk_bf16(OT[db][8 * kk + 6], OT[db][8 * kk + 7]);
                const auto r0 = __builtin_amdgcn_permlane32_swap(ax, bx, false, false);
                const auto r1 = __builtin_amdgcn_permlane32_swap(ay, by, false, false);
                u32x4 w; w.x = r0[0]; w.y = r1[0]; w.z = r0[1]; w.w = r1[1];
                *(u32x4*)(op + 32 * db + 16 * kk + 8 * h) = w; }
    }
    __builtin_amdgcn_s_setprio(0);
}

constexpr int MOE_CHUNK_TILES = 128, MOE_NCHUNK = 4, MOE_LAST_TILES = 136,       DENSE_NCHUNK = 4, DENSE_CHUNK_ROWS = 16384;
__host__ __device__ constexpr int n_phases() {
    int pc = 0;
    for (int L = 0; L < 4; ++L) {
        if (L < 2) pc += 2; else { pc += (L == 2) ? 6 : 3; }
        if (L % 2 == 0) pc += 2 * DENSE_NCHUNK; else pc += 2 + 2 * MOE_NCHUNK + 1;
    }
    return pc;
}

typedef __attribute__((address_space(4))) const Args* KArgsPtr;
__device__ __forceinline__ Args load_args() {
    Args r{};
#if defined(__HIP_DEVICE_COMPILE__)
    KArgsPtr kp = (KArgsPtr)__builtin_amdgcn_kernarg_segment_ptr(); asm volatile("" : "+s"(kp));
#pragma unroll
    for (int i = 0; i < 22; ++i) r.in[i] = kp->in[i];
    r.out = kp->out; r.ws = kp->ws; r.ph_lo = kp->ph_lo; r.ph_hi = kp->ph_hi;
#endif
    return r;
}
__global__ void __launch_bounds__(NTHREADS, 2) yoco_fwd(Args kargs) {
    extern __shared__ __attribute__((aligned(16))) unsigned char lds_raw[];
    LAS unsigned char* lds = (LAS unsigned char*)lds_raw;
    volatile LAS unsigned* MISC = (volatile LAS unsigned*)(lds + MISC_OFF);
    const int tid = threadIdx.x, G = gridDim.x, cid = blockIdx.x;
    if (tid < 64) MISC[tid] = 0u;
    __syncthreads();
#if MK_SINGLE_LAUNCH
    constexpr int lo = 0, hi = n_phases();
#else
    const int lo = kargs.ph_lo, hi = kargs.ph_hi;
#endif
    unsigned char* ws = kargs.ws;
    const bool SPLIT_OK = (lo == 0 && hi == n_phases());
    if (hi - lo > 1) (void)xcd_barrier_post((unsigned*)(ws + WS_CTL), MISC + 8);
    if (tid == 0) atomicOr((unsigned*)(ws + WS_CTL + CTL_XMASK) + (cid & 7), 1u << xb_xcc_id());
    int pc = 0;
#define PH_BEGIN if (pc >= lo && pc < hi) { const Args args = load_args();
#define PH_JOIN }
#define PH_END_SPLIT(split) } if (pc >= lo && pc + 1 < hi) { XcdBarrier bb; bb.bar = (unsigned*)(load_args().ws + WS_CTL); bb.x = xb_xcc_id(); bb.st = (volatile LAS unsigned*)(lds + MISC_OFF) + 8; if (split) xcd_arrive(bb); else xcd_barrier(bb); } ++pc;
#define PH_END_GROUP(grp) } if (pc >= lo && pc + 1 < hi) { XcdBarrier bb; bb.bar = (unsigned*)(load_args().ws + WS_CTL); bb.x = xb_xcc_id(); bb.st = (volatile LAS unsigned*)(lds + MISC_OFF) + 8; if (grp) group_barrier(bb, cid); else xcd_barrier(bb); } ++pc;
#define PH_END } if (pc >= lo && pc + 1 < hi) { XcdBarrier bb; bb.bar = (unsigned*)(load_args().ws + WS_CTL); bb.x = xb_xcc_id(); bb.st = (volatile LAS unsigned*)(lds + MISC_OFF) + 8; xcd_barrier(bb); if (PROBE_BAR) xcd_barrier(bb); } ++pc;

    bf16_t* XB = (bf16_t*)(ws + WS_KVRAW);
    bf16_t* HID = (bf16_t*)(ws + WS_H);
    float* SSQ = (float*)(ws + MS_SSQ);
    LAS float* EPIP = (LAS float*)(lds + MISC_OFF + LX_P); LAS float* EPISQ = (LAS float*)(lds + MISC_OFF + LX_SQ);
    LAS float* LGAIN = (LAS float*)(lds + MISC_OFF + LX_GAIN); LAS float* LPOS = (LAS float*)(lds + MISC_OFF + LX_POS);


#pragma clang loop unroll(full)
    for (int L = 0; L < 4; ++L) {
        const bf16_t* XBin = XB;
        if (L < 2) {
            PH_BEGIN
                if (L == 0) { p_convert_static(args, lds); p_convert_moe(args, lds, 0); __syncthreads();
                              p_pool_diff(args.in[I_X], (const float*)nullptr, HID, lds); }
                else p_pool_diff((const bf16_t*)XB, (const float*)SSQ, HID, lds);
            PH_END
            PH_BEGIN
                pg8::Gemm g{256, DM, 256};
                pg8::GridSched S{NTOK / 256, 4, G, cid, (const char*)HID, (size_t)256 * DM * 2, (size_t)256 * 2, (const char*)(ws + W_POOL) + (size_t)L * 4 * 65536 * 2, (size_t)65536 * 2, 0, 1 << 30};
                if (L == 0) { pg8::EpiResid<float> E{args.in[I_X], XB, SSQ, DM, 0, EPIP, 1.f}; pg8::gemm_phase(lds, g, S, E); }
                else { pg8::EpiResid<bf16_t> E{XB, XB, SSQ, DM, 0, EPIP, 1.f}; pg8::gemm_phase(lds, g, S, E); }
            PH_END
        } else {
            const int j = L - 2;
            if (j == 0) {
                PH_BEGIN
                    { const int t = opaque_tid();
                      if (t < 192) LGAIN[t] = args.in[I_GK][t];
                      for (int i = t; i < 2 * 32 * 64; i += NTHREADS) LPOS[i] = args.in[I_CPOS][i];
                      __syncthreads(); }
                    pg8::Gemm g{DM, DM, DM};
                    pg8::GridSched S{NTOK / 256, 6, G, cid, (const char*)XBin, (size_t)256 * DM * 2, 0, (const char*)(ws + W_KV), (size_t)256 * DM * 2, 0, 1 << 30};
                    pg8::EpiKV E{pg8::RowScale{SSQ, 0, EPISQ}, (bf16_t*)(ws + WS_BLK), (bf16_t*)(ws + WS_KF), (bf16_t*)(ws + WS_VF), LGAIN, LPOS};
                    DUP(7) pg8::gemm_phase(lds, g, S, E);
                PH_JOIN
            }
            PH_BEGIN
                { const int t = opaque_tid(); if (t < 64) LGAIN[192 + t] = args.in[I_GQ][j * 64 + t]; __syncthreads(); }
                pg8::Gemm g{DM, DM, DM};
                pg8::GridSched S{NTOK / 256, 5, G, cid, (const char*)XBin, (size_t)256 * DM * 2, 0, (const char*)(ws + W_QG) + (size_t)j * 1280 * DM * 2, (size_t)256 * DM * 2, 0, 1 << 30};
                pg8::EpiQG E{pg8::RowScale{SSQ, 0, EPISQ}, (bf16_t*)(ws + WS_QGRAW), 1280, LGAIN + 192, 0.125f * 1.44269504f};
                DUP(7) pg8::gemm_phase(lds, g, S, E);
            PH_END
            if (j == 0) {
                PH_BEGIN
                    pg8::Gemm g{2048, 2048, 2048};
                    pg8::GridSched S{128, 1, G, cid, (const char*)(ws + WS_BLK), (size_t)256 * 2048 * 2, 0, (const char*)(ws + W_C1), 0, (size_t)256 * 2048 * 2, 64};
                    pg8::EpiBf16<1, false> E{HID, 256, pg8::RowScale{nullptr, 0, nullptr}, 1.f};
                    DUP(7) pg8::gemm_phase(lds, g, S, E);
                PH_END
                PH_BEGIN
                    pg8::Gemm g{256, 256, 256};
                    pg8::GridSched S{128, 1, G, cid, (const char*)HID, (size_t)256 * 256 * 2, 0, (const char*)(ws + W_C2), 0, (size_t)256 * 256 * 2, 64};
                    pg8::EpiCmp2 E{(float*)(ws + MS_CMPRAW)};
                    DUP(7) pg8::gemm_phase(lds, g, S, E);
                PH_END
                PH_BEGIN
                    DUP(6) p_cmp_finish(args);
                PH_END
            }
            PH_BEGIN
                p_attn<0>(args, lds);
#if PROBE_ATTN
                p_attn<PROBE_ATTN>(args, lds);
#endif
            PH_END
            PH_BEGIN
                pg8::Gemm g{DM, DM, DM};
                pg8::GridSched S{NTOK / 256, 4, G, cid, (const char*)HID, (size_t)256 * DM * 2, 0, (const char*)(ws + W_O) + (size_t)j * DM * DM * 2, (size_t)256 * DM * 2, 0, 1 << 30};
                pg8::EpiResid<bf16_t> E{XB, XB, SSQ, DM, 0, EPIP, 1.f};
                pg8::gemm_phase(lds, g, S, E);
            PH_END
        }
        if ((L & 1) == 0) {
            const int i = L >> 1;
            for (int ch = 0; ch < DENSE_NCHUNK; ++ch) {
                PH_BEGIN
                    pg8::Gemm g{DM, DM, DM};
                    pg8::GridSched S{DENSE_CHUNK_ROWS / 256, 28, G, cid, (const char*)(XB + (size_t)ch * DENSE_CHUNK_ROWS * DM), (size_t)256 * DM * 2, 0, (const char*)(ws + W_GU) + (size_t)i * 7168 * DM * 2, (size_t)256 * DM * 2, 0, 1 << 30};
                    pg8::EpiSwiGLU<true> E{HID, FFD, pg8::RowScale{SSQ, ch * DENSE_CHUNK_ROWS, EPISQ}, (unsigned*)(ws + MS_CMPRAW)};
                    pg8::gemm_phase(lds, g, S, E, WaitHook{SPLIT_OK && ch > 0, (unsigned*)(args.ws + WS_CTL), (volatile LAS unsigned*)(lds + MISC_OFF) + 8});
                PH_END_GROUP(SPLIT_OK)
                PH_BEGIN
                    pg8::Gemm g{FFD / 2, FFD / 2, FFD / 2};
                    pg8::GridSched S{DENSE_CHUNK_ROWS / 256, 4, G, cid, (const char*)HID, (size_t)256 * FFD, 0, (const char*)(ws + W_D) + (size_t)i * DM * FFD, (size_t)256 * FFD, 0, 1 << 30};
                    pg8::EpiResid<bf16_t> E{XB, XB, SSQ, DM, ch * DENSE_CHUNK_ROWS, EPIP, pg8::F8_OSC};
                    pg8::gemm_phase<pg8::EpiResid<bf16_t>, pg8::GridSched, pg8::NoHook, true, true>(lds, g, S, E);
                PH_END_SPLIT(SPLIT_OK && ch + 1 < DENSE_NCHUNK)
            }
        } else {
            const int l = L >> 1;
            PH_BEGIN
                if (l == 1) { p_convert_moe(args, lds, 1); __syncthreads(); }
                p_router_a(args, XB, l, lds);
            PH_END
            PH_BEGIN
                DUP(5) p_router_b(args, XB, lds);
            PH_END
            for (int ch = 0; ch < MOE_NCHUNK; ++ch) {
                PH_BEGIN
                    const int NT = *(const int*)(ws + CTL_NT), capT = (ch == MOE_NCHUNK - 1) ? MOE_LAST_TILES : MOE_CHUNK_TILES; int nT = NT - ch * MOE_CHUNK_TILES; nT = nT < 0 ? 0 : (nT > capT ? capT : nT);
                    LAS int* LTE = (LAS int*)(lds + MISC_OFF + 14336);
                    { const int t = opaque_tid(); if (t < nT) LTE[t] = ((const int*)(ws + CTL_TILEE))[ch * MOE_CHUNK_TILES + t]; __syncthreads(); }
                    pg8::Gemm g{DM / 2, DM / 2, DM / 2};
                    pg8::MoeSched S{nT, 28, G, cid, LTE, (const char*)(ws + WS_A + 128 * MiB) + (size_t)ch * MOE_CHUNK_TILES * 256 * DM, (size_t)256 * DM, (const char*)(ws + WS_WMOE), (size_t)256 * DM, 28};
                    pg8::EpiSwiGLU<false> E{HID, FFD, pg8::RowScale{nullptr, 0, nullptr}, (unsigned*)(ws + MS_CMPRAW)};
                    pg8::gemm_phase<pg8::EpiSwiGLU<false>, pg8::MoeSched, WaitHook, false, true>(lds, g, S, E, WaitHook{SPLIT_OK && ch > 0, (unsigned*)(args.ws + WS_CTL), (volatile LAS unsigned*)(lds + MISC_OFF) + 8});
                PH_END_GROUP(SPLIT_OK && ch + 1 < MOE_NCHUNK)
                PH_BEGIN
                    const int NT = *(const int*)(ws + CTL_NT), capT = (ch == MOE_NCHUNK - 1) ? MOE_LAST_TILES : MOE_CHUNK_TILES; int nT = NT - ch * MOE_CHUNK_TILES; nT = nT < 0 ? 0 : (nT > capT ? capT : nT);
                    LAS int* LTE = (LAS int*)(lds + MISC_OFF + 14336);
                    { const int t = opaque_tid(); if (t < nT) LTE[t] = ((const int*)(ws + CTL_TILEE))[ch * MOE_CHUNK_TILES + t]; __syncthreads(); }
                    { pg8::Gemm g{FFD / 2, FFD / 2, FFD / 2};
                      pg8::MoeSched S{nT, 4, G, cid, LTE, (const char*)HID, (size_t)256 * FFD, (const char*)(ws + WMOE_D), (size_t)256 * FFD, 4};
                      pg8::EpiBf16<0, false> E{(bf16_t*)(ws + WS_A) + (size_t)ch * MOE_CHUNK_TILES * 256 * DM, DM, pg8::RowScale{nullptr, 0, nullptr}, pg8::F8_OSC};
                      pg8::gemm_phase<pg8::EpiBf16<0, false>, pg8::MoeSched, pg8::NoHook, true, true>(lds, g, S, E); }
                PH_END_SPLIT(SPLIT_OK && ch + 1 < MOE_NCHUNK)
            }
            PH_BEGIN
                if (L == 3) p_moe_combine<true>(args, XB, SSQ, kargs.out); else p_moe_combine<false>(args, XB, SSQ, nullptr);
            PH_END
        }
    }
#undef PH_BEGIN
#undef PH_END
}

extern "C" void kernel_launch(void* const* d_in, const int* in_sizes, int n_in, void* d_out, int out_size, void* d_ws, size_t ws_size, hipStream_t stream) {
    static int grid = 0;
    if (grid == 0) {
        if (n_in != 22 || in_sizes[0] != NTOK * DM || out_size != NTOK * DM || ws_size < WS_END) {
            fprintf(stderr, "kernel_launch: unexpected problem: n_in %d in0 %d out %d ws %zu (need %zu)\n", n_in, n_in > 0 ? in_sizes[0] : -1, out_size, ws_size, (size_t)WS_END); grid = -1; return; }
        int dev = 0, cus = 0;
        if (hipGetDevice(&dev) != hipSuccess || hipDeviceGetAttribute(&cus, hipDeviceAttributeMultiprocessorCount, dev) != hipSuccess) { grid = -1; return; }
        if (hipFuncSetAttribute((const void*)yoco_fwd, hipFuncAttributeMaxDynamicSharedMemorySize, LDS_BYTES) != hipSuccess) { fprintf(stderr, "kernel_launch: hipFuncSetAttribute failed\n"); grid = -1; return; }
        int per_cu = 0;
        if (hipOccupancyMaxActiveBlocksPerMultiprocessor(&per_cu, (const void*)yoco_fwd, NTHREADS, LDS_BYTES) != hipSuccess || per_cu < 1)
            fprintf(stderr, "kernel_launch: note: occupancy query says %d\n", per_cu);
        (void)hipGetLastError();
        grid = cus;
    }
    if (grid < 0) return;
    (void)hipMemsetAsync((char*)d_ws + WS_CTL, 0, CTL_ZERO_BYTES, stream);
    Args a{};
    for (int i = 0; i < 22; ++i) a.in[i] = (const float*)d_in[i];
    a.out = (float*)d_out; a.ws = (unsigned char*)d_ws;
    constexpr int NPH = n_phases();
#if MK_SINGLE_LAUNCH
    a.ph_lo = 0; a.ph_hi = NPH;
    hipLaunchKernelGGL(yoco_fwd, dim3(grid), dim3(NTHREADS), LDS_BYTES, stream, a);
#else
    for (int p = 0; p < NPH; ++p) { a.ph_lo = p; a.ph_hi = p + 1; hipLaunchKernelGGL(yoco_fwd, dim3(grid), dim3(NTHREADS), LDS_BYTES, stream, a); }
#endif
}
```

```cpp
#include <hip/hip_runtime.h>
#include <cstdio>
#include <cstdint>

#ifndef MK_SINGLE_LAUNCH
#define MK_SINGLE_LAUNCH 1
#endif

#ifndef PROBE_BAR
#define PROBE_BAR 0
#endif
#ifndef PROBE_ATTN
#define PROBE_ATTN 0
#endif
#ifndef PROBE_DUP
#define PROBE_DUP 0
#endif
#define DUP(bit) for (int _rep = 0; _rep < (((PROBE_DUP) >> (bit)) & 1) + 1; ++_rep)
#define LAS __attribute__((address_space(3)))
typedef unsigned short bf16_t;
typedef short bf16x8 __attribute__((ext_vector_type(8)));
typedef float f32x4 __attribute__((ext_vector_type(4)));
typedef float f32x2 __attribute__((ext_vector_type(2)));
typedef unsigned u32x4 __attribute__((ext_vector_type(4)));
typedef int v8i32 __attribute__((ext_vector_type(8)));
typedef int v4i32 __attribute__((ext_vector_type(4)));
typedef unsigned u32x2 __attribute__((ext_vector_type(2)));

constexpr int NTOK = 65536, DM = 1024, FFD = 3584, NEXP = 8, SEQ = 2048, NBATCH = 32;
constexpr int NCMP = 127, NSLC = 32;
constexpr float EPS = 1e-6f;
constexpr float NEGF = -1e30f, TINYF = 1e-30f;

constexpr size_t MiB = (size_t)1 << 20;
constexpr size_t WS_CTL = 0;
constexpr size_t CTL_ZERO_BYTES = 64 * 1024;
constexpr size_t CTL_CNT = 64 * 1024;
constexpr size_t CTL_TILEE = 80 * 1024;
constexpr size_t CTL_NT = 88 * 1024;
constexpr size_t WS_W = 1 * MiB;
constexpr size_t W_POOL = WS_W;
constexpr size_t W_GU = W_POOL + (size_t)2 * 4 * 256 * 256 * 2;
constexpr size_t W_D = W_GU + (size_t)2 * 7168 * 1024 * 2;
constexpr size_t W_KV = W_D + (size_t)2 * 1024 * 3584 * 2;
constexpr size_t W_QG = W_KV + (size_t)1536 * 1024 * 2;
constexpr size_t W_O = W_QG + (size_t)2 * 1280 * 1024 * 2;
constexpr size_t W_C1 = W_O + (size_t)2 * 1024 * 1024 * 2;
constexpr size_t W_C2 = W_C1 + (size_t)2 * 256 * 2048 * 2;
constexpr size_t W_END = W_C2 + (size_t)2 * 256 * 256 * 2;
constexpr size_t WS_WMOE = 60 * MiB;
constexpr size_t WMOE_D = WS_WMOE + (size_t)8 * 7168 * 1024 * 2;
constexpr size_t WS_A = 228 * MiB;
constexpr size_t WS_BLK = WS_A + 128 * MiB;
constexpr size_t WS_KF = WS_WMOE;
constexpr size_t WS_VF = WS_WMOE + 64 * MiB;
constexpr size_t WS_KCF = WS_WMOE + 128 * MiB;
constexpr size_t WS_VCF = WS_KCF + 2 * MiB;
constexpr size_t WS_H = 488 * MiB;
constexpr size_t WS_KVRAW = 616 * MiB;
constexpr size_t WS_QGRAW = 808 * MiB;
constexpr size_t WS_MISC = 968 * MiB;
constexpr size_t MS_CMPRAW = WS_MISC;
constexpr size_t MS_RE = WS_MISC + 8 * MiB;
constexpr size_t MS_RG = MS_RE + 256 * 1024;
constexpr size_t MS_RSTD = MS_RG + 512 * 1024;
constexpr size_t MS_SLOT = MS_RSTD + 256 * 1024;
constexpr size_t MS_SSQ = MS_SLOT + 512 * 1024;
constexpr size_t WS_END = WS_MISC + 12 * MiB;
static_assert(W_END <= WS_WMOE, "weights region");

__device__ __forceinline__ unsigned f2bf(float f) { unsigned u = __builtin_bit_cast(unsigned, f); return (u + 0x7fffu + ((u >> 16) & 1u)) >> 16; }
__device__ __forceinline__ unsigned pk2(float lo, float hi) { return f2bf(lo) | (f2bf(hi) << 16); }
__device__ __forceinline__ float bf2f(unsigned short b) { return __builtin_bit_cast(float, (unsigned)b << 16); }
__device__ __forceinline__ float bflo(unsigned w) { return __builtin_bit_cast(float, w << 16); }
__device__ __forceinline__ float bfhi(unsigned w) { return __builtin_bit_cast(float, w & 0xffff0000u); }
__device__ __forceinline__ unsigned cvt_pk_bf16(float lo, float hi) { unsigned r; asm volatile("v_cvt_pk_bf16_f32 %0, %1, %2" : "=v"(r) : "v"(lo), "v"(hi)); return r; }
__device__ __forceinline__ f32x4 ld4(const float* p) { return *(const f32x4*)p; }
__device__ __forceinline__ f32x4 ld4(const bf16_t* p) { const u32x2 w = *(const u32x2*)p; return (f32x4){bflo(w.x), bfhi(w.x), bflo(w.y), bfhi(w.y)}; }
__device__ __forceinline__ void ld8(const float* p, f32x4& a, f32x4& b) { a = *(const f32x4*)p; b = *(const f32x4*)(p + 4); }
__device__ __forceinline__ void ld8(const bf16_t* p, f32x4& a, f32x4& b) { const u32x4 w = *(const u32x4*)p; a = (f32x4){bflo(w.x), bfhi(w.x), bflo(w.y), bfhi(w.y)}; b = (f32x4){bflo(w.z), bfhi(w.z), bflo(w.w), bfhi(w.w)}; }
__device__ __forceinline__ float wave_sum(float v) {
#pragma unroll
    for (int o = 1; o < 64; o <<= 1) v += __shfl_xor(v, o);
    return v;
}
__device__ __forceinline__ int opaque_tid() { int t = threadIdx.x; asm volatile("" : "+v"(t)); return t; }
__device__ __forceinline__ float silu_f(float g) { return g * __builtin_amdgcn_rcpf(1.f + __expf(-g)); }

namespace pg8 {
constexpr int BM = 256, BK = 64, HALF = 128, HTB = HALF * BK * 2, STAGE_BYTES = 8 * HTB, NXCD = 8, WGM = 8;
__host__ __device__ __forceinline__ int lds_byte(int r, int c) { const int st = (r >> 4) * 2 + (c >> 5), rr = r & 15, cc = c & 31, ob = rr * 64 + cc * 2; return st * 1024 + (ob ^ (((ob >> 9) & 1) << 5)); }
__host__ __device__ __forceinline__ void stage_rc(int b, int& R, int& C) { const int st = b / 1024, sb = b % 1024, swz = sb ^ (((sb >> 9) & 1) << 5); R = (st >> 1) * 16 + swz / 64; C = (st & 1) * 32 + (swz % 64) / 2; }
__host__ __device__ __forceinline__ int perm32(int rho) { const int n = rho >> 4, i = rho & 15; return 8 * (i >> 2) + 4 * n + (i & 3); }

struct Unit { int pm, pn; };
struct Gemm { int K, lda, ldb; };

__device__ __forceinline__ bool grid_order(int nM, int nN, int G, int c, int i, Unit& u) {
    const int nwg = nM * nN; const long L = (long)i * G + c; if (L >= nwg) return false;
    int wgid = (int)L; { const int q = nwg / NXCD, r = nwg % NXCD, xcd = wgid % NXCD, off = wgid / NXCD; wgid = (xcd < r ? xcd * (q + 1) : r * (q + 1) + (xcd - r) * q) + off; }
    const int nig = WGM * nN, gid = wgid / nig, fm = gid * WGM, gsz = (nM - fm) < WGM ? (nM - fm) : WGM;
    u.pm = fm + ((wgid % nig) % gsz); u.pn = (wgid % nig) / gsz; return true;
}
struct GridSched {
    int nM, nN, G, c; const char* A; size_t a_sm, a_sn; const char* B; size_t b_sn, b_sm; int b_div;
    __device__ __forceinline__ bool next(int i, Unit& u) const { return grid_order(nM, nN, G, c, i, u); }
    __device__ __forceinline__ const char* a_tile(const Unit& u) const { return A + (size_t)u.pm * a_sm + (size_t)u.pn * a_sn; }
    __device__ __forceinline__ const char* b_tile(const Unit& u) const { return B + (size_t)u.pn * b_sn + (size_t)(u.pm / b_div) * b_sm; }
};
struct MoeSched {
    int nM, nN, G, c; const LAS int* tile_e; const char* A; size_t a_sm; const char* B; size_t b_tile_bytes; int tiles_per_e;
    __device__ __forceinline__ bool next(int i, Unit& u) const { return grid_order(nM, nN, G, c, i, u); }
    __device__ __forceinline__ const char* a_tile(const Unit& u) const { return A + (size_t)u.pm * a_sm; }
    __device__ __forceinline__ const char* b_tile(const Unit& u) const { const int e = __builtin_amdgcn_readfirstlane(tile_e[u.pm]); return B + ((size_t)e * tiles_per_e + u.pn) * b_tile_bytes; }
};

constexpr int XSPLIT = 7, XK = 512, XROWS = 8 * 256;
constexpr float F8_HS = 8.f, F8_WS = 64.f, F8_OSC = 1.f / (F8_HS * F8_WS);
constexpr float F8_XS = 8.f, F8_GUS = 1.f / (F8_XS * F8_WS);
constexpr int XKE = XK / 2;
struct MoeSplitSched {
    int nX, G, c; const LAS int* tile_e; const char* A; size_t a_sm; const char* B; size_t b_tile_bytes;
    __device__ __forceinline__ bool next(int i, Unit& u) const { return grid_order(nX, 4 * XSPLIT, G, c, i, u); }
    __device__ __forceinline__ const char* a_tile(const Unit& u) const { return A + (size_t)u.pm * a_sm + (size_t)(u.pn >> 2) * (XK / 64) * 1024; }
    __device__ __forceinline__ const char* b_tile(const Unit& u) const { const int e = __builtin_amdgcn_readfirstlane(tile_e[u.pm]); return B + ((size_t)e * 4 + (u.pn & 3)) * b_tile_bytes + (size_t)(u.pn >> 2) * (XK / 64) * 1024; }
};
struct RowScale {
    const float* SSQ; int row_off; LAS float* SQ;
    __device__ __forceinline__ void pre_dma(const Unit& u, int slot, int wid, int lane) const {
        const float* g = SSQ + (size_t)(row_off + u.pm * BM) * 4 + wid * 64 + lane;
#pragma unroll
        for (int i = 0; i < 2; ++i) __builtin_amdgcn_global_load_lds((const unsigned*)(g + i * 512), (LAS unsigned*)(SQ + slot * 1024 + i * 512 + wid * 64), 4, 0, 0);
    }
    __device__ __forceinline__ float msq(int slot, int lrow) const { const f32x4 p = *(const LAS f32x4*)(SQ + slot * 1024 + lrow * 4); return ((p.x + p.y) + (p.z + p.w)) * (1.f / DM) + EPS; }
    __device__ __forceinline__ float get(int slot, int lrow) const { const f32x4 p = *(const LAS f32x4*)(SQ + slot * 1024 + lrow * 4); return __builtin_amdgcn_rsqf(((p.x + p.y) + (p.z + p.w)) * (1.f / DM) + EPS); }
};
template <typename TS> struct EpiResid {
    static constexpr bool PERM = true, PRE = false; static constexpr int NSTORE = 0;
    __device__ __forceinline__ void pre_dma(const Unit&, int, int, int) const {}
    const TS* src; bf16_t* XB; float* SSQ; int ld; int row_off; LAS float* P; float osc;
    __device__ __forceinline__ void operator()(const f32x4 (&acc)[2][2][4][2], const Unit& u, int wr, int wc, int fr, int fq, int) const {
        const int row0 = row_off + u.pm * BM + wr * 64 + fr, col0 = u.pn * BM + wc * 32 + 8 * fq;
#pragma unroll
        for (int ai = 0; ai < 2; ++ai)
#pragma unroll
            for (int m = 0; m < 4; ++m) { const size_t ro = (size_t)(row0 + ai * HALF + m * 16) * ld + col0; float ss = 0.f;
#pragma unroll
                for (int bj = 0; bj < 2; ++bj) { f32x4 v0, v1; ld8(src + ro + bj * HALF, v0, v1); v0 += acc[ai][bj][m][0] * osc; v1 += acc[ai][bj][m][1] * osc;
                        u32x4 w; w.x = cvt_pk_bf16(v0.x, v0.y); w.y = cvt_pk_bf16(v0.z, v0.w); w.z = cvt_pk_bf16(v1.x, v1.y); w.w = cvt_pk_bf16(v1.z, v1.w); *(u32x4*)(XB + ro + bj * HALF) = w;
                        ss += ((v0.x * v0.x + v0.y * v0.y) + (v0.z * v0.z + v0.w * v0.w)) + ((v1.x * v1.x + v1.y * v1.y) + (v1.z * v1.z + v1.w * v1.w)); }
                ss += __shfl_xor(ss, 16); ss += __shfl_xor(ss, 32);
                if (fq == 0) P[(ai * HALF + wr * 64 + m * 16 + fr) * 4 + wc] = ss; }
        asm volatile("s_waitcnt lgkmcnt(0)" ::: "memory"); __builtin_amdgcn_s_barrier(); asm volatile("" ::: "memory");
        const int t = opaque_tid();
        if (t < 256) { const f32x4 p = *(const LAS f32x4*)(P + t * 4); SSQ[(size_t)(row_off + u.pm * BM + t) * 4 + u.pn] = (p.x + p.y) + (p.z + p.w); }
    }
};
template <bool SCALE> struct EpiSwiGLU {
    static constexpr bool PERM = true, PRE = SCALE; static constexpr int NSTORE = 0;
    bf16_t* O; int ldc; RowScale R; unsigned* sink;
    __device__ __forceinline__ unsigned* dummy() const { return sink + (size_t)blockIdx.x * 4096; }
    __device__ __forceinline__ void pre_dma(const Unit& u, int slot, int wid, int lane) const { if (SCALE) R.pre_dma(u, slot, wid, lane); }
    __device__ __forceinline__ void operator()(const f32x4 (&acc)[2][2][4][2], const Unit& u, int wr, int wc, int fr, int fq, int slot) const {
        const int rb0 = u.pm * 16 + wr * 4, cb = u.pn * 2 + (wc >> 1), ncb = ldc >> 6;
#pragma unroll
        for (int ai = 0; ai < 2; ++ai)
#pragma unroll
            for (int m = 0; m < 4; ++m) { bf16_t* rowp = (bf16_t*)((char*)O + ((size_t)(rb0 + ai * 8 + m) * ncb + cb) * 1024 + fr * 64 + (wc & 1) * 32 + fq * 8);
                float nr = SCALE ? -1.44269504f : -1.44269504f * F8_GUS, ir2 = 1.f;
                if (SCALE) { ir2 = R.msq(slot, ai * HALF + wr * 64 + m * 16 + fr); nr = -1.44269504f * __builtin_amdgcn_rsqf(ir2); }
                u32x4 w = (u32x4){0u, 0u, 0u, 0u};
#pragma unroll
                for (int n = 0; n < 2; ++n) {
#pragma unroll
                    for (int hh = 0; hh < 2; ++hh) { const f32x2 g = (f32x2){acc[ai][0][m][n][2 * hh], acc[ai][0][m][n][2 * hh + 1]}, u = (f32x2){acc[ai][1][m][n][2 * hh], acc[ai][1][m][n][2 * hh + 1]};
                        const f32x2 t = g * nr; f32x2 e; e.x = __builtin_amdgcn_exp2f(t.x); e.y = __builtin_amdgcn_exp2f(t.y);
                        f32x2 d; if (SCALE) d = e * ir2 + ir2; else d = e + 1.0f;
                        f32x2 q; q.x = __builtin_amdgcn_rcpf(d.x); q.y = __builtin_amdgcn_rcpf(d.y);
                        const f32x2 hv = (g * u) * q;
                        { const f32x2 h8 = hv * (SCALE ? F8_HS : F8_HS * F8_GUS * F8_GUS);
                            if (n == 0 && hh == 0) w.x = (unsigned)__builtin_amdgcn_cvt_pk_fp8_f32(h8.x, h8.y, (int)w.x, false); else if (n == 0) w.x = (unsigned)__builtin_amdgcn_cvt_pk_fp8_f32(h8.x, h8.y, (int)w.x, true);
                            else if (hh == 0) w.y = (unsigned)__builtin_amdgcn_cvt_pk_fp8_f32(h8.x, h8.y, (int)w.y, false); else w.y = (unsigned)__builtin_amdgcn_cvt_pk_fp8_f32(h8.x, h8.y, (int)w.y, true); } } }
                *(u32x2*)rowp = (u32x2){w.x, w.y}; }
    }
};
template <int ACT  , bool SCALE> struct EpiBf16 {
    static constexpr bool PERM = true, PRE = SCALE; static constexpr int NSTORE = 0;
    bf16_t* O; int ldc; RowScale R; float osc;
    __device__ __forceinline__ void pre_dma(const Unit& u, int slot, int wid, int lane) const { if (SCALE) R.pre_dma(u, slot, wid, lane); }
    __device__ __forceinline__ void operator()(const f32x4 (&acc)[2][2][4][2], const Unit& u, int wr, int wc, int fr, int fq, int slot) const {
        const int row0 = u.pm * BM + wr * 64 + fr, col0 = u.pn * BM + wc * 32 + 8 * fq;
#pragma unroll
        for (int ai = 0; ai < 2; ++ai)
#pragma unroll
            for (int m = 0; m < 4; ++m) { bf16_t* rowp = O + (size_t)(row0 + ai * HALF + m * 16) * ldc + col0;
                const float r = (SCALE ? R.get(slot, ai * HALF + wr * 64 + m * 16 + fr) : 1.f) * osc;
#pragma unroll
                for (int bj = 0; bj < 2; ++bj) { f32x4 v0 = acc[ai][bj][m][0] * r, v1 = acc[ai][bj][m][1] * r;
                    if (ACT == 1) {
#pragma unroll
                        for (int j = 0; j < 4; ++j) { v0[j] = silu_f(v0[j]); v1[j] = silu_f(v1[j]); } }
                    u32x4 w; w.x = cvt_pk_bf16(v0[0], v0[1]); w.y = cvt_pk_bf16(v0[2], v0[3]); w.z = cvt_pk_bf16(v1[0], v1[1]); w.w = cvt_pk_bf16(v1[2], v1[3]);
                    *(u32x4*)(rowp + bj * HALF) = w; } }
    }
};

struct EpiPart {
    static constexpr bool PERM = true, PRE = false; static constexpr int NSTORE = 0;
    bf16_t* P;
    __device__ __forceinline__ void pre_dma(const Unit&, int, int, int) const {}
    __device__ __forceinline__ void operator()(const f32x4 (&acc)[2][2][4][2], const Unit& u, int wr, int wc, int fr, int fq, int) const {
        const int row0 = u.pm * BM + wr * 64 + fr, col0 = (u.pn & 3) * BM + wc * 32 + 8 * fq; bf16_t* O = P + (size_t)(u.pn >> 2) * XROWS * DM;
#pragma unroll
        for (int ai = 0; ai < 2; ++ai)
#pragma unroll
            for (int m = 0; m < 4; ++m) { bf16_t* rowp = O + (size_t)(row0 + ai * HALF + m * 16) * DM + col0;
#pragma unroll
                for (int bj = 0; bj < 2; ++bj) { const f32x4 v0 = acc[ai][bj][m][0] * F8_OSC, v1 = acc[ai][bj][m][1] * F8_OSC;
                    u32x4 w; w.x = cvt_pk_bf16(v0[0], v0[1]); w.y = cvt_pk_bf16(v0[2], v0[3]); w.z = cvt_pk_bf16(v1[0], v1[1]); w.w = cvt_pk_bf16(v1[2], v1[3]);
                    *(u32x4*)(rowp + bj * HALF) = w; } }
    }
};

__device__ __forceinline__ int vt_pos_(int k) { return (k & ~12) | ((k & 4) << 1) | ((k & 8) >> 1); }
struct EpiKV {
    static constexpr bool PERM = true, PRE = true; static constexpr int NSTORE = 0;
    RowScale R; bf16_t* BLK; bf16_t* KF; bf16_t* VF; const LAS float* gain; const LAS float* pos;
    __device__ __forceinline__ void pre_dma(const Unit& u, int slot, int wid, int lane) const { R.pre_dma(u, slot, wid, lane); }
    __device__ __forceinline__ void operator()(const f32x4 (&acc)[2][2][4][2], const Unit& u, int wr, int wc, int fr, int fq, int slot) const {
        const int kind = u.pn, w = kind >> 1, g = wc;
#pragma unroll
        for (int ai = 0; ai < 2; ++ai)
#pragma unroll
            for (int m = 0; m < 4; ++m) {
                const int lrow = ai * HALF + wr * 64 + m * 16 + fr, row = u.pm * BM + lrow, b = row >> 11, t = row & 2047;
                const float rs = R.get(slot, lrow);
                f32x4 v[2][2];
#pragma unroll
                for (int bj = 0; bj < 2; ++bj)
#pragma unroll
                    for (int n = 0; n < 2; ++n) v[bj][n] = acc[ai][bj][m][n] * rs;
                if (kind < 2) {
#pragma unroll
                    for (int which = 0; which < 2; ++which) { const int c = (t >> 4) - which, l = (t & 15) + 16 * which;
                        if (c >= 0 && c < NCMP) { bf16_t* dst = BLK + ((size_t)kind * 16384 + (size_t)(b * NCMP + c) * 4 + g) * 2048 + l * 64;
#pragma unroll
                            for (int bj = 0; bj < 2; ++bj) { const int d0 = 32 * bj + 8 * fq; const LAS float* pp = pos + (kind * 32 + l) * 64 + d0;
                                const f32x4 p0 = *(const LAS f32x4*)pp, p1 = *(const LAS f32x4*)(pp + 4); const f32x4 x0 = v[bj][0] + p0, x1 = v[bj][1] + p1;
                                u32x4 o; o.x = cvt_pk_bf16(x0[0], x0[1]); o.y = cvt_pk_bf16(x0[2], x0[3]); o.z = cvt_pk_bf16(x1[0], x1[1]); o.w = cvt_pk_bf16(x1[2], x1[3]);
                                *(u32x4*)(dst + d0) = o; } } }
                } else if ((kind & 1) == 0) {
                    float ss = 0.f;
#pragma unroll
                    for (int bj = 0; bj < 2; ++bj)
#pragma unroll
                        for (int n = 0; n < 2; ++n) ss += (v[bj][n][0] * v[bj][n][0] + v[bj][n][1] * v[bj][n][1]) + (v[bj][n][2] * v[bj][n][2] + v[bj][n][3] * v[bj][n][3]);
                    ss += __shfl_xor(ss, 16); ss += __shfl_xor(ss, 32);
                    const float rn = __builtin_amdgcn_rsqf(ss * (1.f / 64.f) + EPS);
                    const int kk = t & 63; bf16_t* tile = KF + (((size_t)(w - 1) * 128 + b * 4 + g) * 32 + (t >> 6)) * 4096;
#pragma unroll
                    for (int bj = 0; bj < 2; ++bj) { const int d0 = 32 * bj + 8 * fq; const LAS float* gp = gain + w * 64 + d0;
                        const f32x4 g0 = *(const LAS f32x4*)gp, g1 = *(const LAS f32x4*)(gp + 4); const f32x4 x0 = v[bj][0] * rn * g0, x1 = v[bj][1] * rn * g1;
                        u32x4 o; o.x = cvt_pk_bf16(x0[0], x0[1]); o.y = cvt_pk_bf16(x0[2], x0[3]); o.z = cvt_pk_bf16(x1[0], x1[1]); o.w = cvt_pk_bf16(x1[2], x1[3]);
                        *(u32x4*)(tile + (((kk >> 5) * 4 + (d0 >> 4)) * 64 + ((d0 >> 3) & 1) * 32 + (kk & 31)) * 8) = o; }
                } else {
                    const int kk = t & 63, ps = vt_pos_(kk); bf16_t* tile = VF + (((size_t)(w - 1) * 128 + b * 4 + g) * 32 + (t >> 6)) * 4096 + (((ps >> 4) * 2) * 64 + ((ps >> 3) & 1) * 32) * 8 + (ps & 7);
#pragma unroll
                    for (int bj = 0; bj < 2; ++bj)
#pragma unroll
                        for (int n = 0; n < 2; ++n)
#pragma unroll
                            for (int jj = 0; jj < 4; ++jj) { const int cc = 8 * fq + 4 * n + jj;
                                tile[(bj * 64 + cc) * 8] = (bf16_t)(cvt_pk_bf16(v[bj][n][jj], 0.f) & 0xffffu); }
                } }
    }
};
struct EpiQG {
    static constexpr bool PERM = true, PRE = true; static constexpr int NSTORE = 0;
    RowScale R; bf16_t* Q; int ldq; const LAS float* gain; float qscale;
    __device__ __forceinline__ void pre_dma(const Unit& u, int slot, int wid, int lane) const { R.pre_dma(u, slot, wid, lane); }
    __device__ __forceinline__ void operator()(const f32x4 (&acc)[2][2][4][2], const Unit& u, int wr, int wc, int fr, int fq, int slot) const {
#pragma unroll
        for (int ai = 0; ai < 2; ++ai)
#pragma unroll
            for (int m = 0; m < 4; ++m) {
                const int lrow = ai * HALF + wr * 64 + m * 16 + fr, row = u.pm * BM + lrow;
                const float rs = R.get(slot, lrow);
                f32x4 v[2][2];
#pragma unroll
                for (int bj = 0; bj < 2; ++bj)
#pragma unroll
                    for (int n = 0; n < 2; ++n) v[bj][n] = acc[ai][bj][m][n] * rs;
                if (u.pn < 4) {
                    float ss = 0.f;
#pragma unroll
                    for (int bj = 0; bj < 2; ++bj)
#pragma unroll
                        for (int n = 0; n < 2; ++n) ss += (v[bj][n][0] * v[bj][n][0] + v[bj][n][1] * v[bj][n][1]) + (v[bj][n][2] * v[bj][n][2] + v[bj][n][3] * v[bj][n][3]);
                    ss += __shfl_xor(ss, 16); ss += __shfl_xor(ss, 32);
                    const float rn = qscale * __builtin_amdgcn_rsqf(ss * (1.f / 64.f) + EPS);
                    bf16_t* dst = Q + (size_t)row * ldq + (4 * u.pn + wc) * 64;
#pragma unroll
                    for (int bj = 0; bj < 2; ++bj) { const int d0 = 32 * bj + 8 * fq; const LAS float* gp = gain + d0;
                        const f32x4 g0 = *(const LAS f32x4*)gp, g1 = *(const LAS f32x4*)(gp + 4); const f32x4 x0 = v[bj][0] * rn * g0, x1 = v[bj][1] * rn * g1;
                        u32x4 o; o.x = cvt_pk_bf16(x0[0], x0[1]); o.y = cvt_pk_bf16(x0[2], x0[3]); o.z = cvt_pk_bf16(x1[0], x1[1]); o.w = cvt_pk_bf16(x1[2], x1[3]);
                        *(u32x4*)(dst + d0) = o; }
                } else {
#pragma unroll
                    for (int bj = 0; bj < 2; ++bj) { const int o0 = 64 * wc + 32 * bj + 8 * fq;
                        if (o0 < 48) { u32x4 o; o.x = cvt_pk_bf16(v[bj][0][0], v[bj][0][1]); o.y = cvt_pk_bf16(v[bj][0][2], v[bj][0][3]); o.z = cvt_pk_bf16(v[bj][1][0], v[bj][1][1]); o.w = cvt_pk_bf16(v[bj][1][2], v[bj][1][3]);
                            *(u32x4*)(Q + (size_t)row * ldq + 1024 + o0) = o; } }
                } }
    }
};

struct EpiCmp2 {
    static constexpr bool PERM = true, PRE = false; static constexpr int NSTORE = 0;
    float* CMP;
    __device__ __forceinline__ void pre_dma(const Unit&, int, int, int) const {}
    __device__ __forceinline__ void operator()(const f32x4 (&acc)[2][2][4][2], const Unit& u, int wr, int wc, int fr, int fq, int) const {
        if (wc != 0) return;
#pragma unroll
        for (int ai = 0; ai < 2; ++ai)
#pragma unroll
            for (int m = 0; m < 4; ++m) { float* rowp = CMP + (size_t)(u.pm * BM + ai * HALF + wr * 64 + m * 16 + fr) * 64 + 8 * fq;
#pragma unroll
                for (int bj = 0; bj < 2; ++bj) { *(f32x4*)(rowp + 32 * bj) = acc[ai][bj][m][0]; *(f32x4*)(rowp + 32 * bj + 4) = acc[ai][bj][m][1]; } }
    }
};

struct NoHook { static constexpr bool ON = false; __device__ __forceinline__ void operator()() const {} };
template <class Epi, class Sched, class Hook = NoHook, bool ATILED = false, bool FP8 = false>
__device__ __forceinline__ void gemm_phase(LAS unsigned char* lds, const Gemm g, const Sched& S, const Epi& E, const Hook hook = Hook()) {
    const int tid = opaque_tid(), wid = __builtin_amdgcn_readfirstlane(tid >> 6), lane = tid & 63, wr = wid >> 2, wc = wid & 3, fr = lane & 15, fq = lane >> 4;
    int nt = g.K / BK; asm volatile("" : "+s"(nt));
    unsigned voffA[2], voffB[2];
#pragma unroll
    for (int i = 0; i < 2; ++i) { int R, C; stage_rc(tid * 16 + i * 8192, R, C); const int Rb = Epi::PERM ? ((R & ~31) + perm32(R & 31)) : R;
        voffA[i] = ATILED ? (unsigned)((((R >> 4) * (g.lda >> 5) + (C >> 5)) << 10) + (R & 15) * 64 + (C & 31) * 2) : (unsigned)(R * g.lda + C) * 2u;
        static_assert(Epi::PERM, "the converted weights are stored in the PERM row order"); (void)Rb;
        voffB[i] = (unsigned)((((R >> 4) * (g.ldb >> 5) + (C >> 5)) << 10) + (R & 15) * 64 + (C & 31) * 2); }
    const size_t voffA_step = ATILED ? (size_t)4 * (g.lda >> 5) * 1024 : (size_t)64 * g.lda * 2, voffB_step = (size_t)4 * (g.ldb >> 5) * 1024;
    const size_t kstep = (size_t)2048, kstepA = ATILED ? (size_t)2048 : (size_t)(BK * 2);
    const size_t hstepA = ATILED ? (size_t)(HALF / 16) * (g.lda >> 5) * 1024 : (size_t)HALF * g.lda * 2, hstepB = (size_t)(HALF / 16) * (g.ldb >> 5) * 1024;
    const unsigned ldsw = (unsigned)wid * 1024u;
    const int lanep = lds_byte(fr, fq * 8), aoffs = wr * 8192, boffs = wc * 4096;
#define aoff (__extension__({ int o_ = lanep; asm volatile("" : "+v"(o_)); o_ + aoffs; }))
#define boff (__extension__({ int o_ = lanep; asm volatile("" : "+v"(o_)); o_ + boffs; }))
#define PG8_SA(b, h) (((b) * 2 + (h)) * HTB)
#define PG8_SB(b, h) ((4 + (b) * 2 + (h)) * HTB)
#define PG8_STAGE(bufoff, gbase, voff) do { _Pragma("unroll") for (int _i = 0; _i < 2; ++_i) \
        { unsigned vo_ = (voff)[0]; asm volatile("" : "+v"(vo_)); __builtin_amdgcn_global_load_lds((const unsigned*)((const char*)(gbase) + _i * voff##_step + vo_), (LAS unsigned*)(lds + (bufoff) + ldsw + _i * 8192), 16, 0, 0); } } while (0)
#define PG8_LDA(dst, b, h) do { const int aoff_ = aoff; _Pragma("unroll") for (int m = 0; m < 4; ++m) { \
        if constexpr (FP8) { const v4i32 l_ = *(const LAS v4i32*)(lds + PG8_SA(b, h) + aoff_ + m * 2048), h_ = *(const LAS v4i32*)(lds + PG8_SA(b, h) + aoff_ + m * 2048 + 1024); dst##8[m] = __builtin_shufflevector(l_, h_, 0, 1, 2, 3, 4, 5, 6, 7); } \
        else { _Pragma("unroll") for (int k = 0; k < 2; ++k) dst[m][k] = *(const LAS bf16x8*)(lds + PG8_SA(b, h) + aoff_ + m * 2048 + k * 1024); } } } while (0)
#define PG8_LDB(dst, b, h) do { const int boff_ = boff; _Pragma("unroll") for (int n = 0; n < 2; ++n) { \
        if constexpr (FP8) { const v4i32 l_ = *(const LAS v4i32*)(lds + PG8_SB(b, h) + boff_ + n * 2048), h_ = *(const LAS v4i32*)(lds + PG8_SB(b, h) + boff_ + n * 2048 + 1024); dst##8[n] = __builtin_shufflevector(l_, h_, 0, 1, 2, 3, 4, 5, 6, 7); } \
        else { _Pragma("unroll") for (int k = 0; k < 2; ++k) dst[n][k] = *(const LAS bf16x8*)(lds + PG8_SB(b, h) + boff_ + n * 2048 + k * 1024); } } } while (0)
#define PG8_MMA(ai, bj, At, Bt) do { __builtin_amdgcn_s_setprio(1); _Pragma("unroll") for (int m = 0; m < 4; ++m) _Pragma("unroll") for (int n = 0; n < 2; ++n) { \
        if constexpr (FP8) { acc[ai][bj][m][n] = __builtin_amdgcn_mfma_scale_f32_16x16x128_f8f6f4(Bt##8[n], At##8[m], acc[ai][bj][m][n], 0, 0, 0, 0x7f7f7f7f, 0, 0x7f7f7f7f); } \
        else { _Pragma("unroll") for (int k = 0; k < 2; ++k) acc[ai][bj][m][n] = __builtin_amdgcn_mfma_f32_16x16x32_bf16(Bt[n][k], At[m][k], acc[ai][bj][m][n], 0, 0, 0); } } \
        __builtin_amdgcn_s_setprio(0); } while (0)
#define PG8_WAIT_V(n) asm volatile("s_waitcnt vmcnt(" #n ")" ::: "memory")
#define PG8_WAIT_L(n) asm volatile("s_waitcnt lgkmcnt(" #n ")" ::: "memory")
#define PG8_BAR __builtin_amdgcn_s_barrier()
#define PG8_SCHED __builtin_amdgcn_sched_barrier(0)
    Unit cur, nxt; int ui = 0;
    static_assert(Epi::NSTORE == 0 || Epi::NSTORE == 8, "the relaxed waits are written for 8 epilogue stores");
    if (!S.next(0, cur)) { if constexpr (Hook::ON) hook(); return; }
    f32x4 acc[2][2][4][2];
#pragma unroll
    for (int a = 0; a < 2; ++a)
#pragma unroll
        for (int b = 0; b < 2; ++b)
#pragma unroll
            for (int m = 0; m < 4; ++m)
#pragma unroll
                for (int n = 0; n < 2; ++n) acc[a][b][m][n] = (f32x4){0.f, 0.f, 0.f, 0.f};
    bf16x8 At[4][2], B0[2][2], B1[2][2]; v8i32 At8[4], B08[2], B18[2];
    const char* cA = S.a_tile(cur); const char* cB = S.b_tile(cur);
    if constexpr (Epi::PRE) E.pre_dma(cur, 0, wid, lane);
    PG8_STAGE(PG8_SB(0, 0), cB, voffB); PG8_STAGE(PG8_SB(0, 1), cB + hstepB, voffB); PG8_STAGE(PG8_SA(0, 0), cA, voffA); PG8_STAGE(PG8_SA(0, 1), cA + hstepA, voffA);
    if (wr == 1) PG8_BAR;
    PG8_WAIT_V(2); PG8_BAR;
    PG8_STAGE(PG8_SB(1, 0), cB + kstep, voffB); PG8_STAGE(PG8_SA(1, 0), cA + kstepA, voffA); PG8_STAGE(PG8_SB(1, 1), cB + hstepB + kstep, voffB);
    PG8_WAIT_V(6); PG8_BAR;
    if constexpr (Epi::NSTORE == 8) {
        PG8_STAGE(PG8_SA(1, 1), cA + kstepA + hstepA, voffA);
        unsigned* dz = E.dummy() + tid;
#pragma unroll
        for (int i = 0; i < 8; ++i) __builtin_nontemporal_store(0u, dz + i * 512); }
    for (;;) {
        const bool has_next = S.next(ui + 1, nxt);
        const char* nA = has_next ? S.a_tile(nxt) : cA; const char* nB = has_next ? S.b_tile(nxt) : cB;
        int t = 0;
        if constexpr (Epi::NSTORE == 8) {
            const bool last = (t == nt - 2);
            const char* a2 = last ? nA : cA + (size_t)(t + 2) * kstepA; const char* b2 = last ? nB : cB + (size_t)(t + 2) * kstep;
            const char* a3 = a2 + kstepA; const char* b3 = b2 + kstep;
            if constexpr (Epi::PRE) { if (last && has_next) E.pre_dma(nxt, (ui + 1) & 1, wid, lane); }
            PG8_LDB(B0, 0, 0); PG8_LDB(B1, 0, 1); PG8_SCHED; PG8_LDA(At, 0, 0);
            PG8_WAIT_V(16); PG8_WAIT_L(0); PG8_BAR; PG8_MMA(0, 0, At, B0); PG8_MMA(0, 1, At, B1); PG8_BAR; PG8_SCHED;
            PG8_LDA(At, 0, 1); PG8_STAGE(PG8_SB(0, 0), b2, voffB); PG8_STAGE(PG8_SB(0, 1), b2 + hstepB, voffB); PG8_STAGE(PG8_SA(0, 0), a2, voffA);
            PG8_WAIT_V(16); PG8_WAIT_L(0); PG8_BAR; PG8_MMA(1, 0, At, B0); PG8_MMA(1, 1, At, B1); PG8_BAR; PG8_SCHED;
            PG8_LDB(B0, 1, 0); PG8_LDB(B1, 1, 1); PG8_SCHED; PG8_LDA(At, 1, 0); PG8_STAGE(PG8_SA(0, 1), a2 + hstepA, voffA);
            PG8_WAIT_V(16); PG8_WAIT_L(0); PG8_BAR; PG8_MMA(0, 0, At, B0); PG8_MMA(0, 1, At, B1); PG8_BAR; PG8_SCHED;
            PG8_LDA(At, 1, 1); PG8_STAGE(PG8_SB(1, 0), b3, voffB); PG8_STAGE(PG8_SB(1, 1), b3 + hstepB, voffB); PG8_STAGE(PG8_SA(1, 0), a3, voffA);
            PG8_WAIT_V(8); PG8_WAIT_L(0); PG8_BAR; PG8_MMA(1, 0, At, B0); PG8_MMA(1, 1, At, B1); PG8_BAR; PG8_SCHED;
            t = 2; }
        for (; t < nt; t += 2) {
            const bool last = (t == nt - 2);
            const char* a1 = cA + (size_t)(t + 1) * kstepA;
            const char* a2 = last ? nA : cA + (size_t)(t + 2) * kstepA; const char* b2 = last ? nB : cB + (size_t)(t + 2) * kstep;
            const char* a3 = a2 + kstepA; const char* b3 = b2 + kstep;
            if constexpr (Epi::PRE) { if (last && has_next) E.pre_dma(nxt, (ui + 1) & 1, wid, lane); }
            PG8_LDB(B0, 0, 0); PG8_LDB(B1, 0, 1); PG8_SCHED; PG8_LDA(At, 0, 0); PG8_STAGE(PG8_SA(1, 1), a1 + hstepA, voffA);
            PG8_WAIT_V(8); PG8_WAIT_L(0); PG8_BAR; PG8_MMA(0, 0, At, B0); PG8_MMA(0, 1, At, B1); PG8_BAR; PG8_SCHED;
            PG8_LDA(At, 0, 1); PG8_STAGE(PG8_SB(0, 0), b2, voffB); PG8_STAGE(PG8_SB(0, 1), b2 + hstepB, voffB); PG8_STAGE(PG8_SA(0, 0), a2, voffA);
            PG8_WAIT_V(8); PG8_WAIT_L(0); PG8_BAR; PG8_MMA(1, 0, At, B0); PG8_MMA(1, 1, At, B1); PG8_BAR; PG8_SCHED;
            PG8_LDB(B0, 1, 0); PG8_LDB(B1, 1, 1); PG8_SCHED; PG8_LDA(At, 1, 0); PG8_STAGE(PG8_SA(0, 1), a2 + hstepA, voffA);
            PG8_WAIT_V(8); PG8_WAIT_L(0); PG8_BAR; PG8_MMA(0, 0, At, B0); PG8_MMA(0, 1, At, B1); PG8_BAR; PG8_SCHED;
            PG8_LDA(At, 1, 1); PG8_STAGE(PG8_SB(1, 0), b3, voffB); PG8_STAGE(PG8_SB(1, 1), b3 + hstepB, voffB); PG8_STAGE(PG8_SA(1, 0), a3, voffA);
            PG8_WAIT_V(8); PG8_WAIT_L(0); PG8_BAR; PG8_MMA(1, 0, At, B0); PG8_MMA(1, 1, At, B1); PG8_BAR; PG8_SCHED;
        }
        if (wr == 0) PG8_BAR;
        if constexpr (Hook::ON) { if (ui == 0) hook(); }
        if constexpr (Epi::NSTORE == 8) {
            if (has_next) PG8_STAGE(PG8_SA(1, 1), nA + kstepA + hstepA, voffA); }
        { const int tz = opaque_tid(), lz = tz & 63;
          E(acc, cur, wr, wc, lz & 15, lz >> 4, ui & 1); }
        if (!has_next) break;
#pragma unroll
        for (int a = 0; a < 2; ++a)
#pragma unroll
            for (int b = 0; b < 2; ++b)
#pragma unroll
                for (int m = 0; m < 4; ++m)
#pragma unroll
                    for (int n = 0; n < 2; ++n) acc[a][b][m][n] = (f32x4){0.f, 0.f, 0.f, 0.f};
        cur = nxt; cA = nA; cB = nB; ++ui;
        if (wr == 1) PG8_BAR;
    }
    PG8_WAIT_V(0);
    PG8_BAR;
#undef PG8_SA
#undef PG8_SB
#undef PG8_STAGE
#undef PG8_LDA
#undef PG8_LDB
#undef PG8_MMA
#undef PG8_WAIT_V
#undef PG8_WAIT_L
#undef PG8_BAR
#undef PG8_SCHED
#undef aoff
#undef boff
}
}

#define XB_TMO      128
#define XB_XCNT(j)  (256  + 64 * (j))
#define XB_XSUB(j)  (1280 + 64 * (j))
#define XB_XGEN(j)  (2304 + 64 * (j))
#define XB_TOP      3328
#define XB_TOPGEN   3392
#define XCD_BAR_WORDS 3456
#define XB_SPIN_CAP (1u << 22)
__device__ __forceinline__ unsigned xb_ld(unsigned* p)              { return __hip_atomic_load(p, __ATOMIC_RELAXED, __HIP_MEMORY_SCOPE_AGENT); }
__device__ __forceinline__ unsigned xb_add(unsigned* p, unsigned v) { return __hip_atomic_fetch_add(p, v, __ATOMIC_RELAXED, __HIP_MEMORY_SCOPE_AGENT); }
__device__ __forceinline__ unsigned xb_xcc_id() { return (unsigned)__builtin_amdgcn_s_getreg((3 << 11) | 20) & 0xFu; }
#define XB_SPIN(cond, bar) do { unsigned _sp = 0; while (cond) { __builtin_amdgcn_s_sleep(1); \
    if ((++_sp & 255u) == 0u) { if (xb_ld(&(bar)[XB_TMO])) break; if (_sp > XB_SPIN_CAP) { atomicAdd(&(bar)[XB_TMO], 1u); break; } } } } while (0)
struct XcdBarrier { unsigned* bar; unsigned x; volatile LAS unsigned* st; };
__device__ __forceinline__ XcdBarrier xcd_barrier_post(unsigned* bar, volatile LAS unsigned* st) {
    XcdBarrier b; b.bar = bar; b.x = xb_xcc_id(); b.st = st;
    if (threadIdx.x == 0) (void)xb_add(&bar[XB_XCNT(b.x)], 1u);
    return b;
}
__device__ __forceinline__ void xcd_barrier_complete(unsigned* bar, unsigned x, unsigned& nloc, unsigned& nx) {
    const unsigned G = gridDim.x * gridDim.y * gridDim.z;
    unsigned sum, cnt, mine, sp = 0u;
    for (;;) {
        sum = 0u; cnt = 0u; mine = 0u;
#pragma unroll
        for (unsigned j = 0; j < 16; ++j) { const unsigned c = xb_ld(&bar[XB_XCNT(j)]); sum += c; cnt += (c > 0u) ? 1u : 0u; mine = (j == x) ? c : mine; }
        if (sum == G) break;
        __builtin_amdgcn_s_sleep(1);
        if ((++sp & 255u) == 0u) { if (xb_ld(&bar[XB_TMO])) break; if (sp > XB_SPIN_CAP) { atomicAdd(&bar[XB_TMO], 1u); break; } }
    }
    nloc = mine > 0u ? mine : 1u; nx = cnt > 0u ? cnt : 1u;
}
__device__ __forceinline__ void xcd_barrier(const XcdBarrier& b) {
    asm volatile("s_waitcnt vmcnt(0)" ::: "memory");
    __syncthreads();
    if (threadIdx.x == 0) {
        unsigned* bar = b.bar;
        __builtin_amdgcn_s_waitcnt(0);
        unsigned nloc = b.st[0], nx = b.st[1];
        if (nloc == 0u) { xcd_barrier_complete(bar, b.x, nloc, nx); b.st[0] = nloc; b.st[1] = nx; }
        const unsigned old = xb_add(&bar[XB_XSUB(b.x)], 1u);
        const unsigned gen = old / nloc;
        if (old + 1u == (gen + 1u) * nloc) {
            __builtin_amdgcn_fence(__ATOMIC_RELEASE, "agent");
            asm volatile("s_waitcnt vmcnt(0)" ::: "memory");
            const unsigned og = xb_add(&bar[XB_TOP], 1u);
            const unsigned tg = og / nx;
            if (og + 1u == (tg + 1u) * nx) xb_add(&bar[XB_TOPGEN], 1u);
            else XB_SPIN(xb_ld(&bar[XB_TOPGEN]) == tg, bar);
            __builtin_amdgcn_fence(__ATOMIC_ACQUIRE, "agent");
            xb_add(&bar[XB_XGEN(b.x)], 1u);
            asm volatile("s_waitcnt vmcnt(0)" ::: "memory");
        } else {
            XB_SPIN((int)(xb_ld(&bar[XB_XGEN(b.x)]) - (gen + 1u)) < 0, bar);
            __builtin_amdgcn_fence(__ATOMIC_ACQUIRE, "agent");
            asm volatile("s_waitcnt vmcnt(0)" ::: "memory");
        }
    }
    __syncthreads();
}
__device__ __forceinline__ void xcd_arrive(const XcdBarrier& b) {
    asm volatile("s_waitcnt vmcnt(0)" ::: "memory");
    __syncthreads();
    if (threadIdx.x == 0) {
        unsigned* bar = b.bar;
        __builtin_amdgcn_s_waitcnt(0);
        unsigned nloc = b.st[0], nx = b.st[1];
        if (nloc == 0u) { xcd_barrier_complete(bar, b.x, nloc, nx); b.st[0] = nloc; b.st[1] = nx; }
        const unsigned old = xb_add(&bar[XB_XSUB(b.x)], 1u);
        const unsigned gen = old / nloc;
        unsigned leader = 0u;
        if (old + 1u == (gen + 1u) * nloc) {
            leader = 1u;
            __builtin_amdgcn_fence(__ATOMIC_RELEASE, "agent");
            asm volatile("s_waitcnt vmcnt(0)" ::: "memory");
            const unsigned og = xb_add(&bar[XB_TOP], 1u);
            const unsigned tg = og / nx;
            if (og + 1u == (tg + 1u) * nx) xb_add(&bar[XB_TOPGEN], 1u);
        }
        b.st[2] = gen; b.st[3] = leader;
    }
}
__device__ __forceinline__ void xcd_wait_arrived(const XcdBarrier& b) {
    if (threadIdx.x == 0) {
        unsigned* bar = b.bar; const unsigned gen = b.st[2], leader = b.st[3];
        XB_SPIN((int)(xb_ld(&bar[XB_TOPGEN]) - (gen + 1u)) < 0, bar);
        __builtin_amdgcn_fence(__ATOMIC_ACQUIRE, "agent");
        if (leader) xb_add(&bar[XB_XGEN(b.x)], 1u);
        asm volatile("s_waitcnt vmcnt(0)" ::: "memory");
    }
    __syncthreads();
}

constexpr size_t CTL_GRP = 32 * 1024, CTL_XMASK = 36 * 1024;
__device__ __forceinline__ void group_barrier(const XcdBarrier& b, int cid) {
    asm volatile("s_waitcnt vmcnt(0)" ::: "memory");
    __syncthreads();
    if (threadIdx.x == 0) {
        unsigned* bar = b.bar; const unsigned* xm = bar + CTL_XMASK / 4; unsigned ok = (gridDim.x == 256u) ? 1u : 0u;
#pragma unroll
        for (int j = 0; j < 8; ++j) { const unsigned mk = xb_ld((unsigned*)&xm[j]); ok &= (mk != 0u && (mk & (mk - 1u)) == 0u) ? 1u : 0u; }
        b.st[4] = ok;
        if (ok) {
            unsigned* cnt = bar + CTL_GRP / 4 + (cid & 7) * 64;
            __builtin_amdgcn_s_waitcnt(0);
            const unsigned old = xb_add(cnt, 1u), target = (old / 32u + 1u) * 32u;
            XB_SPIN((int)(xb_ld(cnt) - target) < 0, bar);
            __builtin_amdgcn_fence(__ATOMIC_ACQUIRE, "agent");
            asm volatile("s_waitcnt vmcnt(0)" ::: "memory");
        }
    }
    __syncthreads();
    if (!b.st[4]) xcd_barrier(b);
}
struct WaitHook { static constexpr bool ON = true; bool on; unsigned* bar; volatile LAS unsigned* st;
    __device__ __forceinline__ void operator()() const { if (on) { XcdBarrier bw; bw.bar = bar; bw.x = xb_xcc_id(); bw.st = st; xcd_wait_arrived(bw); } } };

constexpr int NWAVES = 8, NTHREADS = 512;
constexpr int RING_BYTES = 131072, MISC_OFF = RING_BYTES, LDS_BYTES = 163840;
constexpr int LX_P = 1024, LX_SQ = 5120, LX_GAIN = 13312, LX_POS = 16384;

struct Args { const float* in[22]; float* out; unsigned char* ws; int ph_lo, ph_hi; };
enum { I_X = 0, I_RELB, I_NMIX, I_NFFN, I_POOLW, I_POOLS, I_NKV, I_WKV, I_GK, I_CPOS, I_CW1, I_CW2, I_WQG, I_GQ, I_WO, I_FWG, I_FWU, I_FWD, I_ROUTER, I_MWG, I_MWU, I_MWD };

__device__ __forceinline__ void cvt_item(const float* src, int ld, int nvalid, const float* rowgain, const float* colscale, bf16_t* dst, int K, int k0, LAS float* scr, int lane, bool f8 = false) {
    { const int q = lane & 7, r = lane >> 3;
      f32x4 v[8];
#pragma unroll
      for (int i = 0; i < 8; ++i) { const int kk = 8 * i + r; v[i] = (f32x4){0.f, 0.f, 0.f, 0.f};
          if (4 * q < nvalid) { v[i] = *(const f32x4*)(src + (size_t)(k0 + kk) * ld + 4 * q); if (rowgain) v[i] *= rowgain[k0 + kk]; } }
#pragma unroll
      for (int i = 0; i < 8; ++i) { LAS float* d = scr + (8 * i + r) * 33 + 4 * q; d[0] = v[i].x; d[1] = v[i].y; d[2] = v[i].z; d[3] = v[i].w; } }
    asm volatile("s_waitcnt lgkmcnt(0)" ::: "memory");
    const int c = lane & 7;
#pragma unroll
    for (int j = 0; j < 4; ++j) { const int n = (lane >> 3) + 8 * j; const LAS float* s = scr + (8 * c) * 33 + n;
        const float cs = (colscale && n < nvalid) ? colscale[n] : 1.f;
        u32x4 o; o.x = pk2(s[0 * 33] * cs, s[1 * 33] * cs); o.y = pk2(s[2 * 33] * cs, s[3 * 33] * cs); o.z = pk2(s[4 * 33] * cs, s[5 * 33] * cs); o.w = pk2(s[6 * 33] * cs, s[7 * 33] * cs);
        const int np = 16 * ((n >> 2) & 1) + (((n >> 3) << 2) | (n & 3)), kc = k0 + 8 * c;
        if (!f8) *(u32x4*)((char*)dst + ((size_t)((np >> 4) * (K >> 5) + (kc >> 5)) << 10) + (np & 15) * 64 + (kc & 31) * 2) = o;
        else { const float ws = cs * pg8::F8_WS;
            int lo = __builtin_amdgcn_cvt_pk_fp8_f32(s[0 * 33] * ws, s[1 * 33] * ws, 0, false); lo = __builtin_amdgcn_cvt_pk_fp8_f32(s[2 * 33] * ws, s[3 * 33] * ws, lo, true);
            int hi = __builtin_amdgcn_cvt_pk_fp8_f32(s[4 * 33] * ws, s[5 * 33] * ws, 0, false); hi = __builtin_amdgcn_cvt_pk_fp8_f32(s[6 * 33] * ws, s[7 * 33] * ws, hi, true);
            *(u32x2*)((char*)dst + ((size_t)((np >> 4) * (K >> 6) + (kc >> 6)) << 10) + (np & 15) * 64 + (kc & 63)) = (u32x2){(unsigned)lo, (unsigned)hi}; } }
    asm volatile("s_waitcnt lgkmcnt(0)" ::: "memory");
}
__device__ __forceinline__ void cvt_plain(const float* src, int K, int N, const float* rowgain, const float* colscale, bf16_t* dst, int item, LAS float* scr, int lane, bool f8 = false) {
    const int nblk = N / 32, kb = item / nblk, nb = item % nblk;
    cvt_item(src + nb * 32, N, 32, rowgain, colscale ? colscale + nb * 32 : nullptr, f8 ? (bf16_t*)((char*)dst + (size_t)nb * 32 * K) : dst + (size_t)nb * 32 * K, K, kb * 64, scr, lane, f8);
}
__device__ __forceinline__ void cvt_gu(const float* wg, const float* wu, const float* rowgain, bf16_t* dst, int item, LAS float* scr, int lane, bool f8 = false) {
    constexpr int nblk = 7168 / 32; const int kb = item / nblk, nb = item % nblk, np = nb * 32, p = np >> 8, b = (np >> 7) & 1, j0 = np & 127;
    cvt_item((b ? wu : wg) + p * 128 + j0, FFD, 32, rowgain, nullptr, f8 ? (bf16_t*)((char*)dst + (size_t)np * DM) : dst + (size_t)np * DM, DM, kb * 64, scr, lane, f8);
}
__device__ __forceinline__ void cvt_qg(const float* w, const float* rowgain, bf16_t* dst, int item, LAS float* scr, int lane) {
    constexpr int nblk = 1280 / 32; const int kb = item / nblk, nb = item % nblk, np = nb * 32;
    int nvalid = 1072 - np; nvalid = nvalid < 0 ? 0 : (nvalid > 32 ? 32 : nvalid);
    cvt_item(w + np, 1072, nvalid, rowgain, nullptr, dst + (size_t)np * DM, DM, kb * 64, scr, lane);
}
__device__ __forceinline__ void cvt_headperm(const float* w, int ld, int ncols, const float* rowgain, bf16_t* dst, int K, int nblk, int item, LAS float* scr, int lane) {
    const int kb = item / nblk, nb = item % nblk, np = nb * 32, tile = np >> 8, bj = (np >> 7) & 1, wc = (np >> 5) & 3, o = tile * 256 + 64 * wc + 32 * bj;
    int nvalid = ncols - o; nvalid = nvalid < 0 ? 0 : (nvalid > 32 ? 32 : nvalid);
    cvt_item(w + o, ld, nvalid, rowgain, nullptr, dst + (size_t)np * K, K, kb * 64, scr, lane);
}
constexpr int IT_POOL = 8 * 32, IT_GU = 16 * 224, IT_D = 56 * 32, IT_KV = 16 * 48, IT_QG = 16 * 40, IT_O = 16 * 32, IT_C1 = 32 * 8;
constexpr int IT_C2 = 4 * 8;
constexpr int IT_STATIC = IT_POOL + 2 * IT_GU + 2 * IT_D + IT_KV + 2 * IT_QG + 2 * IT_O + 2 * IT_C1 + 2 * IT_C2;
__device__ __forceinline__ void p_convert_static(const Args& a, LAS unsigned char* lds) {
    const int tz = opaque_tid(), lane = tz & 63, wave = tz >> 6;
    LAS float* scr = (LAS float*)(lds + wave * 16384);
    unsigned char* ws = a.ws;
    for (int it = blockIdx.x * NWAVES + wave; it < IT_STATIC; it += gridDim.x * NWAVES) {
        int r = it;
        if (r < IT_POOL) { const int mg = r / 32, L = mg >> 2, g = mg & 3;
            cvt_plain(a.in[I_POOLW] + (size_t)mg * 65536, 256, 256, a.in[I_NMIX] + L * DM + g * 256, a.in[I_POOLS] + L * DM + g * 256, (bf16_t*)(ws + W_POOL) + (size_t)mg * 65536, r % 32, scr, lane); continue; } r -= IT_POOL;
        if (r < 2 * IT_GU) { const int i = r / IT_GU;
            cvt_gu(a.in[I_FWG] + (size_t)i * DM * FFD, a.in[I_FWU] + (size_t)i * DM * FFD, a.in[I_NFFN] + (2 * i) * DM, (bf16_t*)(ws + W_GU) + (size_t)i * 7168 * DM, r % IT_GU, scr, lane); continue; } r -= 2 * IT_GU;
        if (r < 2 * IT_D) { const int i = r / IT_D;
            cvt_plain(a.in[I_FWD] + (size_t)i * FFD * DM, FFD, DM, nullptr, nullptr, (bf16_t*)(ws + W_D + (size_t)i * DM * FFD), r % IT_D, scr, lane, true); continue; } r -= 2 * IT_D;
        if (r < IT_KV) { cvt_headperm(a.in[I_WKV], 1536, 1536, a.in[I_NKV], (bf16_t*)(ws + W_KV), DM, 48, r, scr, lane); continue; } r -= IT_KV;
        if (r < 2 * IT_QG) { const int j = r / IT_QG;
            cvt_headperm(a.in[I_WQG] + (size_t)j * DM * 1072, 1072, 1072, a.in[I_NMIX] + (2 + j) * DM, (bf16_t*)(ws + W_QG) + (size_t)j * 1280 * DM, DM, 40, r % IT_QG, scr, lane); continue; } r -= 2 * IT_QG;
        if (r < 2 * IT_O) { const int j = r / IT_O;
            cvt_plain(a.in[I_WO] + (size_t)j * DM * DM, DM, DM, nullptr, nullptr, (bf16_t*)(ws + W_O) + (size_t)j * DM * DM, r % IT_O, scr, lane); continue; } r -= 2 * IT_O;
        if (r < 2 * IT_C1) { const int w = r / IT_C1;
            cvt_plain(a.in[I_CW1] + (size_t)w * 2048 * 256, 2048, 256, nullptr, nullptr, (bf16_t*)(ws + W_C1) + (size_t)w * 256 * 2048, r % IT_C1, scr, lane); continue; } r -= 2 * IT_C1;
        { const int w = r / IT_C2;
            cvt_headperm(a.in[I_CW2] + (size_t)w * 256 * 64, 64, 64, nullptr, (bf16_t*)(ws + W_C2) + (size_t)w * 256 * 256, 256, 8, r % IT_C2, scr, lane); }
    }
}
__device__ __forceinline__ void p_convert_moe(const Args& a, LAS unsigned char* lds, int l) {
    const int tz = opaque_tid(), lane = tz & 63, wave = tz >> 6;
    LAS float* scr = (LAS float*)(lds + wave * 16384);
    unsigned char* ws = a.ws;
    const float* gain = a.in[I_NFFN] + (2 * l + 1) * DM;
    constexpr int NIT = 8 * (IT_GU + IT_D);
    for (int it = blockIdx.x * NWAVES + wave; it < NIT; it += gridDim.x * NWAVES) {
        if (it < 8 * IT_GU) { const int e = it / IT_GU; const size_t wo = ((size_t)l * 8 + e) * DM * FFD;
            cvt_gu(a.in[I_MWG] + wo, a.in[I_MWU] + wo, gain, (bf16_t*)(ws + WS_WMOE + (size_t)e * 7168 * DM), it % IT_GU, scr, lane, true); }
        else { const int r = it - 8 * IT_GU, e = r / IT_D; const size_t wo = ((size_t)l * 8 + e) * FFD * DM;
            cvt_plain(a.in[I_MWD] + wo, FFD, DM, nullptr, nullptr, (bf16_t*)(ws + WMOE_D + (size_t)e * DM * FFD), r % IT_D, scr, lane, true); }
    }
}

__device__ __forceinline__ float row_load_rstd(const float* xrow, int lane, f32x4 (&v)[4]) {
    const f32x4* xr = (const f32x4*)xrow + lane; float s = 0.f;
#pragma unroll
    for (int j = 0; j < 4; ++j) { v[j] = xr[64 * j]; s += (v[j].x * v[j].x + v[j].y * v[j].y) + (v[j].z * v[j].z + v[j].w * v[j].w); }
    return 1.0f / sqrtf(wave_sum(s) * (1.f / DM) + EPS);
}
__device__ __forceinline__ void row_store_bf16(bf16_t* orow, int lane, const f32x4 (&v)[4], float sc) {
    unsigned long long* o8 = (unsigned long long*)orow + lane;
#pragma unroll
    for (int j = 0; j < 4; ++j) o8[64 * j] = (unsigned long long)pk2(v[j].x * sc, v[j].y * sc) | ((unsigned long long)pk2(v[j].z * sc, v[j].w * sc) << 32);
}
__device__ __forceinline__ void row_load8(const bf16_t* xrow, int lane, f32x4 (&v)[4]) {
#pragma unroll
    for (int j = 0; j < 2; ++j) ld8(xrow + 8 * lane + 512 * j, v[2 * j], v[2 * j + 1]);
}
__device__ __forceinline__ void row_store8(bf16_t* orow, int lane, const f32x4 (&v)[4], float sc) {
#pragma unroll
    for (int j = 0; j < 2; ++j) { u32x4 o; o.x = pk2(v[2 * j].x * sc, v[2 * j].y * sc); o.y = pk2(v[2 * j].z * sc, v[2 * j].w * sc); o.z = pk2(v[2 * j + 1].x * sc, v[2 * j + 1].y * sc); o.w = pk2(v[2 * j + 1].z * sc, v[2 * j + 1].w * sc);
        *(u32x4*)(orow + 8 * lane + 512 * j) = o; }
}
__device__ __forceinline__ void row_store_f8(unsigned char* orow, int lane, const f32x4 (&v)[4], float sc) {
#pragma unroll
    for (int j = 0; j < 2; ++j) { int lo = __builtin_amdgcn_cvt_pk_fp8_f32(v[2 * j].x * sc, v[2 * j].y * sc, 0, false); lo = __builtin_amdgcn_cvt_pk_fp8_f32(v[2 * j].z * sc, v[2 * j].w * sc, lo, true);
        int hi = __builtin_amdgcn_cvt_pk_fp8_f32(v[2 * j + 1].x * sc, v[2 * j + 1].y * sc, 0, false); hi = __builtin_amdgcn_cvt_pk_fp8_f32(v[2 * j + 1].z * sc, v[2 * j + 1].w * sc, hi, true);
        *(u32x2*)(orow + 8 * lane + 512 * j) = (u32x2){(unsigned)lo, (unsigned)hi}; }
}
__device__ __forceinline__ void p_norm(const float* x, bf16_t* XN) {
    const int tz = opaque_tid(), lane = tz & 63, gw = blockIdx.x * NWAVES + (tz >> 6), NGW = gridDim.x * NWAVES;
    for (int m = gw; m < NTOK; m += NGW) { f32x4 v[4]; const float r = row_load_rstd(x + (size_t)m * DM, lane, v); row_store_bf16(XN + (size_t)m * DM, lane, v, r); }
}
template <typename TX> __device__ __forceinline__ void p_pool_diff(const TX* x, const float* SSQ  , bf16_t* DIFF, LAS unsigned char* lds) {
    LAS float* rs = (LAS float*)lds;
    const int tid = opaque_tid(), lane = tid & 63, wave = tid >> 6;
    for (int tile = blockIdx.x; tile < NTOK / 128; tile += gridDim.x) {
        const int b = tile >> 4, t0 = (tile & 15) * 128; const TX* xb = x + (size_t)b * SEQ * DM;
        if (SSQ) { if (tid < 143) { const int t = t0 - 15 + tid; if (t >= 0) { const f32x4 p = *(const f32x4*)(SSQ + ((size_t)b * SEQ + t) * 4); rs[tid] = 1.0f / sqrtf(((p.x + p.y) + (p.z + p.w)) * (1.f / DM) + EPS); } } }
        else for (int i = wave; i < 143; i += NWAVES) { const int t = t0 - 15 + i; if (t >= 0) { float sq = 0.f;
#pragma unroll
                for (int j = 0; j < 4; ++j) { const f32x4 v = ld4(xb + (size_t)t * DM + 4 * lane + 256 * j); sq += (v.x * v.x + v.y * v.y) + (v.z * v.z + v.w * v.w); }
                const float r = 1.0f / sqrtf(wave_sum(sq) * (1.f / DM) + EPS); if (lane == 0) rs[i] = r; } }
        __syncthreads();
        const int q = tid >> 7, cq = tid & 127, g = cq >> 5, w = 2 << g, ts = t0 + 32 * q;
        const TX* xc = xb + 8 * cq;
        f32x4 sa = (f32x4){0.f, 0.f, 0.f, 0.f}, sb = sa;
        { f32x4 wa[15], wb[15];
#pragma unroll
          for (int i = 1; i < 16; ++i) { const int ii = i < w ? i : w - 1; int t = ts - ii; t = t < 0 ? 0 : t; ld8(xc + (size_t)t * DM, wa[i - 1], wb[i - 1]); }
#pragma unroll
          for (int i = 1; i < 16; ++i) { const int t = ts - i; const float r = (i < w && t >= 0) ? rs[t - t0 + 15] : 0.f; sa += wa[i - 1] * r; sb += wb[i - 1] * r; } }
        for (int tt0 = 0; tt0 < 32; tt0 += 4) {
            f32x4 na[4], nb[4], oa[4], ob[4];
#pragma unroll
            for (int j = 0; j < 4; ++j) { const int t = ts + tt0 + j; ld8(xc + (size_t)t * DM, na[j], nb[j]); int told = t + 1 - w; told = told < 0 ? 0 : told; ld8(xc + (size_t)told * DM, oa[j], ob[j]); }
#pragma unroll
            for (int j = 0; j < 4; ++j) { const int t = ts + tt0 + j;
                f32x4 ha = na[j], hb = nb[j]; { const float r = rs[t - t0 + 15]; ha *= r; hb *= r; }
                sa += ha; sb += hb;
                const int cnt = (t + 1 < w) ? (t + 1) : w; const float ic = __builtin_amdgcn_rcpf((float)cnt);
                const f32x4 da = sa * ic - ha, db = sb * ic - hb;
                u32x4 o; o.x = pk2(da.x, da.y); o.y = pk2(da.z, da.w); o.z = pk2(db.x, db.y); o.w = pk2(db.z, db.w);
                *(u32x4*)(DIFF + ((size_t)b * SEQ + t) * DM + 8 * cq) = o;
                const int told = t + 1 - w; const float ro = (told >= 0) ? rs[told - t0 + 15] : 0.f; sa -= oa[j] * ro; sb -= ob[j] * ro; } }
        __syncthreads();
    }
}
__device__ __forceinline__ void p_router_a(const Args& a, const bf16_t* x, int l, LAS unsigned char* lds) {
    LAS float* grT = (LAS float*)lds;
    LAS int* cnt = (LAS int*)(lds + 32768);
    const int tid = opaque_tid(), lane = tid & 63, wave = tid >> 6;
    const float* gain = a.in[I_NFFN] + (2 * l + 1) * DM; const float* router = a.in[I_ROUTER] + (size_t)l * DM * NEXP;
    for (int i = tid; i < DM * NEXP; i += NTHREADS) { const int k = i >> 3, e = i & 7; grT[e * DM + k] = gain[k] * router[i]; }
    int* RE = (int*)(a.ws + MS_RE); f32x2* RG = (f32x2*)(a.ws + MS_RG); float* RSTD = (float*)(a.ws + MS_RSTD); int* CNT = (int*)(a.ws + CTL_CNT);
    for (int tb = blockIdx.x; tb < NTOK / 256; tb += gridDim.x) {
        if (tid < 8) cnt[tid] = 0;
        __syncthreads();
        for (int i0 = wave * 4; i0 < 256; i0 += NWAVES * 4) {
            f32x4 v4[4][4];
#pragma unroll
            for (int q = 0; q < 4; ++q) row_load8(x + (size_t)(tb * 256 + i0 + q) * DM, lane, v4[q]);
#pragma unroll
            for (int q = 0; q < 4; ++q) { const int tok = tb * 256 + i0 + q;
                float ssq = 0.f;
#pragma unroll
                for (int j = 0; j < 4; ++j) ssq += (v4[q][j].x * v4[q][j].x + v4[q][j].y * v4[q][j].y) + (v4[q][j].z * v4[q][j].z + v4[q][j].w * v4[q][j].w);
                const float r = 1.0f / sqrtf(wave_sum(ssq) * (1.f / DM) + EPS);
                float lg[8];
#pragma unroll
                for (int e = 0; e < 8; ++e) { float sd = 0.f;
#pragma unroll
                    for (int j = 0; j < 4; ++j) { const f32x4 w = *(const LAS f32x4*)(grT + e * DM + 512 * (j >> 1) + 8 * lane + 4 * (j & 1)); sd += (v4[q][j].x * w.x + v4[q][j].y * w.y) + (v4[q][j].z * w.z + v4[q][j].w * w.w); }
                    lg[e] = wave_sum(sd) * r; }
                int e0 = 0; float l0 = lg[0];
#pragma unroll
                for (int e = 1; e < 8; ++e) if (lg[e] > l0) { l0 = lg[e]; e0 = e; }
                int e1 = -1; float l1 = 0.f;
#pragma unroll
                for (int e = 0; e < 8; ++e) if (e != e0 && (e1 < 0 || lg[e] > l1)) { l1 = lg[e]; e1 = e; }
                if (lane == 0) { const float g1 = 1.f / (1.f + expf(l0 - l1)), g0 = 1.f - g1;
                    RE[tok] = e0 | (e1 << 8); RG[tok] = (f32x2){g0, g1}; RSTD[tok] = r; __hip_atomic_fetch_add(&cnt[e0], 1, __ATOMIC_RELAXED, __HIP_MEMORY_SCOPE_WORKGROUP); __hip_atomic_fetch_add(&cnt[e1], 1, __ATOMIC_RELAXED, __HIP_MEMORY_SCOPE_WORKGROUP); } } }
        __syncthreads();
        if (tid < 8) CNT[tb * 8 + tid] = cnt[tid];
        __syncthreads();
    }
}
__device__ __forceinline__ void p_router_b(const Args& a, const bf16_t* x, LAS unsigned char* lds) {
    LAS int* cn = (LAS int*)lds;
    LAS int* tot = cn + 2048; LAS int* bef = tot + 8; LAS int* seg = bef + 8; LAS int* wtot = seg + 16;
    LAS int* slot = wtot + 32;
    const int tid = opaque_tid(), lane = tid & 63, wave = tid >> 6;
    const int* RE = (const int*)(a.ws + MS_RE); const float* RSTD = (const float*)(a.ws + MS_RSTD); const int* CNT = (const int*)(a.ws + CTL_CNT);
    int* SLOT = (int*)(a.ws + MS_SLOT); int* TILE_E = (int*)(a.ws + CTL_TILEE); int* NT = (int*)(a.ws + CTL_NT);
    unsigned char* XS8 = a.ws + WS_A + 128 * MiB;
    for (int tb = blockIdx.x; tb < NTOK / 256; tb += gridDim.x) {
        { const int4 c4 = *(const int4*)(CNT + tid * 4); cn[tid * 4] = c4.x; cn[tid * 4 + 1] = c4.y; cn[tid * 4 + 2] = c4.z; cn[tid * 4 + 3] = c4.w; }
        __syncthreads();
        if (tid < 8) { int t = 0, bf = 0; for (int b = 0; b < 256; ++b) { const int c = cn[b * 8 + tid]; t += c; if (b < tb) bf += c; } tot[tid] = t; bef[tid] = bf; }
        __syncthreads();
        if (tid == 0) { int s = 0; for (int e = 0; e < 8; ++e) { seg[e] = s; s += ((tot[e] + 255) >> 8) << 8; } seg[8] = s; if (tb == 0) *NT = s >> 8; }
        int e0 = 0, e1 = 0, r0 = 0, r1 = 0;
        if (tid < 256) { const int re = RE[tb * 256 + tid]; e0 = re & 255; e1 = re >> 8;
#pragma unroll
            for (int e = 0; e < 8; ++e) { const bool f = (e0 == e) || (e1 == e); const unsigned long long mk = __ballot(f);
                const int r = __popcll(mk & ((1ull << lane) - 1ull)); if (lane == 0) wtot[wave * 8 + e] = __popcll(mk); if (e == e0) r0 = r; if (e == e1) r1 = r; } }
        __syncthreads();
        if (tb == 0) { const int ntl = seg[8] >> 8;
            for (int t = tid; t < ntl; t += NTHREADS) { int e = 0;
#pragma unroll
                for (int q = 1; q < 8; ++q) e = (seg[q] <= (t << 8)) ? q : e;
                TILE_E[t] = e; } }
        if (tid < 256) { int o0 = 0, o1 = 0; for (int w = 0; w < wave; ++w) { o0 += wtot[w * 8 + e0]; o1 += wtot[w * 8 + e1]; }
            const int p0 = seg[e0] + bef[e0] + o0 + r0, p1 = seg[e1] + bef[e1] + o1 + r1;
            slot[tid * 2] = p0; slot[tid * 2 + 1] = p1; *(int2*)(SLOT + (size_t)(tb * 256 + tid) * 2) = make_int2(p0, p1); }
        __syncthreads();
        for (int i0 = wave * 4; i0 < 256; i0 += NWAVES * 4) {
            f32x4 v4[4][4]; float r4[4];
#pragma unroll
            for (int q = 0; q < 4; ++q) { const int tok = tb * 256 + i0 + q; r4[q] = RSTD[tok]; row_load8(x + (size_t)tok * DM, lane, v4[q]); }
#pragma unroll
            for (int q = 0; q < 4; ++q) { row_store_f8(XS8 + (size_t)slot[(i0 + q) * 2] * DM, lane, v4[q], r4[q] * pg8::F8_XS); row_store_f8(XS8 + (size_t)slot[(i0 + q) * 2 + 1] * DM, lane, v4[q], r4[q] * pg8::F8_XS); } }
        __syncthreads();
    }
}
template <bool FINAL> __device__ __forceinline__ void p_moe_combine(const Args& a, bf16_t* XB, float* SSQ, float* out) {
    const int tz = opaque_tid(), lane = tz & 63, gw = blockIdx.x * NWAVES + (tz >> 6), NGW = gridDim.x * NWAVES;
    const f32x2* RG = (const f32x2*)(a.ws + MS_RG); const int* SLOT = (const int*)(a.ws + MS_SLOT); const bf16_t* YS = (const bf16_t*)(a.ws + WS_A);
    const bf16_t* YSP = (const bf16_t*)(a.ws + WS_QGRAW);
    constexpr int XROW0 = 1 << 30;
    for (int m0 = gw * 2; m0 < NTOK; m0 += NGW * 2) {
        f32x2 g2[2]; int2 sl2[2];
#pragma unroll
        for (int q = 0; q < 2; ++q) { g2[q] = RG[m0 + q]; sl2[q] = *(const int2*)(SLOT + (size_t)(m0 + q) * 2); }
        u32x4 xv[2][2], ya[2][2], yb[2][2];
#pragma unroll
        for (int q = 0; q < 2; ++q) { const u32x4* xr = (const u32x4*)(XB + (size_t)(m0 + q) * DM) + lane;
            const u32x4* y0 = (const u32x4*)(YS + (size_t)(sl2[q].x < XROW0 ? sl2[q].x : 0) * DM) + lane; const u32x4* y1 = (const u32x4*)(YS + (size_t)(sl2[q].y < XROW0 ? sl2[q].y : 0) * DM) + lane;
#pragma unroll
            for (int j = 0; j < 2; ++j) { xv[q][j] = xr[64 * j]; ya[q][j] = y0[64 * j]; yb[q][j] = y1[64 * j]; } }
#pragma unroll
        for (int q = 0; q < 2; ++q) { const int m = m0 + q; const f32x2 g = g2[q];
            u32x4* xb = (u32x4*)(XB + (size_t)m * DM) + lane; f32x4* orow = (f32x4*)(out + (size_t)m * DM) + 2 * lane; float ss = 0.f;
            const int s0 = __builtin_amdgcn_readfirstlane(sl2[q].x), s1 = __builtin_amdgcn_readfirstlane(sl2[q].y);
#pragma unroll
            for (int j = 0; j < 2; ++j) { const u32x4 x0 = xv[q][j];
                f32x4 a0l, a0h, a1l, a1h;
                { const u32x4 w = ya[q][j]; a0l = (f32x4){bflo(w.x), bfhi(w.x), bflo(w.y), bfhi(w.y)}; a0h = (f32x4){bflo(w.z), bfhi(w.z), bflo(w.w), bfhi(w.w)}; }
                { const u32x4 w = yb[q][j]; a1l = (f32x4){bflo(w.x), bfhi(w.x), bflo(w.y), bfhi(w.y)}; a1h = (f32x4){bflo(w.z), bfhi(w.z), bflo(w.w), bfhi(w.w)}; }
                if (s0 >= XROW0) { a0l = (f32x4){0.f, 0.f, 0.f, 0.f}; a0h = a0l;
                    for (int ks = 0; ks < pg8::XSPLIT; ++ks) { f32x4 pl, ph; ld8(YSP + ((size_t)ks * pg8::XROWS + (s0 - XROW0)) * DM + 8 * lane + 512 * j, pl, ph); a0l += pl; a0h += ph; } }
                if (s1 >= XROW0) { a1l = (f32x4){0.f, 0.f, 0.f, 0.f}; a1h = a1l;
                    for (int ks = 0; ks < pg8::XSPLIT; ++ks) { f32x4 pl, ph; ld8(YSP + ((size_t)ks * pg8::XROWS + (s1 - XROW0)) * DM + 8 * lane + 512 * j, pl, ph); a1l += pl; a1h += ph; } }
                const f32x4 xl = (f32x4){bflo(x0.x), bfhi(x0.x), bflo(x0.y), bfhi(x0.y)}, xh = (f32x4){bflo(x0.z), bfhi(x0.z), bflo(x0.w), bfhi(x0.w)};
                const f32x4 v = xl + g.x * a0l + g.y * a1l, u = xh + g.x * a0h + g.y * a1h;
                if (FINAL) { orow[128 * j] = v; orow[128 * j + 1] = u; }
                else { u32x4 w; w.x = pk2(v.x, v.y); w.y = pk2(v.z, v.w); w.z = pk2(u.x, u.y); w.w = pk2(u.z, u.w); xb[64 * j] = w;
                    ss += ((v.x * v.x + v.y * v.y) + (v.z * v.z + v.w * v.w)) + ((u.x * u.x + u.y * u.y) + (u.z * u.z + u.w * u.w)); } }
            if (!FINAL) { ss = wave_sum(ss); if (lane == 0) *(f32x4*)(SSQ + (size_t)m * 4) = (f32x4){ss, 0.f, 0.f, 0.f}; } } }
}

__device__ __forceinline__ void headnorm_inplace(bf16_t* buf, int ld, int col0, int nheads, const float* gain, float scale) {
    const int tz = opaque_tid(), gl = (blockIdx.x * NTHREADS + tz) >> 3, NG = (gridDim.x * NTHREADS) >> 3, sub = tz & 7;
    f32x4 ga = *(const f32x4*)(gain + sub * 8), gb = *(const f32x4*)(gain + sub * 8 + 4);
    const long total = (long)NTOK * nheads;
    for (long it = gl; it < total; it += NG) { const int tok = (int)(it / nheads), h = (int)(it % nheads);
        u32x4* p = (u32x4*)(buf + (size_t)tok * ld + col0 + h * 64 + sub * 8); const u32x4 w = *p;
        float v[8] = {bflo(w.x), bfhi(w.x), bflo(w.y), bfhi(w.y), bflo(w.z), bfhi(w.z), bflo(w.w), bfhi(w.w)};
        float s = 0.f;
#pragma unroll
        for (int j = 0; j < 8; ++j) s += v[j] * v[j];
        s += __shfl_xor(s, 1); s += __shfl_xor(s, 2); s += __shfl_xor(s, 4);
        const float r = scale / sqrtf(s * (1.f / 64.f) + EPS);
        u32x4 o; o.x = pk2(v[0] * r * ga.x, v[1] * r * ga.y); o.y = pk2(v[2] * r * ga.z, v[3] * r * ga.w); o.z = pk2(v[4] * r * gb.x, v[5] * r * gb.y); o.w = pk2(v[6] * r * gb.z, v[7] * r * gb.w);
        *p = o; }
}
__device__ __forceinline__ void p_cmp_gather(const Args& a) {
    const bf16_t* KV = (const bf16_t*)(a.ws + WS_KVRAW); bf16_t* BLK = (bf16_t*)(a.ws + WS_BLK); const float* pos = a.in[I_CPOS];
    const long total = (long)2 * 16256 * 256;
    const int tz = opaque_tid();
    for (long it = (long)blockIdx.x * NTHREADS + tz; it < total; it += (long)gridDim.x * NTHREADS) {
        const int piece = (int)(it & 255), row = (int)((it >> 8) % 16256), w = (int)((it >> 8) / 16256);
        const int l = piece >> 3, d0 = (piece & 7) * 8, g = row & 3, bc = row >> 2, b = bc / NCMP, c = bc % NCMP;
        const u32x4 kv = *(const u32x4*)(KV + ((size_t)b * SEQ + 16 * c + l) * 1536 + w * 256 + g * 64 + d0);
        const f32x4 pa = *(const f32x4*)(pos + (w * 32 + l) * 64 + d0), pb = *(const f32x4*)(pos + (w * 32 + l) * 64 + d0 + 4);
        u32x4 o; o.x = pk2(bflo(kv.x) + pa.x, bfhi(kv.x) + pa.y); o.y = pk2(bflo(kv.y) + pa.z, bfhi(kv.y) + pa.w); o.z = pk2(bflo(kv.z) + pb.x, bfhi(kv.z) + pb.y); o.w = pk2(bflo(kv.w) + pb.z, bfhi(kv.w) + pb.w);
        *(u32x4*)(BLK + ((size_t)w * 16384 + row) * 2048 + l * 64 + d0) = o; }
}
__device__ __forceinline__ int vt_pos(int k) { return (k & ~12) | ((k & 4) << 1) | ((k & 8) >> 1); }
__device__ __forceinline__ void p_cmp_finish(const Args& a) {
    const float* CMP = (const float*)(a.ws + MS_CMPRAW); const float* gk0 = a.in[I_GK];
    bf16_t* KCF = (bf16_t*)(a.ws + WS_KCF); bf16_t* VCF = (bf16_t*)(a.ws + WS_VCF);
    const int tz = opaque_tid(), lane = tz & 63, gw = blockIdx.x * NWAVES + (tz >> 6), NGW = gridDim.x * NWAVES;
    for (int it = gw; it < 2 * 16384; it += NGW) { const int w = it >> 14, idx = it & 16383, g = idx & 3, bc = idx >> 2, b = bc >> 7, c = bc & 127;
        float s = 0.f;
        if (c < NCMP) { s = CMP[((size_t)w * 16384 + (size_t)(b * NCMP + c) * 4 + g) * 64 + lane];
            if (w == 0) { const float ss = wave_sum(s * s); s = s * (1.0f / sqrtf(ss * (1.f / 64.f) + EPS)) * gk0[lane]; } }
        const int d = lane, t2 = c >> 6, kk = c & 63;
        if (w == 0) KCF[(((size_t)(b * 4 + g) * 2 + t2) * 8 + (kk >> 5) * 4 + (d >> 4)) * 512 + (((d >> 3) & 1) * 32 + (kk & 31)) * 8 + (d & 7)] = (bf16_t)f2bf(s);
        else { const int ps = vt_pos(kk); VCF[(((size_t)(b * 4 + g) * 2 + t2) * 8 + ((ps >> 4) * 2 + (d >> 5))) * 512 + (((ps >> 3) & 1) * 32 + (d & 31)) * 8 + (ps & 7)] = (bf16_t)f2bf(s); } }
}
__device__ __forceinline__ void p_kv_frag(const Args& a) {
    const bf16_t* KV = (const bf16_t*)(a.ws + WS_KVRAW); bf16_t* KF = (bf16_t*)(a.ws + WS_KF); bf16_t* VF = (bf16_t*)(a.ws + WS_VF);
    const int tz = opaque_tid();
    const long total = (long)2 * NBATCH * 4 * 8 * SEQ;
    const int sub = tz & 7;
    for (long it = (long)blockIdx.x * NTHREADS + tz; it < total; it += (long)gridDim.x * NTHREADS) {
        { const int t = (int)((it >> 3) & 2047), g = (int)((it >> 14) & 3), b = (int)((it >> 16) & 31), w = (int)(it >> 21);
          const float* gain = a.in[I_GK] + 64 * (1 + w);
          const u32x4 wv = *(const u32x4*)(KV + ((size_t)b * SEQ + t) * 1536 + 512 + w * 512 + g * 64 + sub * 8);
          float v[8] = {bflo(wv.x), bfhi(wv.x), bflo(wv.y), bfhi(wv.y), bflo(wv.z), bfhi(wv.z), bflo(wv.w), bfhi(wv.w)};
          float ss = 0.f;
#pragma unroll
          for (int j = 0; j < 8; ++j) ss += v[j] * v[j];
          ss += __shfl_xor(ss, 1); ss += __shfl_xor(ss, 2); ss += __shfl_xor(ss, 4);
          const float r = 1.0f / sqrtf(ss * (1.f / 64.f) + EPS);
          const f32x4 ga = *(const f32x4*)(gain + sub * 8), gb = *(const f32x4*)(gain + sub * 8 + 4);
          u32x4 o; o.x = pk2(v[0] * r * ga.x, v[1] * r * ga.y); o.y = pk2(v[2] * r * ga.z, v[3] * r * ga.w); o.z = pk2(v[4] * r * gb.x, v[5] * r * gb.y); o.w = pk2(v[6] * r * gb.z, v[7] * r * gb.w);
          const int kk = t & 63;
          *(u32x4*)(KF + ((((size_t)w * 128 + b * 4 + g) * 32 + (t >> 6)) * 8 + (kk >> 5) * 4 + (sub >> 1)) * 512 + ((sub & 1) * 32 + (kk & 31)) * 8) = o; }
        { const int t = (int)(it & 2047), piece = (int)((it >> 11) & 7), g = (int)((it >> 14) & 3), b = (int)((it >> 16) & 31), w = (int)(it >> 21);
          const u32x4 v = *(const u32x4*)(KV + ((size_t)b * SEQ + t) * 1536 + 768 + w * 512 + g * 64 + piece * 8);
          const int ps = vt_pos(t & 63), d0 = piece * 8;
          bf16_t* dst = VF + ((((size_t)w * 128 + b * 4 + g) * 32 + (t >> 6)) * 8 + ((ps >> 4) * 2 + (d0 >> 5))) * 512 + (((ps >> 3) & 1) * 32 + (d0 & 31)) * 8 + (ps & 7);
          dst[0] = (bf16_t)(v.x & 0xffff); dst[8] = (bf16_t)(v.x >> 16); dst[16] = (bf16_t)(v.y & 0xffff); dst[24] = (bf16_t)(v.y >> 16);
          dst[32] = (bf16_t)(v.z & 0xffff); dst[40] = (bf16_t)(v.z >> 16); dst[48] = (bf16_t)(v.w & 0xffff); dst[56] = (bf16_t)(v.w >> 16); } }
}

__device__ __forceinline__ int rel_bucket(int n) {
    if (n < 16) return n;
    int lg = 16 + (int)(logf((float)n * (1.f / 16.f)) / logf(8.f) * 16.f);
    return lg < 31 ? lg : 31;
}
typedef float f32x16 __attribute__((ext_vector_type(16)));
#define MFMA32(a, b, c) __builtin_amdgcn_mfma_f32_32x32x16_bf16((a), (b), (c), 0, 0, 0)
__device__ __forceinline__ float xhalf(float v, int h) { (void)h; return __shfl_xor(v, 32); }
__device__ __forceinline__ float dpp_xor1(float v) { return __shfl_xor(v, 1); }
__device__ __forceinline__ float dpp_xor2(float v) { return __shfl_xor(v, 2); }
__device__ __forceinline__ void pv_tile(const bf16_t* VTp, const f32x16& p0, const f32x16& p1, f32x16 (&O)[2], int lane) {
#pragma unroll
    for (int bb = 0; bb < 2; ++bb)
#pragma unroll
        for (int s2 = 0; s2 < 2; ++s2) {
            u32x4 w;
            if (bb == 0) { w.x = cvt_pk_bf16(p0[8 * s2 + 0], p0[8 * s2 + 1]); w.y = cvt_pk_bf16(p0[8 * s2 + 2], p0[8 * s2 + 3]); w.z = cvt_pk_bf16(p0[8 * s2 + 4], p0[8 * s2 + 5]); w.w = cvt_pk_bf16(p0[8 * s2 + 6], p0[8 * s2 + 7]); }
            else         { w.x = cvt_pk_bf16(p1[8 * s2 + 0], p1[8 * s2 + 1]); w.y = cvt_pk_bf16(p1[8 * s2 + 2], p1[8 * s2 + 3]); w.z = cvt_pk_bf16(p1[8 * s2 + 4], p1[8 * s2 + 5]); w.w = cvt_pk_bf16(p1[8 * s2 + 6], p1[8 * s2 + 7]); }
            const bf16x8 Pf = __builtin_bit_cast(bf16x8, w);
#pragma unroll
            for (int db = 0; db < 2; ++db) {
                const bf16x8 vf = *(const bf16x8*)(VTp + (size_t)((((bb * 2 + s2) * 2 + db) * 64 + lane) * 8));
                O[db] = MFMA32(vf, Pf, O[db]); } }
}
constexpr float MINIT = -1e20f;
constexpr float DEFER_THR = 11.5f;
constexpr int BT_C = 384, BT_N = 512;
__device__ __forceinline__ void online_tile(f32x16& s0, f32x16& s1, const LAS float* bl  , float& m, float& l, f32x16 (&O)[2]) {
    float mx = m;
    { float b0[16];
#pragma unroll
      for (int r = 0; r < 16; ++r) b0[r] = bl[(r & 3) + 8 * (r >> 2)];
#pragma unroll
      for (int r = 0; r < 16; ++r) { const float v = s0[r] + b0[r]; s0[r] = v; mx = fmaxf(mx, v); } }
    { float b1[16];
#pragma unroll
      for (int r = 0; r < 16; ++r) b1[r] = bl[32 + (r & 3) + 8 * (r >> 2)];
#pragma unroll
      for (int r = 0; r < 16; ++r) { const float v = s1[r] + b1[r]; s1[r] = v; mx = fmaxf(mx, v); } }
    mx = fmaxf(mx, __shfl_xor(mx, 32));
    if (!__all(mx - m <= DEFER_THR)) { const float al = __builtin_amdgcn_exp2f(m - mx); m = mx; l *= al; O[0] *= al; O[1] *= al; }
}
__device__ __forceinline__ void online_tile_wedge(f32x16& s0, f32x16& s1, int tedge  , float cb, float& m, float& l, f32x16 (&O)[2]) {
    float mx = m;
#pragma unroll
    for (int r = 0; r < 16; ++r) { const float v = ((r & 3) + 8 * (r >> 2) >= tedge) ? s0[r] + cb : NEGF; s0[r] = v; mx = fmaxf(mx, v); }
#pragma unroll
    for (int r = 0; r < 16; ++r) { const float v = (32 + (r & 3) + 8 * (r >> 2) >= tedge) ? s1[r] + cb : NEGF; s1[r] = v; mx = fmaxf(mx, v); }
    mx = fmaxf(mx, __shfl_xor(mx, 32));
    if (!__all(mx - m <= DEFER_THR)) { const float al = __builtin_amdgcn_exp2f(m - mx); m = mx; l *= al; O[0] *= al; O[1] *= al; }
}
__device__ __forceinline__ void online_tile_far(f32x16& s0, f32x16& s1, float cb, float& m, float& l, f32x16 (&O)[2]) {
    float mx = m;
#pragma unroll
    for (int r = 0; r < 16; ++r) { s0[r] += cb; mx = fmaxf(mx, s0[r]); }
#pragma unroll
    for (int r = 0; r < 16; ++r) { s1[r] += cb; mx = fmaxf(mx, s1[r]); }
    mx = fmaxf(mx, __shfl_xor(mx, 32));
    if (!__all(mx - m <= DEFER_THR)) { const float al = __builtin_amdgcn_exp2f(m - mx); m = mx; l *= al; O[0] *= al; O[1] *= al; }
}
template <int MODE> __device__ __forceinline__ void p_attn(const Args& a, LAS unsigned char* lds) {
    LAS float* biasd = (LAS float*)lds;
    const float* relb = a.in[I_RELB];
    if (opaque_tid() >= 256) __builtin_amdgcn_s_setprio(1);
    for (int i = opaque_tid(); i < 16 * BT_N; i += NTHREADS) { const int head = i / BT_N, dist = BT_C - (i % BT_N); biasd[i] = dist < 0 ? NEGF : relb[rel_bucket(dist < 128 ? dist : 128) * 16 + head] * 1.44269504f; }
    __syncthreads();
    const bf16_t* QG = (const bf16_t*)(a.ws + WS_QGRAW);
    const bf16_t* KF = (const bf16_t*)(a.ws + WS_KF); const bf16_t* VF = (const bf16_t*)(a.ws + WS_VF);
    const bf16_t* KCF = (const bf16_t*)(a.ws + WS_KCF); const bf16_t* VCF = (const bf16_t*)(a.ws + WS_VCF);
    bf16_t* OUT = (bf16_t*)(a.ws + (MODE == 0 ? WS_H : WS_BLK));
    for (int unit = blockIdx.x; unit < NBATCH * 32 * 4; unit += gridDim.x) {
        const int tid = opaque_tid(), lane = tid & 63, wave = tid >> 6, c = lane & 31, h = lane >> 5;
        const int k = unit >> 8, idx = unit & 255, xg = idx & 7;
        const int b = 2 * k + (xg >> 2), g = xg & 3, qx = ((idx >> 3) + 4 * (k >> 1)) & 31, qt = (k & 1) ? 31 - qx : qx;
        const int ql = 8 * wave + (c >> 2), r = c & 3, head = 4 * g + r; int tq = qt * 64 + ql; asm volatile("" : "+v"(tq));
        const size_t tok = (size_t)b * SEQ + tq;
        const LAS float* bd = biasd + head * BT_N + BT_C;
        bf16x8 Qf[4];
        LAS bf16x8* qlds = (LAS bf16x8*)(lds + 32768) + wave * 256 + lane;
#pragma unroll
        for (int s = 0; s < 4; ++s) { Qf[s] = *(const bf16x8*)(QG + tok * 1280 + head * 64 + 16 * s + 8 * h); qlds[64 * s] = Qf[s]; }
        const bf16_t* gp = QG + tok * 1280 + 1024 + head * 3;
        const float gt0 = __builtin_amdgcn_rcpf(1.f + __expf(-bf2f(gp[0]))), gt1 = __builtin_amdgcn_rcpf(1.f + __expf(-bf2f(gp[1]))), gt2 = __builtin_amdgcn_rcpf(1.f + __expf(-bf2f(gp[2])));
        f32x16 OT[2];
        int jsel = -1;
        bf16x8 Kn[8];
        {
            const bf16_t* KC = KCF + (size_t)(b * 4 + g) * 2 * 4096; const bf16_t* VC = VCF + (size_t)(b * 4 + g) * 2 * 4096;
            f32x16 sc[4];
#pragma unroll
            for (int i = 0; i < 4; ++i) sc[i] = (f32x16){0.f, 0.f, 0.f, 0.f, 0.f, 0.f, 0.f, 0.f, 0.f, 0.f, 0.f, 0.f, 0.f, 0.f, 0.f, 0.f};
            { bf16x8 kf[16];
#pragma unroll
              for (int t2 = 0; t2 < 2; ++t2)
#pragma unroll
                for (int s2 = 0; s2 < 4; ++s2) { kf[t2 * 8 + 2 * s2] = *(const bf16x8*)(KC + t2 * 4096 + (s2 * 64 + lane) * 8); kf[t2 * 8 + 2 * s2 + 1] = *(const bf16x8*)(KC + t2 * 4096 + ((4 + s2) * 64 + lane) * 8); }
              __builtin_amdgcn_sched_barrier(0);
#pragma unroll
              for (int t2 = 0; t2 < 2; ++t2)
#pragma unroll
                for (int s2 = 0; s2 < 4; ++s2) { sc[2 * t2] = MFMA32(kf[t2 * 8 + 2 * s2], Qf[s2], sc[2 * t2]); sc[2 * t2 + 1] = MFMA32(kf[t2 * 8 + 2 * s2 + 1], Qf[s2], sc[2 * t2 + 1]); } }
            bf16x8 vcf[8];
#pragma unroll
            for (int i = 0; i < 8; ++i) vcf[i] = *(const bf16x8*)(VC + (i * 64 + lane) * 8);
            __builtin_amdgcn_sched_barrier(0);
            float mx = NEGF;
            const int tq0 = qt * 64 + 8 * __builtin_amdgcn_readfirstlane(wave); const float cbf = bd[-128];
#pragma unroll
            for (int kb = 0; kb < 4; ++kb) {
                if ((tq0 - 31 - 64) - 16 * (32 * kb + 27) >= 128) {
#pragma unroll
                    for (int rr = 0; rr < 16; ++rr) { const float v = sc[kb][rr] + cbf; sc[kb][rr] = v; mx = fmaxf(mx, v); }
                } else if ((tq0 + 7 - 31) - 16 * (32 * kb) < 0) {
#pragma unroll
                    for (int rr = 0; rr < 16; ++rr) sc[kb][rr] = NEGF;
                } else {
                    float bb[16];
#pragma unroll
                    for (int rr = 0; rr < 16; ++rr) { const int dc = (tq - 31 - 64 * h) - 16 * (32 * kb + (rr & 3) + 8 * (rr >> 2)); bb[rr] = bd[-min(max(dc, 0), 128)]; }
#pragma unroll
                    for (int rr = 0; rr < 16; ++rr) { const int dc = (tq - 31 - 64 * h) - 16 * (32 * kb + (rr & 3) + 8 * (rr >> 2));
                        const float v = (dc >= 0) ? sc[kb][rr] + bb[rr] : NEGF; sc[kb][rr] = v; mx = fmaxf(mx, v); } } }
            mx = fmaxf(fmaxf(mx, __shfl_xor(mx, 32)), MINIT);
            float ps = 0.f;
#pragma unroll
            for (int kb = 0; kb < 4; ++kb)
#pragma unroll
                for (int rr = 0; rr < 16; ++rr) { const float p = __builtin_amdgcn_exp2f(sc[kb][rr] - mx); sc[kb][rr] = p; ps += p; }
            ps += __shfl_xor(ps, 32);
            const float inv = __builtin_amdgcn_rcpf(fmaxf(ps, TINYF));
#pragma unroll
            for (int kb = 0; kb < 4; ++kb) sc[kb] *= inv;
            OT[0] = (f32x16){0.f, 0.f, 0.f, 0.f, 0.f, 0.f, 0.f, 0.f, 0.f, 0.f, 0.f, 0.f, 0.f, 0.f, 0.f, 0.f}; OT[1] = OT[0];
#define CMP_PV(t2) do { _Pragma("unroll") for (int bb = 0; bb < 2; ++bb) _Pragma("unroll") for (int s2 = 0; s2 < 2; ++s2) { const f32x16& p = sc[2 * (t2) + bb]; \
                u32x4 w; w.x = cvt_pk_bf16(p[8 * s2 + 0], p[8 * s2 + 1]); w.y = cvt_pk_bf16(p[8 * s2 + 2], p[8 * s2 + 3]); w.z = cvt_pk_bf16(p[8 * s2 + 4], p[8 * s2 + 5]); w.w = cvt_pk_bf16(p[8 * s2 + 6], p[8 * s2 + 7]); \
                const bf16x8 Pf = __builtin_bit_cast(bf16x8, w); \
                _Pragma("unroll") for (int db = 0; db < 2; ++db) OT[db] = MFMA32(vcf[(bb * 2 + s2) * 2 + db], Pf, OT[db]); } } while (0)
            CMP_PV(0);
            { const bf16_t* Kp = KF + (size_t)(b * 4 + g) * 32 * 4096;
#pragma unroll
              for (int s2 = 0; s2 < 4; ++s2) { Kn[2 * s2] = *(const bf16x8*)(Kp + (s2 * 64 + lane) * 8); Kn[2 * s2 + 1] = *(const bf16x8*)(Kp + ((4 + s2) * 64 + lane) * 8); } }
#pragma unroll
            for (int i = 0; i < 8; ++i) vcf[i] = *(const bf16x8*)(VC + 4096 + (i * 64 + lane) * 8);
            __builtin_amdgcn_sched_barrier(0);
            float best = -1.f; int bj = -1; const int jmax = qt - 2;
            float prev_recv = 0.f;
#pragma unroll
            for (int v = 0; v < 16; ++v) if (2 * v <= jmax) { const int kb = v >> 2, aa = v & 3;
                const float p3 = sc[kb][4 * aa + 3];
                const float av = (sc[kb][4 * aa] + sc[kb][4 * aa + 1]) + (sc[kb][4 * aa + 2] + 0.5f * p3);
                const float recv = xhalf(0.5f * p3, h);
                float iv = av + (h ? recv : prev_recv);
                prev_recv = recv;
                iv += dpp_xor1(iv); iv += dpp_xor2(iv);
                const int jj = 2 * v + h;
                if (jj >= 1 && jj <= jmax && iv > best) { best = iv; bj = jj; } }
            { const float ob = xhalf(best, h); const int oj = __builtin_bit_cast(int, xhalf(__builtin_bit_cast(float, bj), h));
              if (oj >= 0 && (bj < 0 || ob > best || (ob == best && oj < bj))) { best = ob; bj = oj; } }
            jsel = bj;
            CMP_PV(1);
#undef CMP_PV
            LAS f32x4* otl0 = (LAS f32x4*)(lds + 65536) + wave * 512 + lane;
#pragma unroll
            for (int db = 0; db < 2; ++db)
#pragma unroll
                for (int r4 = 0; r4 < 4; ++r4) otl0[(db * 4 + r4) * 64] = (f32x4){OT[db][4 * r4], OT[db][4 * r4 + 1], OT[db][4 * r4 + 2], OT[db][4 * r4 + 3]} * gt0;
        }
        {
            float m = MINIT, l = 0.f; f32x16 O[2];
            LAS f32x4* otl = (LAS f32x4*)(lds + 65536) + wave * 512 + lane;
            O[0] = (f32x16){0.f, 0.f, 0.f, 0.f, 0.f, 0.f, 0.f, 0.f, 0.f, 0.f, 0.f, 0.f, 0.f, 0.f, 0.f, 0.f}; O[1] = O[0];
            const bf16_t* KbS = KF + (size_t)(b * 4 + g) * 32 * 4096; const bf16_t* VbS = VF + (size_t)(b * 4 + g) * 32 * 4096;
#define ATT_NEXT(nx, kt, pq, win, ok) do { pq = 0; win = 0; ok = false; \
                while ((nx) < 16) { \
                    if ((nx) < 3) { kt = ((nx) == 1) ? qt - 1 : qt; if (kt > 0) { ok = true; break; } ++(nx); } \
                    else if ((nx) == 3) { if (rem == 0ull) { (nx) = 11; continue; } \
                        kt = __builtin_amdgcn_readlane(jsel, (int)__builtin_ctzll(rem)); rem &= ~__ballot(jsel == kt); pq = 1; ok = true; break; } \
                    else { kt = qt - 15 + (nx); win = 1; if (kt >= 0) { ok = true; break; } ++(nx); } } } while (0)
#define ATT_KPTR(kt, win) (KbS + (size_t)(win) * ((size_t)128 * 32 * 4096) + (size_t)(kt) * 4096)
#define ATT_VPTR(kt, win) (VbS + (size_t)(win) * ((size_t)128 * 32 * 4096) + (size_t)(kt) * 4096)
            int st = 0, kt = 0, pq = 0, win = 0;
            unsigned long long rem = __ballot(jsel >= 1);
            int curwin = 0;
            for (;;) {
                int nx = (st == 3) ? 3 : st + 1, nkt = 0, npq = 0, nwin = 0; bool nok = false;
                ATT_NEXT(nx, nkt, npq, nwin, nok);
                bf16x8 Vc[8];
                { const bf16_t* Vp = ATT_VPTR(kt, win);
#pragma unroll
                  for (int bb = 0; bb < 2; ++bb)
#pragma unroll
                    for (int s2 = 0; s2 < 2; ++s2)
#pragma unroll
                        for (int db = 0; db < 2; ++db) Vc[(bb * 2 + s2) * 2 + db] = *(const bf16x8*)(Vp + ((((bb * 2 + s2) * 2 + db) * 64 + lane) * 8)); }
                if (win != curwin) {
                    const float scl = gt1 * __builtin_amdgcn_rcpf(fmaxf(l, TINYF));
#pragma unroll
                    for (int db = 0; db < 2; ++db)
#pragma unroll
                        for (int r4 = 0; r4 < 4; ++r4) otl[(db * 4 + r4) * 64] += (f32x4){O[db][4 * r4], O[db][4 * r4 + 1], O[db][4 * r4 + 2], O[db][4 * r4 + 3]} * scl;
                    m = MINIT; l = 0.f; O[0] = (f32x16){0.f, 0.f, 0.f, 0.f, 0.f, 0.f, 0.f, 0.f, 0.f, 0.f, 0.f, 0.f, 0.f, 0.f, 0.f, 0.f}; O[1] = O[0]; curwin = win; }
                f32x16 s0 = (f32x16){0.f, 0.f, 0.f, 0.f, 0.f, 0.f, 0.f, 0.f, 0.f, 0.f, 0.f, 0.f, 0.f, 0.f, 0.f, 0.f}, s1 = s0;
#pragma unroll
                for (int s2 = 0; s2 < 4; ++s2) { const bf16x8 qf = qlds[64 * s2]; s0 = MFMA32(Kn[2 * s2], qf, s0); s1 = MFMA32(Kn[2 * s2 + 1], qf, s1); }
                { const bf16_t* Kp = nok ? ATT_KPTR(nkt, nwin) : ATT_KPTR(kt, win);
#pragma unroll
                  for (int s2 = 0; s2 < 4; ++s2) { Kn[2 * s2] = *(const bf16x8*)(Kp + (s2 * 64 + lane) * 8); Kn[2 * s2 + 1] = *(const bf16x8*)(Kp + ((4 + s2) * 64 + lane) * 8); } }
                const bool colok = !pq || (jsel == kt);
                const int dq = qt - kt;
                if (win ? (dq == 3) : (dq >= 3)) online_tile_far(s0, s1, colok ? bd[-128] : NEGF, m, l, O);
                else if (win && dq == 4) online_tile_wedge(s0, s1, (tq - kt * 64 - 4 * h) - 255, bd[-128], m, l, O);
                else online_tile(s0, s1, bd - (colok ? (tq - kt * 64 - 4 * h) : -64), m, l, O);
                { float ps = 0.f;
#pragma unroll
                  for (int bb = 0; bb < 2; ++bb) {
                      f32x16& sb = bb ? s1 : s0;
#pragma unroll
                      for (int r = 0; r < 16; ++r) { const float p = __builtin_amdgcn_exp2f(sb[r] - m); sb[r] = p; ps += p; }
#pragma unroll
                      for (int s2 = 0; s2 < 2; ++s2) {
                          u32x4 w; w.x = cvt_pk_bf16(sb[8 * s2 + 0], sb[8 * s2 + 1]); w.y = cvt_pk_bf16(sb[8 * s2 + 2], sb[8 * s2 + 3]); w.z = cvt_pk_bf16(sb[8 * s2 + 4], sb[8 * s2 + 5]); w.w = cvt_pk_bf16(sb[8 * s2 + 6], sb[8 * s2 + 7]);
                          const bf16x8 Pf = __builtin_bit_cast(bf16x8, w);
#pragma unroll
                          for (int db = 0; db < 2; ++db) O[db] = MFMA32(Vc[(bb * 2 + s2) * 2 + db], Pf, O[db]); }
                      __builtin_amdgcn_sched_barrier(0); }
                  ps += __shfl_xor(ps, 32); l += ps; }
                if (!nok) break;
                st = nx; kt = nkt; pq = npq; win = nwin;
            }
#undef ATT_NEXT
#undef ATT_KPTR
#undef ATT_VPTR
            const float scl = gt2 * __builtin_amdgcn_rcpf(fmaxf(l, TINYF));
#pragma unroll
            for (int db = 0; db < 2; ++db)
#pragma unroll
                for (int r4 = 0; r4 < 4; ++r4) { const f32x4 p = otl[(db * 4 + r4) * 64];
#pragma unroll
                    for (int j = 0; j < 4; ++j) OT[db][4 * r4 + j] = p[j] + O[db][4 * r4 + j] * scl; }
        }
        bf16_t* op = OUT + tok * DM + head * 64;
#pragma unroll
        for (int db = 0; db < 2; ++db)
#pragma unroll
            for (int kk = 0; kk < 2; ++kk) {
                const unsigned ax = cvt_pk_bf16(OT[db][8 * kk], OT[db][8 * kk + 1]), ay = cvt_pk_bf16(OT[db][8 * kk + 2], OT[db][8 * kk + 3]);
                const unsigned bx = cvt_pk_bf16(OT[db][8 * kk + 4], OT[db][8 * kk + 5]), by = cvt_pk_bf16(OT[db][8 * kk + 6], OT[db][8 * kk + 7]);
                const auto r0 = __builtin_amdgcn_permlane32_swap(ax, bx, false, false);
                const auto r1 = __builtin_amdgcn_permlane32_swap(ay, by, false, false);
                u32x4 w; w.x = r0[0]; w.y = r1[0]; w.z = r0[1]; w.w = r1[1];
                *(u32x4*)(op + 32 * db + 16 * kk + 8 * h) = w; }
    }
    __builtin_amdgcn_s_setprio(0);
}

constexpr int MOE_CHUNK_TILES = 128, MOE_NCHUNK = 4, MOE_LAST_TILES = 136,       DENSE_NCHUNK = 2, DENSE_CHUNK_ROWS = 32768;
__host__ __device__ constexpr int n_phases() {
    int pc = 0;
    for (int L = 0; L < 4; ++L) {
        if (L < 2) pc += 2; else { pc += (L == 2) ? 6 : 3; }
        if (L % 2 == 0) pc += 2 * DENSE_NCHUNK; else pc += 2 + 2 * MOE_NCHUNK + 1;
    }
    return pc;
}

typedef __attribute__((address_space(4))) const Args* KArgsPtr;
__device__ __forceinline__ Args load_args() {
    Args r{};
#if defined(__HIP_DEVICE_COMPILE__)
    KArgsPtr kp = (KArgsPtr)__builtin_amdgcn_kernarg_segment_ptr(); asm volatile("" : "+s"(kp));
#pragma unroll
    for (int i = 0; i < 22; ++i) r.in[i] = kp->in[i];
    r.out = kp->out; r.ws = kp->ws; r.ph_lo = kp->ph_lo; r.ph_hi = kp->ph_hi;
#endif
    return r;
}
__global__ void __launch_bounds__(NTHREADS, 2) yoco_fwd(Args kargs) {
    extern __shared__ __attribute__((aligned(16))) unsigned char lds_raw[];
    LAS unsigned char* lds = (LAS unsigned char*)lds_raw;
    volatile LAS unsigned* MISC = (volatile LAS unsigned*)(lds + MISC_OFF);
    const int tid = threadIdx.x, G = gridDim.x, cid = blockIdx.x;
    if (tid < 64) MISC[tid] = 0u;
    __syncthreads();
#if MK_SINGLE_LAUNCH
    constexpr int lo = 0, hi = n_phases();
#else
    const int lo = kargs.ph_lo, hi = kargs.ph_hi;
#endif
    unsigned char* ws = kargs.ws;
    const bool SPLIT_OK = (lo == 0 && hi == n_phases());
    if (hi - lo > 1) (void)xcd_barrier_post((unsigned*)(ws + WS_CTL), MISC + 8);
    if (tid == 0) atomicOr((unsigned*)(ws + WS_CTL + CTL_XMASK) + (cid & 7), 1u << xb_xcc_id());
    int pc = 0;
#define PH_BEGIN if (pc >= lo && pc < hi) { const Args args = load_args();
#define PH_JOIN }
#define PH_END_SPLIT(split) } if (pc >= lo && pc + 1 < hi) { XcdBarrier bb; bb.bar = (unsigned*)(load_args().ws + WS_CTL); bb.x = xb_xcc_id(); bb.st = (volatile LAS unsigned*)(lds + MISC_OFF) + 8; if (split) xcd_arrive(bb); else xcd_barrier(bb); } ++pc;
#define PH_END_GROUP(grp) } if (pc >= lo && pc + 1 < hi) { XcdBarrier bb; bb.bar = (unsigned*)(load_args().ws + WS_CTL); bb.x = xb_xcc_id(); bb.st = (volatile LAS unsigned*)(lds + MISC_OFF) + 8; if (grp) group_barrier(bb, cid); else xcd_barrier(bb); } ++pc;
#define PH_END } if (pc >= lo && pc + 1 < hi) { XcdBarrier bb; bb.bar = (unsigned*)(load_args().ws + WS_CTL); bb.x = xb_xcc_id(); bb.st = (volatile LAS unsigned*)(lds + MISC_OFF) + 8; xcd_barrier(bb); if (PROBE_BAR) xcd_barrier(bb); } ++pc;

    bf16_t* XB = (bf16_t*)(ws + WS_KVRAW);
    bf16_t* HID = (bf16_t*)(ws + WS_H);
    float* SSQ = (float*)(ws + MS_SSQ);
    LAS float* EPIP = (LAS float*)(lds + MISC_OFF + LX_P); LAS float* EPISQ = (LAS float*)(lds + MISC_OFF + LX_SQ);
    LAS float* LGAIN = (LAS float*)(lds + MISC_OFF + LX_GAIN); LAS float* LPOS = (LAS float*)(lds + MISC_OFF + LX_POS);


#pragma clang loop unroll(full)
    for (int L = 0; L < 4; ++L) {
        const bf16_t* XBin = XB;
        if (L < 2) {
            PH_BEGIN
                if (L == 0) { p_convert_static(args, lds); p_convert_moe(args, lds, 0); __syncthreads();
                              p_pool_diff(args.in[I_X], (const float*)nullptr, HID, lds); }
                else p_pool_diff((const bf16_t*)XB, (const float*)SSQ, HID, lds);
            PH_END
            PH_BEGIN
                pg8::Gemm g{256, DM, 256};
                pg8::GridSched S{NTOK / 256, 4, G, cid, (const char*)HID, (size_t)256 * DM * 2, (size_t)256 * 2, (const char*)(ws + W_POOL) + (size_t)L * 4 * 65536 * 2, (size_t)65536 * 2, 0, 1 << 30};
                if (L == 0) { pg8::EpiResid<float> E{args.in[I_X], XB, SSQ, DM, 0, EPIP, 1.f}; pg8::gemm_phase(lds, g, S, E); }
                else { pg8::EpiResid<bf16_t> E{XB, XB, SSQ, DM, 0, EPIP, 1.f}; pg8::gemm_phase(lds, g, S, E); }
            PH_END
        } else {
            const int j = L - 2;
            if (j == 0) {
                PH_BEGIN
                    { const int t = opaque_tid();
                      if (t < 192) LGAIN[t] = args.in[I_GK][t];
                      for (int i = t; i < 2 * 32 * 64; i += NTHREADS) LPOS[i] = args.in[I_CPOS][i];
                      __syncthreads(); }
                    pg8::Gemm g{DM, DM, DM};
                    pg8::GridSched S{NTOK / 256, 6, G, cid, (const char*)XBin, (size_t)256 * DM * 2, 0, (const char*)(ws + W_KV), (size_t)256 * DM * 2, 0, 1 << 30};
                    pg8::EpiKV E{pg8::RowScale{SSQ, 0, EPISQ}, (bf16_t*)(ws + WS_BLK), (bf16_t*)(ws + WS_KF), (bf16_t*)(ws + WS_VF), LGAIN, LPOS};
                    DUP(7) pg8::gemm_phase(lds, g, S, E);
                PH_JOIN
            }
            PH_BEGIN
                { const int t = opaque_tid(); if (t < 64) LGAIN[192 + t] = args.in[I_GQ][j * 64 + t]; __syncthreads(); }
                pg8::Gemm g{DM, DM, DM};
                pg8::GridSched S{NTOK / 256, 5, G, cid, (const char*)XBin, (size_t)256 * DM * 2, 0, (const char*)(ws + W_QG) + (size_t)j * 1280 * DM * 2, (size_t)256 * DM * 2, 0, 1 << 30};
                pg8::EpiQG E{pg8::RowScale{SSQ, 0, EPISQ}, (bf16_t*)(ws + WS_QGRAW), 1280, LGAIN + 192, 0.125f * 1.44269504f};
                DUP(7) pg8::gemm_phase(lds, g, S, E);
            PH_END
            if (j == 0) {
                PH_BEGIN
                    pg8::Gemm g{2048, 2048, 2048};
                    pg8::GridSched S{128, 1, G, cid, (const char*)(ws + WS_BLK), (size_t)256 * 2048 * 2, 0, (const char*)(ws + W_C1), 0, (size_t)256 * 2048 * 2, 64};
                    pg8::EpiBf16<1, false> E{HID, 256, pg8::RowScale{nullptr, 0, nullptr}, 1.f};
                    DUP(7) pg8::gemm_phase(lds, g, S, E);
                PH_END
                PH_BEGIN
                    pg8::Gemm g{256, 256, 256};
                    pg8::GridSched S{128, 1, G, cid, (const char*)HID, (size_t)256 * 256 * 2, 0, (const char*)(ws + W_C2), 0, (size_t)256 * 256 * 2, 64};
                    pg8::EpiCmp2 E{(float*)(ws + MS_CMPRAW)};
                    DUP(7) pg8::gemm_phase(lds, g, S, E);
                PH_END
                PH_BEGIN
                    DUP(6) p_cmp_finish(args);
                PH_END
            }
            PH_BEGIN
                p_attn<0>(args, lds);
#if PROBE_ATTN
                p_attn<PROBE_ATTN>(args, lds);
#endif
            PH_END
            PH_BEGIN
                pg8::Gemm g{DM, DM, DM};
                pg8::GridSched S{NTOK / 256, 4, G, cid, (const char*)HID, (size_t)256 * DM * 2, 0, (const char*)(ws + W_O) + (size_t)j * DM * DM * 2, (size_t)256 * DM * 2, 0, 1 << 30};
                pg8::EpiResid<bf16_t> E{XB, XB, SSQ, DM, 0, EPIP, 1.f};
                pg8::gemm_phase(lds, g, S, E);
            PH_END
        }
        if ((L & 1) == 0) {
            const int i = L >> 1;
            for (int ch = 0; ch < DENSE_NCHUNK; ++ch) {
                PH_BEGIN
                    pg8::Gemm g{DM, DM, DM};
                    pg8::GridSched S{DENSE_CHUNK_ROWS / 256, 28, G, cid, (const char*)(XB + (size_t)ch * DENSE_CHUNK_ROWS * DM), (size_t)256 * DM * 2, 0, (const char*)(ws + W_GU) + (size_t)i * 7168 * DM * 2, (size_t)256 * DM * 2, 0, 1 << 30};
                    pg8::EpiSwiGLU<true> E{HID, FFD, pg8::RowScale{SSQ, ch * DENSE_CHUNK_ROWS, EPISQ}, (unsigned*)(ws + MS_CMPRAW)};
                    pg8::gemm_phase(lds, g, S, E, WaitHook{SPLIT_OK && ch > 0, (unsigned*)(args.ws + WS_CTL), (volatile LAS unsigned*)(lds + MISC_OFF) + 8});
                PH_END_GROUP(SPLIT_OK)
                PH_BEGIN
                    pg8::Gemm g{FFD / 2, FFD / 2, FFD / 2};
                    pg8::GridSched S{DENSE_CHUNK_ROWS / 256, 4, G, cid, (const char*)HID, (size_t)256 * FFD, 0, (const char*)(ws + W_D) + (size_t)i * DM * FFD, (size_t)256 * FFD, 0, 1 << 30};
                    pg8::EpiResid<bf16_t> E{XB, XB, SSQ, DM, ch * DENSE_CHUNK_ROWS, EPIP, pg8::F8_OSC};
                    pg8::gemm_phase<pg8::EpiResid<bf16_t>, pg8::GridSched, pg8::NoHook, true, true>(lds, g, S, E);
                PH_END_SPLIT(SPLIT_OK && ch + 1 < DENSE_NCHUNK)
            }
        } else {
            const int l = L >> 1;
            PH_BEGIN
                if (l == 1) { p_convert_moe(args, lds, 1); __syncthreads(); }
                p_router_a(args, XB, l, lds);
            PH_END
            PH_BEGIN
                DUP(5) p_router_b(args, XB, lds);
            PH_END
            for (int ch = 0; ch < MOE_NCHUNK; ++ch) {
                PH_BEGIN
                    const int NT = *(const int*)(ws + CTL_NT), capT = (ch == MOE_NCHUNK - 1) ? MOE_LAST_TILES : MOE_CHUNK_TILES; int nT = NT - ch * MOE_CHUNK_TILES; nT = nT < 0 ? 0 : (nT > capT ? capT : nT);
                    LAS int* LTE = (LAS int*)(lds + MISC_OFF + 14336);
                    { const int t = opaque_tid(); if (t < nT) LTE[t] = ((const int*)(ws + CTL_TILEE))[ch * MOE_CHUNK_TILES + t]; __syncthreads(); }
                    pg8::Gemm g{DM / 2, DM / 2, DM / 2};
                    pg8::MoeSched S{nT, 28, G, cid, LTE, (const char*)(ws + WS_A + 128 * MiB) + (size_t)ch * MOE_CHUNK_TILES * 256 * DM, (size_t)256 * DM, (const char*)(ws + WS_WMOE), (size_t)256 * DM, 28};
                    pg8::EpiSwiGLU<false> E{HID, FFD, pg8::RowScale{nullptr, 0, nullptr}, (unsigned*)(ws + MS_CMPRAW)};
                    pg8::gemm_phase<pg8::EpiSwiGLU<false>, pg8::MoeSched, WaitHook, false, true>(lds, g, S, E, WaitHook{SPLIT_OK && ch > 0, (unsigned*)(args.ws + WS_CTL), (volatile LAS unsigned*)(lds + MISC_OFF) + 8});
                PH_END_GROUP(SPLIT_OK && ch + 1 < MOE_NCHUNK)
                PH_BEGIN
                    const int NT = *(const int*)(ws + CTL_NT), capT = (ch == MOE_NCHUNK - 1) ? MOE_LAST_TILES : MOE_CHUNK_TILES; int nT = NT - ch * MOE_CHUNK_TILES; nT = nT < 0 ? 0 : (nT > capT ? capT : nT);
                    LAS int* LTE = (LAS int*)(lds + MISC_OFF + 14336);
                    { const int t = opaque_tid(); if (t < nT) LTE[t] = ((const int*)(ws + CTL_TILEE))[ch * MOE_CHUNK_TILES + t]; __syncthreads(); }
                    { pg8::Gemm g{FFD / 2, FFD / 2, FFD / 2};
                      pg8::MoeSched S{nT, 4, G, cid, LTE, (const char*)HID, (size_t)256 * FFD, (const char*)(ws + WMOE_D), (size_t)256 * FFD, 4};
                      pg8::EpiBf16<0, false> E{(bf16_t*)(ws + WS_A) + (size_t)ch * MOE_CHUNK_TILES * 256 * DM, DM, pg8::RowScale{nullptr, 0, nullptr}, pg8::F8_OSC};
                      pg8::gemm_phase<pg8::EpiBf16<0, false>, pg8::MoeSched, pg8::NoHook, true, true>(lds, g, S, E); }
                PH_END_SPLIT(SPLIT_OK && ch + 1 < MOE_NCHUNK)
            }
            PH_BEGIN
                if (L == 3) p_moe_combine<true>(args, XB, SSQ, kargs.out); else p_moe_combine<false>(args, XB, SSQ, nullptr);
            PH_END
        }
    }
#undef PH_BEGIN
#undef PH_END
}

extern "C" void kernel_launch(void* const* d_in, const int* in_sizes, int n_in, void* d_out, int out_size, void* d_ws, size_t ws_size, hipStream_t stream) {
    static int grid = 0;
    if (grid == 0) {
        if (n_in != 22 || in_sizes[0] != NTOK * DM || out_size != NTOK * DM || ws_size < WS_END) {
            fprintf(stderr, "kernel_launch: unexpected problem: n_in %d in0 %d out %d ws %zu (need %zu)\n", n_in, n_in > 0 ? in_sizes[0] : -1, out_size, ws_size, (size_t)WS_END); grid = -1; return; }
        int dev = 0, cus = 0;
        if (hipGetDevice(&dev) != hipSuccess || hipDeviceGetAttribute(&cus, hipDeviceAttributeMultiprocessorCount, dev) != hipSuccess) { grid = -1; return; }
        if (hipFuncSetAttribute((const void*)yoco_fwd, hipFuncAttributeMaxDynamicSharedMemorySize, LDS_BYTES) != hipSuccess) { fprintf(stderr, "kernel_launch: hipFuncSetAttribute failed\n"); grid = -1; return; }
        int per_cu = 0;
        if (hipOccupancyMaxActiveBlocksPerMultiprocessor(&per_cu, (const void*)yoco_fwd, NTHREADS, LDS_BYTES) != hipSuccess || per_cu < 1)
            fprintf(stderr, "kernel_launch: note: occupancy query says %d\n", per_cu);
        (void)hipGetLastError();
        grid = cus;
    }
    if (grid < 0) return;
    (void)hipMemsetAsync((char*)d_ws + WS_CTL, 0, CTL_ZERO_BYTES, stream);
    Args a{};
    for (int i = 0; i < 22; ++i) a.in[i] = (const float*)d_in[i];
    a.out = (float*)d_out; a.ws = (unsigned char*)d_ws;
    constexpr int NPH = n_phases();
#if MK_SINGLE_LAUNCH
    a.ph_lo = 0; a.ph_hi = NPH;
    hipLaunchKernelGGL(yoco_fwd, dim3(grid), dim3(NTHREADS), LDS_BYTES, stream, a);
#else
    for (int p = 0; p < NPH; ++p) { a.ph_lo = p; a.ph_hi = p + 1; hipLaunchKernelGGL(yoco_fwd, dim3(grid), dim3(NTHREADS), LDS_BYTES, stream, a); }
#endif
}
```
